# Optimizing an MI355X kernel written in HIP

```python
import math
import jax, jax.numpy as jnp
from jax import lax
import numpy as np

D_MODEL = 1024
BATCH = 4
SEQ = 4096
DEPTH = 2

D_MIX = 1024
MLA_HEADS = 6
MLA_Q_RANK = 256
MLA_KV_RANK = 128
MLA_NOPE = 64
MLA_ROPE = 32
MLA_V = 64
ROPE_THETA = 10000.0
POOL_WINDOWS = (2, 4, 8, 16)
POOL_GROUP = 64
POOL_WIDTH = POOL_GROUP * len(POOL_WINDOWS)
FOX_HEADS = 6
FOX_HEAD_DIM = 64
FOX_GATE_BIAS_INIT = 2.0
BLOCK_Q = 128
D_FF = 2816
EPS = 1e-6
IN_Q_A = MLA_Q_RANK
IN_KV_A = MLA_KV_RANK
IN_K_ROPE = MLA_ROPE
IN_POOL = POOL_WIDTH
IN_FOX_QKV = 3 * FOX_HEADS * FOX_HEAD_DIM
IN_FOX_F = FOX_HEADS
N_IN = IN_Q_A + IN_KV_A + IN_K_ROPE + IN_POOL + IN_FOX_QKV + IN_FOX_F

kernel_name = "hybrid_mla_pool_fox_macaron"


def rmsnorm(x, g):
    xf = x.astype(jnp.float32)
    y = xf * lax.rsqrt(jnp.mean(xf * xf, axis=-1, keepdims=True) + EPS)
    return y.astype(x.dtype) * g


def rope(x, pos):
    r = x.shape[-1]
    inv_freq = ROPE_THETA ** (-jnp.arange(0, r, 2, dtype=jnp.float32) / r)
    ang = pos.astype(jnp.float32)[:, None] * inv_freq[None, :]
    cos = jnp.cos(ang).astype(x.dtype)
    sin = jnp.sin(ang).astype(x.dtype)
    x1, x2 = x[..., : r // 2], x[..., r // 2:]
    return jnp.concatenate([x1 * cos - x2 * sin, x2 * cos + x1 * sin], axis=-1)


def causal_block_attention(q, k, v, scale, log_decay_cum=None):
    b, h, s, dk = q.shape
    dv = v.shape[-1]
    nb = s // BLOCK_Q
    qb = q.reshape(b, h, nb, BLOCK_Q, dk).transpose(2, 0, 1, 3, 4)
    kpos = jnp.arange(s)
    xs = (jnp.arange(nb), qb)
    if log_decay_cum is not None:
        xs = xs + (log_decay_cum.reshape(b, h, nb, BLOCK_Q).transpose(2, 0, 1, 3),)

    def one_block(args):
        i, q_blk = args[0], args[1]
        sc = jnp.einsum('bhqd,bhkd->bhqk', q_blk, k, preferred_element_type=jnp.float32) * scale
        if log_decay_cum is not None:
            c_blk = args[2]
            sc = sc + c_blk[..., :, None] - log_decay_cum[..., None, :].astype(jnp.float32)
        qpos = i * BLOCK_Q + jnp.arange(BLOCK_Q)
        sc = jnp.where(kpos[None, :] <= qpos[:, None], sc, -jnp.inf)
        p = jax.nn.softmax(sc, axis=-1).astype(v.dtype)
        return jnp.einsum('bhqk,bhkd->bhqd', p, v)

    out = lax.map(one_block, xs)
    return out.transpose(1, 2, 0, 3, 4).reshape(b, h, s, dv)


def mla_mixer(q_a, kv_a, k_rope, q_a_norm, w_q_b, kv_a_norm, w_kv_b, pos):
    b, s, _ = q_a.shape
    q = (rmsnorm(q_a, q_a_norm) @ w_q_b).reshape(b, s, MLA_HEADS, MLA_NOPE + MLA_ROPE).transpose(0, 2, 1, 3)
    q_nope, q_pe = q[..., :MLA_NOPE], rope(q[..., MLA_NOPE:], pos)
    kv = (rmsnorm(kv_a, kv_a_norm) @ w_kv_b).reshape(b, s, MLA_HEADS, MLA_NOPE + MLA_V).transpose(0, 2, 1, 3)
    k_nope, v = kv[..., :MLA_NOPE], kv[..., MLA_NOPE:]
    k_pe = jnp.broadcast_to(rope(k_rope, pos)[:, None], (b, MLA_HEADS, s, MLA_ROPE))
    qf = jnp.concatenate([q_nope, q_pe], axis=-1)
    kf = jnp.concatenate([k_nope, k_pe], axis=-1)
    o = causal_block_attention(qf, kf, v, 1.0 / math.sqrt(MLA_NOPE + MLA_ROPE))
    return o.transpose(0, 2, 1, 3).reshape(b, s, MLA_HEADS * MLA_V)


def pool_mixer(u, pool_w, pool_scale):
    b, s, _ = u.shape
    ng = len(POOL_WINDOWS)
    ug = u.reshape(b, s, ng, POOL_GROUP)
    cs = jnp.cumsum(ug.astype(jnp.float32), axis=1)
    count = jnp.arange(1, s + 1, dtype=jnp.float32)
    means = []
    for g, w in enumerate(POOL_WINDOWS):
        c = cs[:, :, g]
        prev = jnp.pad(c[:, : s - w], ((0, 0), (w, 0), (0, 0)))
        means.append((c - prev) / jnp.minimum(count, float(w))[None, :, None])
    pooled = jnp.stack(means, axis=2).astype(u.dtype) - ug
    y = jnp.einsum('bsgc,gcd->bsgd', pooled, pool_w)
    return y.reshape(b, s, POOL_WIDTH) * pool_scale


def fox_mixer(qkv, f_logit, fox_b_f):
    b, s, _ = qkv.shape
    qkv = qkv.reshape(b, s, 3, FOX_HEADS, FOX_HEAD_DIM).transpose(2, 0, 3, 1, 4)
    q, k, v = qkv[0], qkv[1], qkv[2]
    log_f = jax.nn.log_sigmoid((f_logit + fox_b_f).astype(jnp.float32))
    cum = jnp.cumsum(log_f, axis=1).transpose(0, 2, 1)
    o = causal_block_attention(q, k, v, 1.0 / math.sqrt(FOX_HEAD_DIM), cum)
    return o.transpose(0, 2, 1, 3).reshape(b, s, FOX_HEADS * FOX_HEAD_DIM)


def swiglu(h, w_gu, w_down):
    gu = h @ w_gu
    g, u = gu[..., :D_FF], gu[..., D_FF:]
    return (jax.nn.silu(g) * u) @ w_down


def hybrid_mixing(h, w_in, q_a_norm, w_q_b, kv_a_norm, w_kv_b, pool_w, pool_scale, fox_b_f, w_out, pos):
    z = h @ w_in
    o0 = 0
    o1 = o0 + IN_Q_A
    o2 = o1 + IN_KV_A
    o3 = o2 + IN_K_ROPE
    o4 = o3 + IN_POOL
    o5 = o4 + IN_FOX_QKV
    o6 = o5 + IN_FOX_F
    ya = mla_mixer(z[..., o0:o1], z[..., o1:o2], z[..., o2:o3], q_a_norm, w_q_b, kv_a_norm, w_kv_b, pos)
    yb = pool_mixer(z[..., o3:o4], pool_w, pool_scale)
    yc = fox_mixer(z[..., o4:o5], z[..., o5:o6], fox_b_f)
    return jnp.concatenate([ya, yb, yc], axis=-1) @ w_out


def setup_inputs(seed: int = 0) -> dict:
    key = jax.random.key(seed)
    ks = jax.random.split(key, 24)
    L, D, F = DEPTH, D_MODEL, D_FF
    f32 = jnp.float32

    def nrm(k, shape, fan_in):
        return jax.random.normal(k, shape, f32) * (fan_in ** -0.5)

    def gain(k, shape):
        return 1.0 + 0.02 * jax.random.normal(k, shape, f32)

    return {
        "x": jax.random.normal(ks[0], (BATCH, SEQ, D), f32),
        "ffn1_norm": gain(ks[1], (L, D)),
        "ffn1_w_gu": nrm(ks[2], (L, D, 2 * F), D),
        "ffn1_w_down": nrm(ks[3], (L, F, D), F),
        "mix_norm": gain(ks[4], (L, D)),
        "w_in": nrm(ks[5], (L, D, N_IN), D),
        "q_a_norm": gain(ks[6], (L, MLA_Q_RANK)),
        "w_q_b": nrm(ks[7], (L, MLA_Q_RANK, MLA_HEADS * (MLA_NOPE + MLA_ROPE)), MLA_Q_RANK),
        "kv_a_norm": gain(ks[8], (L, MLA_KV_RANK)),
        "w_kv_b": nrm(ks[9], (L, MLA_KV_RANK, MLA_HEADS * (MLA_NOPE + MLA_V)), MLA_KV_RANK),
        "pool_w": nrm(ks[10], (L, len(POOL_WINDOWS), POOL_GROUP, POOL_GROUP), POOL_GROUP),
        "pool_scale": gain(ks[11], (L, POOL_WIDTH)),
        "fox_b_f": FOX_GATE_BIAS_INIT + 0.5 * jax.random.normal(ks[12], (L, FOX_HEADS), f32),
        "w_out": nrm(ks[13], (L, D_MIX, D), D_MIX),
        "ffn2_norm": gain(ks[14], (L, D)),
        "ffn2_w_gu": nrm(ks[15], (L, D, 2 * F), D),
        "ffn2_w_down": nrm(ks[16], (L, F, D), F),
        "final_norm": gain(ks[17], (D,)),
    }


def reference(x, ffn1_norm, ffn1_w_gu, ffn1_w_down, mix_norm, w_in, q_a_norm, w_q_b, kv_a_norm, w_kv_b,
              pool_w, pool_scale, fox_b_f, w_out, ffn2_norm, ffn2_w_gu, ffn2_w_down, final_norm):
    pos = jnp.arange(x.shape[1], dtype=jnp.int32)
    for l in range(DEPTH):
        x = x + 0.5 * swiglu(rmsnorm(x, ffn1_norm[l]), ffn1_w_gu[l], ffn1_w_down[l])
        x = x + hybrid_mixing(rmsnorm(x, mix_norm[l]), w_in[l], q_a_norm[l], w_q_b[l], kv_a_norm[l], w_kv_b[l],
                              pool_w[l], pool_scale[l], fox_b_f[l], w_out[l], pos)
        x = x + 0.5 * swiglu(rmsnorm(x, ffn2_norm[l]), ffn2_w_gu[l], ffn2_w_down[l])
    return rmsnorm(x, final_norm)
```

```cpp
#include <hip/hip_runtime.h>
#include <hip/hip_cooperative_groups.h>
#include <cstdio>
#include <cstdint>
namespace cg = cooperative_groups;
#ifndef MK_MULTI
#define MK_MULTI 0
#endif
namespace pg8 {
#define PG8_LAS __attribute__((address_space(3)))
typedef unsigned short bf16_t;
typedef short bf16x8 __attribute__((ext_vector_type(8)));
typedef float f32x4 __attribute__((ext_vector_type(4)));
typedef unsigned u32x4 __attribute__((ext_vector_type(4)));
constexpr int BM = 256, BK = 64, HALF = 128, HTB = HALF * BK * 2  , STAGE_BYTES = 8 * HTB, NXCD = 8, WGM = 8;

__host__ __device__ __forceinline__ int lds_byte(int r, int c) { const int st = (r >> 4) * 2 + (c >> 5), rr = r & 15, cc = c & 31, ob = rr * 64 + cc * 2; return st * 1024 + (ob ^ (((ob >> 9) & 1) << 5)); }
__host__ __device__ __forceinline__ void stage_rc(int b, int& R, int& C) { const int st = b / 1024, sb = b % 1024, swz = sb ^ (((sb >> 9) & 1) << 5); R = (st >> 1) * 16 + swz / 64; C = (st & 1) * 32 + (swz % 64) / 2; }
__host__ __device__ __forceinline__ int perm32(int rho) { const int n = rho >> 4, i = rho & 15; return 8 * (i >> 2) + 4 * n + (i & 3); }

struct Unit { int pm, pn; };
struct Gemm { const bf16_t* A; const bf16_t* Bt; int M, N, K; };

struct StaticOrder {
    int nM, nN, nwg, G, c;
    __host__ __device__ void init(int M, int N, int G_, int c_) { nM = M / BM; nN = N / BM; nwg = nM * nN; G = G_; c = c_; }
    __host__ __device__ bool next(int i, Unit& u) const {
        const long L = (long)i * G + c; if (L >= nwg) return false;
        int wgid = (int)L; { const int q = nwg / NXCD, r = nwg % NXCD, xcd = wgid % NXCD, off = wgid / NXCD; wgid = (xcd < r ? xcd * (q + 1) : r * (q + 1) + (xcd - r) * q) + off; }
        const int nig = WGM * nN, gid = wgid / nig, fm = gid * WGM, gsz = (nM - fm) < WGM ? (nM - fm) : WGM;
        u.pm = fm + ((wgid % nig) % gsz); u.pn = (wgid % nig) / gsz; return true;
    }
    __device__ __forceinline__ void a_ready(const Unit&) const {}
    __device__ __forceinline__ void done(const Unit&) const {}
};
typedef float f32x2 __attribute__((ext_vector_type(2)));
template <class Epi, class Sched, bool ALIGN_EPI = false, bool SP2 = false>
__device__ __forceinline__ void gemm_phase(PG8_LAS unsigned char* lds, const Gemm g, const Sched& S, const Epi& E) {
    int tid = threadIdx.x; asm volatile("" : "+v"(tid)); const int wid = __builtin_amdgcn_readfirstlane(tid >> 6), lane = tid & 63, wr = wid >> 2, wc = wid & 3, fr = lane & 15, fq = lane >> 4;
    const int K = g.K, nt = K / BK;
    unsigned voffA[2], voffB[2];
#pragma unroll
    for (int i = 0; i < 2; ++i) { int R, C; stage_rc(tid * 16 + i * 8192, R, C); const int Rb = Epi::PERM ? ((R & ~31) + perm32(R & 31)) : R;
        voffA[i] = (unsigned)(R * K + C) * 2u; voffB[i] = (unsigned)(Rb * K + C) * 2u; }
    const size_t kstep = (size_t)(BK * 2);
    const size_t hstep = (size_t)HALF * K * 2;
    const size_t tstep = 2 * hstep;
    const unsigned ldsw = (unsigned)wid * 1024u;
    const int aoff = lds_byte(wr * 64 + fr, fq * 8), boff = lds_byte(wc * 32 + fr, fq * 8);
#define PG8_SA(b, h) (((b) * 2 + (h)) * HTB)
#define PG8_SB(b, h) ((4 + (b) * 2 + (h)) * HTB)
#define PG8_STAGE(bufoff, gbase, voff) do { _Pragma("unroll") for (int _i = 0; _i < 2; ++_i) \
        __builtin_amdgcn_global_load_lds((const unsigned*)((const char*)(gbase) + (voff)[_i]), (PG8_LAS unsigned*)(lds + (bufoff) + ldsw + _i * 8192), 16, 0, 0); } while (0)
#define PG8_LDA(dst, b, h) do { _Pragma("unroll") for (int m = 0; m < 4; ++m) _Pragma("unroll") for (int k = 0; k < 2; ++k) dst[m][k] = *(const PG8_LAS bf16x8*)(lds + PG8_SA(b, h) + aoff + m * 2048 + k * 1024); } while (0)
#define PG8_LDB(dst, b, h) do { _Pragma("unroll") for (int n = 0; n < 2; ++n) _Pragma("unroll") for (int k = 0; k < 2; ++k) dst[n][k] = *(const PG8_LAS bf16x8*)(lds + PG8_SB(b, h) + boff + n * 2048 + k * 1024); } while (0)
#define PG8_MMA(ai, bj, At, Bt) do { __builtin_amdgcn_s_setprio(1); _Pragma("unroll") for (int m = 0; m < 4; ++m) _Pragma("unroll") for (int n = 0; n < 2; ++n) _Pragma("unroll") for (int k = 0; k < 2; ++k) \
        acc[ai][bj][m][n] = __builtin_amdgcn_mfma_f32_16x16x32_bf16(Bt[n][k], At[m][k], acc[ai][bj][m][n], 0, 0, 0); __builtin_amdgcn_s_setprio(0); } while (0)
#define PG8_WAIT_V(n) asm volatile("s_waitcnt vmcnt(" #n ")" ::: "memory")
#define PG8_WAIT_L(n) asm volatile("s_waitcnt lgkmcnt(" #n ")" ::: "memory")
#define PG8_BAR __builtin_amdgcn_s_barrier()
#define PG8_SCHED __builtin_amdgcn_sched_barrier(0)
    Unit cur, nxt; int ui = 0;
    if (!S.next(0, cur)) return;
    f32x4 acc[2][2][4][2];
#pragma unroll
    for (int a = 0; a < 2; ++a)
#pragma unroll
        for (int b = 0; b < 2; ++b)
#pragma unroll
            for (int m = 0; m < 4; ++m)
#pragma unroll
                for (int n = 0; n < 2; ++n) acc[a][b][m][n] = (f32x4){0.f, 0.f, 0.f, 0.f};
    bf16x8 At[4][2], B0[2][2], B1[2][2];
    const char* cA = (const char*)g.A + (size_t)cur.pm * tstep; const char* cB = (const char*)g.Bt + (size_t)cur.pn * tstep;
    S.a_ready(cur);
    if constexpr (SP2) {
        PG8_STAGE(PG8_SB(0, 0), cB, voffB); PG8_STAGE(PG8_SB(0, 1), cB + hstep, voffB); PG8_STAGE(PG8_SA(0, 0), cA, voffA); PG8_STAGE(PG8_SA(0, 1), cA + hstep, voffA);
        if (wr == 1) PG8_BAR;
        PG8_WAIT_V(2); PG8_BAR;
        PG8_STAGE(PG8_SB(1, 0), cB + kstep, voffB); PG8_STAGE(PG8_SA(1, 0), cA + kstep, voffA); PG8_STAGE(PG8_SB(1, 1), cB + hstep + kstep, voffB);
        PG8_WAIT_V(6); PG8_BAR;
    } else {
        PG8_STAGE(PG8_SB(0, 0), cB, voffB); PG8_STAGE(PG8_SA(0, 0), cA, voffA); PG8_STAGE(PG8_SB(0, 1), cB + hstep, voffB); PG8_STAGE(PG8_SA(0, 1), cA + hstep, voffA);
        if (wr == 1) PG8_BAR;
        PG8_WAIT_V(4); PG8_BAR;
        PG8_STAGE(PG8_SB(1, 0), cB + kstep, voffB); PG8_STAGE(PG8_SA(1, 0), cA + kstep, voffA); PG8_STAGE(PG8_SB(1, 1), cB + hstep + kstep, voffB);
        PG8_WAIT_V(6); PG8_BAR;
    }
    for (;;) {
        const bool has_next = S.next(ui + 1, nxt);
        const char* nA = has_next ? (const char*)g.A + (size_t)nxt.pm * tstep : cA; const char* nB = has_next ? (const char*)g.Bt + (size_t)nxt.pn * tstep : cB;
        for (int t = 0; t < nt; t += 2) {
            const bool last = (t == nt - 2);
            const char* a1 = cA + (size_t)(t + 1) * kstep;
            const char* a2 = last ? nA : cA + (size_t)(t + 2) * kstep; const char* b2 = last ? nB : cB + (size_t)(t + 2) * kstep;
            const char* a3 = a2 + kstep; const char* b3 = b2 + kstep;
            if (last && has_next) S.a_ready(nxt);
            if constexpr (SP2) {
            PG8_LDB(B0, 0, 0); PG8_LDB(B1, 0, 1); PG8_SCHED; PG8_LDA(At, 0, 0); PG8_STAGE(PG8_SA(1, 1), a1 + hstep, voffA);
            PG8_WAIT_V(8); PG8_WAIT_L(0); PG8_BAR; PG8_MMA(0, 0, At, B0); PG8_MMA(0, 1, At, B1); PG8_BAR; PG8_SCHED;
            PG8_LDA(At, 0, 1); PG8_STAGE(PG8_SB(0, 0), b2, voffB); PG8_STAGE(PG8_SB(0, 1), b2 + hstep, voffB); PG8_STAGE(PG8_SA(0, 0), a2, voffA);
            PG8_WAIT_V(8); PG8_WAIT_L(0); PG8_BAR; PG8_MMA(1, 0, At, B0); PG8_MMA(1, 1, At, B1); PG8_BAR; PG8_SCHED;
            PG8_LDB(B0, 1, 0); PG8_LDB(B1, 1, 1); PG8_SCHED; PG8_LDA(At, 1, 0); PG8_STAGE(PG8_SA(0, 1), a2 + hstep, voffA);
            PG8_WAIT_V(8); PG8_WAIT_L(0); PG8_BAR; PG8_MMA(0, 0, At, B0); PG8_MMA(0, 1, At, B1); PG8_BAR; PG8_SCHED;
            PG8_LDA(At, 1, 1); PG8_STAGE(PG8_SB(1, 0), b3, voffB); PG8_STAGE(PG8_SB(1, 1), b3 + hstep, voffB); PG8_STAGE(PG8_SA(1, 0), a3, voffA);
            PG8_WAIT_V(8); PG8_WAIT_L(0); PG8_BAR; PG8_MMA(1, 0, At, B0); PG8_MMA(1, 1, At, B1); PG8_BAR; PG8_SCHED;
            } else {
            PG8_LDB(B0, 0, 0); PG8_SCHED; PG8_LDA(At, 0, 0); PG8_STAGE(PG8_SA(1, 1), a1 + hstep, voffA);
            PG8_WAIT_L(8); PG8_BAR; PG8_WAIT_L(0); PG8_MMA(0, 0, At, B0); PG8_BAR; PG8_SCHED;
            PG8_LDB(B1, 0, 1); PG8_STAGE(PG8_SB(0, 0), b2, voffB);
            PG8_BAR; PG8_WAIT_L(0); PG8_MMA(0, 1, At, B1); PG8_BAR;
            PG8_LDA(At, 0, 1); PG8_STAGE(PG8_SA(0, 0), a2, voffA);
            PG8_BAR; PG8_WAIT_L(0); PG8_MMA(1, 0, At, B0); PG8_BAR; PG8_SCHED;
            PG8_STAGE(PG8_SB(0, 1), b2 + hstep, voffB);
            PG8_WAIT_V(6); PG8_BAR; PG8_MMA(1, 1, At, B1); PG8_BAR;
            PG8_LDB(B0, 1, 0); PG8_SCHED; PG8_LDA(At, 1, 0); PG8_STAGE(PG8_SA(0, 1), a2 + hstep, voffA);
            PG8_WAIT_L(8); PG8_BAR; PG8_WAIT_L(0); PG8_MMA(0, 0, At, B0); PG8_BAR; PG8_SCHED;
            PG8_LDB(B1, 1, 1); PG8_STAGE(PG8_SB(1, 0), b3, voffB);
            PG8_BAR; PG8_WAIT_L(0); PG8_MMA(0, 1, At, B1); PG8_BAR;
            PG8_LDA(At, 1, 1); PG8_STAGE(PG8_SA(1, 0), a3, voffA);
            PG8_BAR; PG8_WAIT_L(0); PG8_MMA(1, 0, At, B0); PG8_BAR; PG8_SCHED;
            PG8_STAGE(PG8_SB(1, 1), b3 + hstep, voffB);
            PG8_WAIT_V(6); PG8_BAR; PG8_MMA(1, 1, At, B1); PG8_BAR;
            }
        }
        if constexpr (ALIGN_EPI) { if (wr == 0) PG8_BAR; }
        if constexpr (!Epi::AFTER_DRAIN) { E(acc, cur, wr, wc, fr, fq); S.done(cur); }
        if (!has_next) break;
#pragma unroll
        for (int a = 0; a < 2; ++a)
#pragma unroll
            for (int b = 0; b < 2; ++b)
#pragma unroll
                for (int m = 0; m < 4; ++m)
#pragma unroll
                    for (int n = 0; n < 2; ++n) acc[a][b][m][n] = (f32x4){0.f, 0.f, 0.f, 0.f};
        cur = nxt; cA = nA; cB = nB; ++ui;
        if constexpr (ALIGN_EPI) { if (wr == 1) PG8_BAR; }
    }
    PG8_WAIT_V(0);
    if constexpr (!ALIGN_EPI) { if (wr == 0) PG8_BAR; }
    PG8_BAR;
    if constexpr (Epi::AFTER_DRAIN) { E.fused(acc, cur, wr, wc, fr, fq, lds, wid, lane); S.done(cur); }
#undef PG8_SA
#undef PG8_SB
#undef PG8_STAGE
#undef PG8_LDA
#undef PG8_LDB
#undef PG8_MMA
#undef PG8_WAIT_V
#undef PG8_WAIT_L
#undef PG8_BAR
#undef PG8_SCHED
}
}

constexpr int M = 16384, SEQ = 4096, NB = 4, D = 1024, F = 2816, DEPTH = 2;
constexpr int N_IN = 1830;
constexpr int NGU = 2 * F;
constexpr int NWIN = 2048;
constexpr int NQKV = 1536, KQKV = 384;
constexpr int QP = 1152, VP = 768;
constexpr float EPS = 1e-6f;
constexpr float LOG2E = 1.4426950408889634f;
constexpr float QS_MLA = 0.14724444f;
constexpr float QS_FOX = 0.18033688f;

constexpr size_t MiB = 1u << 20;
constexpr size_t WS_CTL = 0;
constexpr size_t WS_ROPE = 1 * MiB;
constexpr size_t WS_FL = 1 * MiB + 512 * 1024;
constexpr size_t WS_W = 2 * MiB;
constexpr size_t WL_GU1 = 0, WL_GU2 = 11 * MiB, WL_DN1 = 22 * MiB, WL_DN2 = 22 * MiB + 5632 * 1024, WL_IN = 33 * MiB, WL_OUT = 37 * MiB, WL_QKV = 39 * MiB;
constexpr size_t WL_STRIDE = 41 * MiB;
constexpr size_t WS_XN = 84 * MiB;
constexpr size_t WS_BIG = 116 * MiB;
constexpr size_t WS_ZS = WS_BIG, WS_U = WS_BIG + 16 * MiB, WS_QKN = WS_BIG + 24 * MiB, WS_QP = WS_BIG + 36 * MiB, WS_KP = WS_BIG + 72 * MiB, WS_V = WS_BIG + 108 * MiB;
constexpr size_t WS_END = WS_BIG + 132 * MiB;
static_assert(WL_QKV + (size_t)NQKV * KQKV * 2 <= WL_STRIDE && WS_W + 2 * WL_STRIDE <= WS_XN, "weights map");
static_assert(WS_QKN + (size_t)M * KQKV * 2 <= WS_QP && WS_V + (size_t)M * VP * 2 <= WS_END && WS_BIG + (size_t)M * F * 2 <= WS_END + 0 * MiB + 0, "act map");

constexpr int LDS_BYTES = 147456;
constexpr int LDS_MISC = 131072 + 4096;

#define LAS __attribute__((address_space(3)))
typedef unsigned short bf16;
typedef float f32x4 __attribute__((ext_vector_type(4)));
typedef float f32x2 __attribute__((ext_vector_type(2)));
typedef float f32x16 __attribute__((ext_vector_type(16)));
typedef unsigned u32x4 __attribute__((ext_vector_type(4)));
typedef unsigned u32x2 __attribute__((ext_vector_type(2)));
typedef short bf16x8 __attribute__((ext_vector_type(8)));
typedef short s16x4 __attribute__((ext_vector_type(4)));
typedef __bf16 bf16x2_t __attribute__((ext_vector_type(2)));

__device__ __forceinline__ unsigned cvtpk(float lo, float hi) { f32x2 v = {lo, hi}; bf16x2_t b = __builtin_convertvector(v, bf16x2_t); return __builtin_bit_cast(unsigned, b); }
__device__ __forceinline__ unsigned f2bf(float f) { unsigned u = __builtin_bit_cast(unsigned, f); return (u + 0x7fffu + ((u >> 16) & 1u)) >> 16; }
__device__ __forceinline__ float bf2f(unsigned b) { return __builtin_bit_cast(float, b << 16); }
__device__ __forceinline__ float lane_xor(float v, int lane, int o) { return __builtin_bit_cast(float, __builtin_amdgcn_ds_bpermute((lane ^ o) << 2, __builtin_bit_cast(int, v))); }
__device__ __forceinline__ float wave_sum(float v, int lane) {
#pragma unroll
    for (int o = 1; o < 64; o <<= 1) v += lane_xor(v, lane, o);
    return v;
}
__device__ __forceinline__ void store8(bf16* p, f32x4 a, f32x4 b) { u32x4 w; w.x = cvtpk(a[0], a[1]); w.y = cvtpk(a[2], a[3]); w.z = cvtpk(b[0], b[1]); w.w = cvtpk(b[2], b[3]); *(u32x4*)p = w; }

struct EpiSwiglu {
    static constexpr bool PERM = true, AFTER_DRAIN = false;
    bf16* O;
    __device__ __forceinline__ void operator()(const pg8::f32x4 (&acc)[2][2][4][2], const pg8::Unit& u, int wr, int wc, int fr, int fq) const {
        asm volatile("" : "+v"(fr), "+v"(fq));
        const int row0 = u.pm * 256 + wr * 64 + fr, col0 = u.pn * 128 + wc * 32 + 8 * fq;
#pragma unroll
        for (int ai = 0; ai < 2; ++ai)
#pragma unroll
            for (int m = 0; m < 4; ++m) {
                bf16* rowp = O + (size_t)(row0 + ai * 128 + m * 16) * F + col0;
                f32x4 r[2];
#pragma unroll
                for (int n = 0; n < 2; ++n) {
                    const f32x4 g = acc[ai][0][m][n], uu = acc[ai][1][m][n];
#pragma unroll
                    for (int j = 0; j < 4; ++j) { const float e = __builtin_amdgcn_exp2f(-g[j] * LOG2E); r[n][j] = g[j] * __builtin_amdgcn_rcpf(1.0f + e) * uu[j]; }
                }
                store8(rowp, r[0], r[1]);
            }
    }
};
struct EpiResid {
    static constexpr bool PERM = false, AFTER_DRAIN = false;
    const float* base; float* out; float scale;
    __device__ __forceinline__ void operator()(const pg8::f32x4 (&acc)[2][2][4][2], const pg8::Unit& u, int wr, int wc, int fr, int fq) const {
        asm volatile("" : "+v"(fr), "+v"(fq));
        const int row0 = u.pm * 256 + wr * 64 + fr, col0 = u.pn * 256 + wc * 32 + 4 * fq;
#pragma unroll
        for (int ai = 0; ai < 2; ++ai)
#pragma unroll
            for (int m = 0; m < 4; ++m) {
                const size_t off = (size_t)(row0 + ai * 128 + m * 16) * D + col0;
#pragma unroll
                for (int bj = 0; bj < 2; ++bj)
#pragma unroll
                    for (int n = 0; n < 2; ++n) { const size_t p = off + bj * 128 + n * 16; const f32x4 b = *(const f32x4*)(base + p); *(f32x4*)(out + p) = b + acc[ai][bj][m][n] * scale; }
                asm volatile("" ::: "memory");
            }
    }
};
struct EpiWin {
    static constexpr bool PERM = true, AFTER_DRAIN = false;
    bf16 *Zs, *U, *Qp, *Kp, *V; float* Fl;
    __device__ __forceinline__ void operator()(const pg8::f32x4 (&acc)[2][2][4][2], const pg8::Unit& u, int wr, int wc, int fr, int fq) const {
        asm volatile("" : "+v"(fr), "+v"(fq));
        const int row0 = u.pm * 256 + wr * 64 + fr;
#pragma unroll
        for (int bj = 0; bj < 2; ++bj) {
            const int c0 = u.pn * 256 + bj * 128 + wc * 32 + 8 * fq;
            bf16* dst; int pitch; float sc = 1.0f; bool f32too = false;
            if (c0 < 512) { dst = Zs + c0; pitch = 512; f32too = (c0 == 416); }
            else if (c0 < 768) { dst = U + (c0 - 512); pitch = 256; }
            else if (c0 < 1920) {
                const int e = c0 - 768, seg = e / 384, w = e - seg * 384, hh = w >> 6, d = w & 63;
                if (seg == 0) { dst = Qp + (6 + hh) * 96 + d; pitch = QP; sc = QS_FOX; }
                else if (seg == 1) { dst = Kp + (6 + hh) * 96 + d; pitch = QP; }
                else { dst = V + (6 + hh) * 64 + d; pitch = VP; }
            } else continue;
#pragma unroll
            for (int ai = 0; ai < 2; ++ai)
#pragma unroll
                for (int m = 0; m < 4; ++m) {
                    const int row = row0 + ai * 128 + m * 16;
                    store8(dst + (size_t)row * pitch, acc[ai][bj][m][0] * sc, acc[ai][bj][m][1] * sc);
                    if (f32too) { *(f32x4*)(Fl + (size_t)row * 8) = acc[ai][bj][m][0]; *(f32x4*)(Fl + (size_t)row * 8 + 4) = acc[ai][bj][m][1]; }
                }
        }
    }
};
struct EpiQKV {
    static constexpr bool PERM = true, AFTER_DRAIN = false;
    bf16 *Qp, *Kp, *V; const float* rope;
    __device__ __forceinline__ void operator()(const pg8::f32x4 (&acc)[2][2][4][2], const pg8::Unit& u, int wr, int wc, int fr, int fq) const {
        asm volatile("" : "+v"(fr), "+v"(fq));
        const int row0 = u.pm * 256 + wr * 64 + fr;
#pragma unroll
        for (int bj = 0; bj < 2; ++bj) {
            const int c0 = u.pn * 256 + bj * 128 + wc * 32 + 8 * fq;
            if (c0 < 576) {
                const int head = c0 / 96, d = c0 - head * 96;
                bf16* dst = Qp + head * 96 + d;
                if (d < 64) {
#pragma unroll
                    for (int ai = 0; ai < 2; ++ai)
#pragma unroll
                        for (int m = 0; m < 4; ++m) { const int row = row0 + ai * 128 + m * 16; store8(dst + (size_t)row * QP, acc[ai][bj][m][0] * QS_MLA, acc[ai][bj][m][1] * QS_MLA); }
                } else {
                    const int a = (d - 64) >> 3;
#pragma unroll
                    for (int ai = 0; ai < 2; ++ai)
#pragma unroll
                        for (int m = 0; m < 4; ++m) {
                            const int row = row0 + ai * 128 + m * 16, pos = row & (SEQ - 1);
                            const f32x4 t0 = *(const f32x4*)(rope + (size_t)(pos * 16 + 4 * a) * 2), t1 = *(const f32x4*)(rope + (size_t)(pos * 16 + 4 * a) * 2 + 4);
                            const f32x4 x = acc[ai][bj][m][0], y = acc[ai][bj][m][1];
                            f32x4 ox, oy;
                            ox[0] = x[0] * t0[0] - x[1] * t0[1]; ox[1] = x[1] * t0[0] + x[0] * t0[1]; ox[2] = x[2] * t0[2] - x[3] * t0[3]; ox[3] = x[3] * t0[2] + x[2] * t0[3];
                            oy[0] = y[0] * t1[0] - y[1] * t1[1]; oy[1] = y[1] * t1[0] + y[0] * t1[1]; oy[2] = y[2] * t1[2] - y[3] * t1[3]; oy[3] = y[3] * t1[2] + y[2] * t1[3];
                            store8(dst + (size_t)row * QP, ox * QS_MLA, oy * QS_MLA);
                            asm volatile("" ::: "memory");
                        }
                }
            } else if (c0 < 1344) {
                const int e = c0 - 576, head = e >> 7, d = e & 127;
                bf16* dst; int pitch;
                if (d < 64) { dst = Kp + head * 96 + d; pitch = QP; } else { dst = V + head * 64 + (d - 64); pitch = VP; }
#pragma unroll
                for (int ai = 0; ai < 2; ++ai)
#pragma unroll
                    for (int m = 0; m < 4; ++m) { const int row = row0 + ai * 128 + m * 16; store8(dst + (size_t)row * pitch, acc[ai][bj][m][0], acc[ai][bj][m][1]); }
            }
        }
    }
};

struct Args {
    const float* in[18];
    float* out; unsigned char* ws;
    int ph_lo, ph_hi;
};
typedef const __attribute__((address_space(4))) Args* CArgsP;
enum { I_X = 0, I_F1N, I_F1GU, I_F1DN, I_MIXN, I_WIN, I_QAN, I_WQB, I_KVAN, I_WKVB, I_POOLW, I_POOLS, I_FOXB, I_WOUT, I_F2N, I_F2GU, I_F2DN, I_FINN };

__device__ __forceinline__ void conv_item(const float* W, int Nsrc, int Ksrc, int sc, int koff, bf16* WT, int Kdst, int k0, int n0, LAS float* scr, int lane) {
#pragma unroll 8
    for (int i = 0; i < 32; ++i) {
        const int kk = 2 * i + (lane >> 5), ks = k0 + kk - koff;
        float v = 0.f;
        if (sc >= 0 && ks >= 0 && ks < Ksrc) v = W[(size_t)ks * Nsrc + sc];
        scr[kk * 33 + (lane & 31)] = v;
    }
    asm volatile("s_waitcnt lgkmcnt(0)" ::: "memory");
    const int c = lane & 7;
#pragma unroll
    for (int j = 0; j < 4; ++j) {
        const int n = (lane >> 3) + 8 * j; const LAS float* s = scr + (8 * c) * 33 + n;
        u32x4 o; o.x = cvtpk(s[0 * 33], s[1 * 33]); o.y = cvtpk(s[2 * 33], s[3 * 33]); o.z = cvtpk(s[4 * 33], s[5 * 33]); o.w = cvtpk(s[6 * 33], s[7 * 33]);
        *(u32x4*)(WT + (size_t)(n0 + n) * Kdst + k0 + 8 * c) = o;
    }
    asm volatile("s_waitcnt lgkmcnt(0)" ::: "memory");
}
constexpr int IT_GU = 16 * (NGU / 32), IT_DN = (F / 64) * (D / 32), IT_IN = 16 * (NWIN / 32), IT_QKV = (KQKV / 64) * (NQKV / 32), IT_OUT = 16 * (D / 32);
constexpr int IT_LAYER = 2 * IT_GU + 2 * IT_DN + IT_IN + IT_QKV + IT_OUT;

__device__ __forceinline__ void prologue(CArgsP Ap, LAS unsigned char* lds, int gw, int NGW, int wave, int lane) {
    LAS float* scr = (LAS float*)(lds + wave * 16384);
    unsigned char* ws = Ap->ws;
    for (int it = gw; it < DEPTH * IT_LAYER; it += NGW) {
        const int l = it / IT_LAYER; int r = it - l * IT_LAYER;
        unsigned char* wl = ws + WS_W + (size_t)l * WL_STRIDE;
        const int nl = lane & 31;
        if (r < 2 * IT_GU) {
            const int f = r / IT_GU; r -= f * IT_GU;
            const float* W = Ap->in[f ? I_F2GU : I_F1GU] + (size_t)l * D * NGU;
            const int nblk = NGU / 32, kb = r / nblk, nb = r - kb * nblk, n = nb * 32 + nl, tile = n >> 8, w = n & 255;
            const int sc = (w < 128) ? tile * 128 + w : F + tile * 128 + (w - 128);
            conv_item(W, NGU, D, sc, 0, (bf16*)(wl + (f ? WL_GU2 : WL_GU1)), D, kb * 64, nb * 32, scr, lane);
            continue;
        }
        r -= 2 * IT_GU;
        if (r < 2 * IT_DN) {
            const int f = r / IT_DN; r -= f * IT_DN;
            const float* W = Ap->in[f ? I_F2DN : I_F1DN] + (size_t)l * F * D;
            const int nblk = D / 32, kb = r / nblk, nb = r - kb * nblk;
            conv_item(W, D, F, nb * 32 + nl, 0, (bf16*)(wl + (f ? WL_DN2 : WL_DN1)), F, kb * 64, nb * 32, scr, lane);
            continue;
        }
        r -= 2 * IT_DN;
        if (r < IT_IN) {
            const float* W = Ap->in[I_WIN] + (size_t)l * D * N_IN;
            const int nblk = NWIN / 32, kb = r / nblk, nb = r - kb * nblk, n = nb * 32 + nl;
            int sc = -1;
            if (n < 416) sc = n; else if (n < 422) sc = 1824 + (n - 416); else if (n < 512) sc = -1; else if (n < 768) sc = 416 + (n - 512); else if (n < 1920) sc = 672 + (n - 768);
            conv_item(W, N_IN, D, sc, 0, (bf16*)(wl + WL_IN), D, kb * 64, nb * 32, scr, lane);
            continue;
        }
        r -= IT_IN;
        if (r < IT_QKV) {
            const int nblk = NQKV / 32, kb = r / nblk, nb = r - kb * nblk, n = nb * 32 + nl;
            if (n < 576) {
                const int head = n / 96, d = n - head * 96; int sd = d;
                if (d >= 64) { const int j2 = d - 64; sd = 64 + (j2 >> 1) + 16 * (j2 & 1); }
                conv_item(Ap->in[I_WQB] + (size_t)l * 256 * 576, 576, 256, head * 96 + sd, 0, (bf16*)(wl + WL_QKV), KQKV, kb * 64, nb * 32, scr, lane);
            } else {
                const int sc = (n < 1344) ? n - 576 : -1;
                conv_item(Ap->in[I_WKVB] + (size_t)l * 128 * 768, 768, 128, sc, 256, (bf16*)(wl + WL_QKV), KQKV, kb * 64, nb * 32, scr, lane);
            }
            continue;
        }
        r -= IT_QKV;
        {
            const float* W = Ap->in[I_WOUT] + (size_t)l * D * D;
            const int nblk = D / 32, kb = r / nblk, nb = r - kb * nblk;
            conv_item(W, D, D, nb * 32 + nl, 0, (bf16*)(wl + WL_OUT), D, kb * 64, nb * 32, scr, lane);
        }
    }
    float* T = (float*)(ws + WS_ROPE);
    for (int e = gw * 64 + lane; e < SEQ * 16; e += NGW * 64) {
        const int pos = e >> 4, j = e & 15;
        const float inv = exp2f(-(float)j * 0.8304820237218405f);
        const float ang = (float)pos * inv;
        const double a = (double)ang, k = __builtin_rint(a * 0.15915494309189535), x = a - k * 6.283185307179586, x2 = x * x;
        double s = x, c = 1.0, ts = x, tc = 1.0;
#pragma unroll 1
        for (int i = 1; i <= 12; ++i) {
            tc = -tc * x2 / (double)((2 * i - 1) * (2 * i)); c += tc;
            ts = -ts * x2 / (double)((2 * i) * (2 * i + 1)); s += ts;
        }
        *(f32x2*)(T + (size_t)e * 2) = (f32x2){(float)c, (float)s};
    }
}

__device__ __forceinline__ void norm_phase(const float* x, const float* g, bf16* xn, float* fout, int gw, int NGW, int lane) {
    f32x4 gv[4];
#pragma unroll
    for (int j = 0; j < 4; ++j) gv[j] = *((const f32x4*)g + lane + 64 * j);
    for (int row = gw; row < M; row += NGW) {
        const f32x4* xr = (const f32x4*)(x + (size_t)row * D) + lane;
        f32x4 v[4]; float s = 0.f;
#pragma unroll
        for (int j = 0; j < 4; ++j) { v[j] = xr[64 * j]; s += (v[j][0] * v[j][0] + v[j][1] * v[j][1]) + (v[j][2] * v[j][2] + v[j][3] * v[j][3]); }
        const float rstd = 1.0f / sqrtf(wave_sum(s, lane) * (1.0f / D) + EPS);
        if (fout) {
            f32x4* o = (f32x4*)(fout + (size_t)row * D) + lane;
#pragma unroll
            for (int j = 0; j < 4; ++j) o[64 * j] = (v[j] * rstd) * gv[j];
        } else {
            u32x2* o = (u32x2*)(xn + (size_t)row * D) + lane;
#pragma unroll
            for (int j = 0; j < 4; ++j) { const f32x4 y = (v[j] * rstd) * gv[j]; o[64 * j] = (u32x2){cvtpk(y[0], y[1]), cvtpk(y[2], y[3])}; }
        }
    }
}

__device__ __forceinline__ void prep_phase(CArgsP Ap, int l, LAS unsigned char* lds, int tid, int wave, int lane, int bid, int G) {
    unsigned char* ws = Ap->ws;
    const bf16* Zs = (const bf16*)(ws + WS_ZS); const bf16* U = (const bf16*)(ws + WS_U);
    bf16* QKn = (bf16*)(ws + WS_QKN); bf16* Qp = (bf16*)(ws + WS_QP); bf16* Kp = (bf16*)(ws + WS_KP); bf16* Y = (bf16*)(ws + WS_XN);
    const float* T = (const float*)(ws + WS_ROPE); const float* Fl = (const float*)(ws + WS_FL);
    const float* qg = Ap->in[I_QAN] + l * 256; const float* kg = Ap->in[I_KVAN] + l * 128;
    const float* pw = Ap->in[I_POOLW] + (size_t)l * 4 * 4096; const float* ps = Ap->in[I_POOLS] + l * 256;
    const float* fb = Ap->in[I_FOXB] + l * 6;
    LAS float* Uw = (LAS float*)lds;
    LAS float* Wg = (LAS float*)(lds + 20480);
    LAS float* Pp = (LAS float*)(lds + 20480 + 16384);
    LAS double* Sd = (LAS double*)(lds + 65536);
    for (int tile = bid; tile < M / 64; tile += G) {
        const int r0 = tile * 64, tloc0 = r0 & (SEQ - 1);
        for (int i = 0; i < 8; ++i) {
            const int row = r0 + wave * 8 + i, pos = row & (SEQ - 1);
            const bf16* z = Zs + (size_t)row * 512;
            const u32x2 qa = *(const u32x2*)(z + 4 * lane); const unsigned ka = *(const unsigned*)(z + 256 + 2 * lane);
            float q0 = bf2f(qa.x & 0xffffu), q1 = bf2f(qa.x >> 16), q2 = bf2f(qa.y & 0xffffu), q3 = bf2f(qa.y >> 16);
            float k0 = bf2f(ka & 0xffffu), k1 = bf2f(ka >> 16);
            const float sq = wave_sum((q0 * q0 + q1 * q1) + (q2 * q2 + q3 * q3), lane), sk = wave_sum(k0 * k0 + k1 * k1, lane);
            const float rq = 1.0f / sqrtf(sq * (1.0f / 256.0f) + EPS), rk = 1.0f / sqrtf(sk * (1.0f / 128.0f) + EPS);
            const f32x4 g4 = *(const f32x4*)(qg + 4 * lane); const f32x2 g2 = *(const f32x2*)(kg + 2 * lane);
            bf16* o = QKn + (size_t)row * KQKV;
            *(u32x2*)(o + 4 * lane) = (u32x2){cvtpk(q0 * rq * g4[0], q1 * rq * g4[1]), cvtpk(q2 * rq * g4[2], q3 * rq * g4[3])};
            *(unsigned*)(o + 256 + 2 * lane) = cvtpk(k0 * rk * g2[0], k1 * rk * g2[1]);
            if (lane < 16) {
                const float x1 = bf2f(z[384 + lane]), x2 = bf2f(z[400 + lane]);
                const f32x2 cs = *(const f32x2*)(T + (size_t)(pos * 16 + lane) * 2);
                const unsigned pk = cvtpk(x1 * cs[0] - x2 * cs[1], x2 * cs[0] + x1 * cs[1]);
                bf16* kp = Kp + (size_t)row * QP + 64 + 2 * lane;
#pragma unroll
                for (int hh = 0; hh < 6; ++hh) *(unsigned*)(kp + hh * 96) = pk;
            }
        }
        for (int g = 0; g < 4; ++g) {
            __syncthreads();
            for (int idx = tid; idx < 79 * 64; idx += 512) {
                const int i = idx >> 6, c = idx & 63; float v = 0.f;
                if (tloc0 - 15 + i >= 0) v = bf2f(U[(size_t)(r0 - 15 + i) * 256 + g * 64 + c]);
                Uw[idx] = v;
            }
            for (int idx = tid; idx < 4096; idx += 512) Wg[idx] = pw[g * 4096 + idx];
            __syncthreads();
            const int w = 2 << g;
            for (int idx = tid; idx < 4096; idx += 512) {
                const int tt = idx >> 6, c = idx & 63; float s = 0.f;
                for (int i = 0; i < w; ++i) s += Uw[(15 + tt - i) * 64 + c];
                const int cnt = min(tloc0 + tt + 1, w);
                Pp[tt * 65 + c] = s / (float)cnt - Uw[(15 + tt) * 64 + c];
            }
            __syncthreads();
            const int tt = tid >> 3, dd = tid & 7;
            f32x4 a0 = {0.f, 0.f, 0.f, 0.f}, a1 = {0.f, 0.f, 0.f, 0.f};
            for (int c = 0; c < 64; ++c) {
                const float p = Pp[tt * 65 + c];
                const f32x4 w0 = *(const LAS f32x4*)(Wg + c * 64 + dd * 8), w1 = *(const LAS f32x4*)(Wg + c * 64 + dd * 8 + 4);
                a0 += w0 * p; a1 += w1 * p;
            }
            const f32x4 s0 = *(const f32x4*)(ps + g * 64 + dd * 8), s1 = *(const f32x4*)(ps + g * 64 + dd * 8 + 4);
            store8(Y + (size_t)(r0 + tt) * D + 384 + g * 64 + dd * 8, a0 * s0, a1 * s1);
        }
        __syncthreads();
    }
    for (int s = bid; s < NB * 6; s += G) {
        const int b = s / 6, h = s - b * 6;
        const float bias = fb[h];
        double pre[8]; double run = 0.0;
#pragma unroll
        for (int j = 0; j < 8; ++j) {
            const float x = Fl[(size_t)(b * SEQ + tid * 8 + j) * 8 + h] + bias;
            const float ls = fminf(x, 0.f) - log1pf(expf(-fabsf(x)));
            run += (double)ls; pre[j] = run;
        }
        double inc = run;
#pragma unroll
        for (int o = 1; o < 64; o <<= 1) { const long long iv = __builtin_bit_cast(long long, inc); const int src = ((lane - o) & 63) << 2; const unsigned lo = (unsigned)__builtin_amdgcn_ds_bpermute(src, (int)(unsigned)iv), hi = (unsigned)__builtin_amdgcn_ds_bpermute(src, (int)(unsigned)(iv >> 32)); const double t = __builtin_bit_cast(double, ((unsigned long long)hi << 32) | lo); if (lane >= o) inc += t; }
        __syncthreads();
        if (lane == 63) Sd[wave] = inc;
        __syncthreads();
        double off = inc - run;
        for (int w2 = 0; w2 < wave; ++w2) off += Sd[w2];
#pragma unroll
        for (int j = 0; j < 8; ++j) {
            const double C = (off + pre[j]) * 1.4426950408889634;
            const unsigned c1 = f2bf((float)C); const double r1 = C - (double)bf2f(c1);
            const unsigned c2 = f2bf((float)r1); const double r2 = r1 - (double)bf2f(c2);
            const unsigned c3 = f2bf((float)r2);
            const size_t row = (size_t)b * SEQ + tid * 8 + j;
            u32x4* q = (u32x4*)(Qp + row * QP + (6 + h) * 96 + 64); u32x4* k = (u32x4*)(Kp + row * QP + (6 + h) * 96 + 64);
            const u32x4 z4 = {0u, 0u, 0u, 0u};
            q[0] = (u32x4){c1 | (c2 << 16), c3 | (0x3F80u << 16), 0x3F803F80u, 0u}; q[1] = z4; q[2] = z4; q[3] = z4;
            k[0] = (u32x4){0x3F803F80u, 0x3F80u | ((c1 ^ 0x8000u) << 16), (c2 ^ 0x8000u) | ((c3 ^ 0x8000u) << 16), 0u}; k[1] = z4; k[2] = z4; k[3] = z4;
        }
        __syncthreads();
    }
}

namespace att {
constexpr int KSTR = 208, KBUF = 64 * KSTR, VBUF = 8192, BUF = KBUF + VBUF;
__device__ __forceinline__ int crow(int i, int h) { return (i & 3) + 8 * (i >> 2) + 4 * h; }
typedef short v4i16_t __attribute__((ext_vector_type(4)));
__device__ __forceinline__ s16x4 vtr(const LAS unsigned char* p) { return __builtin_bit_cast(s16x4, __builtin_amdgcn_ds_read_tr16_b64_v4i16((LAS v4i16_t*)p)); }

__device__ __forceinline__ void attn_unit(LAS unsigned char* lds, const bf16* Qp, const bf16* Kp, const bf16* V, bf16* Y, int b, int head, int qb, int tid, int w, int lane) {
    const int r = lane & 31, h = lane >> 5;
    const size_t rowbase = (size_t)b * SEQ; const int q0 = qb * 256;
    const bf16* qptr = Qp + (rowbase + q0 + 32 * w + r) * QP + head * 96 + 8 * h;
    bf16x8 qf[6];
#pragma unroll
    for (int s = 0; s < 6; ++s) qf[s] = *(const bf16x8*)(qptr + 16 * s);
    f32x16 o0, o1;
#pragma unroll
    for (int i = 0; i < 16; ++i) { o0[i] = 0.f; o1[i] = 0.f; }
    float mrun = -INFINITY, lrun = 0.f;
    const int NT = 4 * (qb + 1);
    const bool lowhalf = tid < 256;
    const bf16* gA = Kp + (rowbase + tid / 12) * QP + head * 96 + (tid % 12) * 8; const int lA = (tid / 12) * KSTR + (tid % 12) * 16;
    const bf16* gB; int lB; size_t stB;
    if (lowhalf) { const int c = tid + 512; gB = Kp + (rowbase + c / 12) * QP + head * 96 + (c % 12) * 8; lB = (c / 12) * KSTR + (c % 12) * 16; stB = (size_t)64 * QP; }
    else { const int c = tid - 256, row = c >> 3, part = c & 7; gB = V + (rowbase + row) * VP + head * 64 + part * 8; lB = KBUF + (part >> 2) * 4096 + row * 64 + (part & 3) * 16; stB = (size_t)64 * VP; }
    const bf16* gC; int lC;
    { const int c = tid + 256, row = c >> 3, part = c & 7; gC = V + (rowbase + row) * VP + head * 64 + part * 8; lC = KBUF + (part >> 2) * 4096 + row * 64 + (part & 3) * 16; }
    u32x4 ra, rb, rc = {0u, 0u, 0u, 0u};
    ra = *(const u32x4*)gA; rb = *(const u32x4*)gB; if (lowhalf) rc = *(const u32x4*)gC;
    *(LAS u32x4*)(lds + lA) = ra; *(LAS u32x4*)(lds + lB) = rb; if (lowhalf) *(LAS u32x4*)(lds + lC) = rc;
    __syncthreads();
    const int i16 = lane & 15, q4 = i16 >> 2, p4 = i16 & 3, blk = (lane >> 4) & 1;
    const int voff = (4 * h + q4) * 64 + blk * 32 + p4 * 8;
    const int qmin = q0 + 32 * w, qme = qmin + r;
    for (int t = 0; t < NT; ++t) {
        const int buf = (t & 1) * BUF, nbuf = BUF - buf;
        const bool more = (t + 1 < NT);
        if (more) {
            gA += (size_t)64 * QP; gB += stB; ra = *(const u32x4*)gA; rb = *(const u32x4*)gB;
            if (lowhalf) { gC += (size_t)64 * VP; rc = *(const u32x4*)gC; }
        }
        const int kmin = 64 * t;
        if (kmin <= qmin + 31) {
            f32x16 s0, s1;
#pragma unroll
            for (int i = 0; i < 16; ++i) { s0[i] = 0.f; s1[i] = 0.f; }
            const LAS unsigned char* kb = lds + buf + r * KSTR + h * 16;
#pragma unroll
            for (int st = 0; st < 6; ++st) {
                const bf16x8 a0 = *(const LAS bf16x8*)(kb + st * 32), a1 = *(const LAS bf16x8*)(kb + 32 * KSTR + st * 32);
                s0 = __builtin_amdgcn_mfma_f32_32x32x16_bf16(a0, qf[st], s0, 0, 0, 0);
                s1 = __builtin_amdgcn_mfma_f32_32x32x16_bf16(a1, qf[st], s1, 0, 0, 0);
            }
            if (kmin + 63 > qmin) {
#pragma unroll
                for (int i = 0; i < 16; ++i) { const int key = kmin + crow(i, h); if (key > qme) s0[i] = -INFINITY; if (key + 32 > qme) s1[i] = -INFINITY; }
            }
            float mx = fmaxf(s0[0], s1[0]);
#pragma unroll
            for (int i = 1; i < 16; ++i) mx = fmaxf(mx, fmaxf(s0[i], s1[i]));
            mx = fmaxf(mx, lane_xor(mx, lane, 32));
            const float mnew = fmaxf(mrun, mx);
            const float alpha = __builtin_amdgcn_exp2f(mrun - mnew);
            mrun = mnew;
            float sum = 0.f;
#pragma unroll
            for (int i = 0; i < 16; ++i) { s0[i] = __builtin_amdgcn_exp2f(s0[i] - mnew); s1[i] = __builtin_amdgcn_exp2f(s1[i] - mnew); sum += s0[i] + s1[i]; }
            lrun = lrun * alpha + sum;
#pragma unroll
            for (int i = 0; i < 16; ++i) { o0[i] *= alpha; o1[i] *= alpha; }
            bf16x8 pf[2][2];
#pragma unroll
            for (int s = 0; s < 2; ++s) {
                u32x4 a = {cvtpk(s0[8 * s], s0[8 * s + 1]), cvtpk(s0[8 * s + 2], s0[8 * s + 3]), cvtpk(s0[8 * s + 4], s0[8 * s + 5]), cvtpk(s0[8 * s + 6], s0[8 * s + 7])};
                u32x4 c = {cvtpk(s1[8 * s], s1[8 * s + 1]), cvtpk(s1[8 * s + 2], s1[8 * s + 3]), cvtpk(s1[8 * s + 4], s1[8 * s + 5]), cvtpk(s1[8 * s + 6], s1[8 * s + 7])};
                pf[0][s] = __builtin_bit_cast(bf16x8, a); pf[1][s] = __builtin_bit_cast(bf16x8, c);
            }
            const LAS unsigned char* vb = lds + buf + KBUF + voff;
#pragma unroll
            for (int kb2 = 0; kb2 < 2; ++kb2)
#pragma unroll
                for (int s = 0; s < 2; ++s) {
                    const LAS unsigned char* vp = vb + (32 * kb2 + 16 * s) * 64;
                    const s16x4 l0 = vtr(vp), h0 = vtr(vp + 8 * 64), l1 = vtr(vp + 4096), h1 = vtr(vp + 4096 + 8 * 64);
                    const bf16x8 v0 = __builtin_shufflevector(l0, h0, 0, 1, 2, 3, 4, 5, 6, 7), v1 = __builtin_shufflevector(l1, h1, 0, 1, 2, 3, 4, 5, 6, 7);
                    o0 = __builtin_amdgcn_mfma_f32_32x32x16_bf16(v0, pf[kb2][s], o0, 0, 0, 0);
                    o1 = __builtin_amdgcn_mfma_f32_32x32x16_bf16(v1, pf[kb2][s], o1, 0, 0, 0);
                }
        }
        if (more) { *(LAS u32x4*)(lds + nbuf + lA) = ra; *(LAS u32x4*)(lds + nbuf + lB) = rb; if (lowhalf) *(LAS u32x4*)(lds + nbuf + lC) = rc; }
        __syncthreads();
    }
    const float lt = lrun + lane_xor(lrun, lane, 32);
    const float inv = 1.0f / lt;
    const int ycol = (head < 6) ? head * 64 : 640 + (head - 6) * 64;
    bf16* yp = Y + (rowbase + qme) * D + ycol + 4 * h;
#pragma unroll
    for (int g = 0; g < 4; ++g) {
        *(u32x2*)(yp + 8 * g) = (u32x2){cvtpk(o0[4 * g] * inv, o0[4 * g + 1] * inv), cvtpk(o0[4 * g + 2] * inv, o0[4 * g + 3] * inv)};
        *(u32x2*)(yp + 32 + 8 * g) = (u32x2){cvtpk(o1[4 * g] * inv, o1[4 * g + 1] * inv), cvtpk(o1[4 * g + 2] * inv, o1[4 * g + 3] * inv)};
    }
}
}

constexpr int NPH = 2 + 12 * DEPTH;
#ifndef PH_EN
#define PH_EN 0xffff
#endif
#define EN(b) ((PH_EN >> (b)) & 1)
__global__ void __launch_bounds__(512, 2) mk_fwd(Args A_unused) {
    extern __shared__ __attribute__((aligned(16))) unsigned char lds_raw[];
    LAS unsigned char* lds = (LAS unsigned char*)lds_raw;
    cg::grid_group grid = cg::this_grid();
    const int ph_lo = A_unused.ph_lo, ph_hi = A_unused.ph_hi;
#define PHASE_ENTER() \
    CArgsP Ap = (CArgsP)__builtin_amdgcn_kernarg_segment_ptr(); asm volatile("" : "+s"(Ap)); \
    int tid = threadIdx.x; asm volatile("" : "+v"(tid)); \
    const int lane = tid & 63, wave = __builtin_amdgcn_readfirstlane(tid >> 6); \
    int bid = blockIdx.x, G = gridDim.x; asm volatile("" : "+s"(bid), "+s"(G)); \
    const int gw = bid * 8 + wave, NGW = G * 8; \
    unsigned char* ws = Ap->ws; asm volatile("" : "+s"(ws)); \
    unsigned char* wl = ws + WS_W + (size_t)l * WL_STRIDE; \
    int KD = D, KF = F, KQ = KQKV; asm volatile("" : "+s"(KD), "+s"(KF), "+s"(KQ)); \
    (void)lane; (void)gw; (void)NGW; (void)wl; (void)tid; (void)KD; (void)KF; (void)KQ;
    for (int ph = ph_lo; ph < ph_hi; ++ph) {
        int l = 0, k = -1;
        if (ph == 0) k = 12; else if (ph == NPH - 1) k = 13; else { l = (ph - 1) / 12; k = (ph - 1) % 12; }
        asm volatile("" : "+s"(k), "+s"(l));
        if (k == 12) {
            PHASE_ENTER();
            if (EN(12)) prologue(Ap, lds, gw, NGW, wave, lane);
        } else if (k == 13) {
            PHASE_ENTER();
            if (EN(0)) norm_phase(Ap->out, Ap->in[I_FINN], nullptr, Ap->out, gw, NGW, lane);
        } else if (EN(0) && (k == 0 || k == 3 || k == 9)) {
            PHASE_ENTER();
            const float* src = (l == 0 && k == 0) ? Ap->in[I_X] : Ap->out;
            const float* g = Ap->in[k == 0 ? I_F1N : (k == 3 ? I_MIXN : I_F2N)] + l * D;
            norm_phase(src, g, (bf16*)(ws + WS_XN), nullptr, gw, NGW, lane);
        } else if (EN(1) && (k == 1 || k == 10)) {
            PHASE_ENTER();
            pg8::Gemm g{(const bf16*)(ws + WS_XN), (const bf16*)(wl + (k == 1 ? WL_GU1 : WL_GU2)), M, NGU, KD}; pg8::StaticOrder S; S.init(M, NGU, G, bid);
            EpiSwiglu E{(bf16*)(ws + WS_BIG)};
            pg8::gemm_phase<EpiSwiglu, pg8::StaticOrder, true, true>(lds, g, S, E);
        } else if (EN(2) && (k == 2 || k == 11)) {
            PHASE_ENTER();
            pg8::Gemm g{(const bf16*)(ws + WS_BIG), (const bf16*)(wl + (k == 2 ? WL_DN1 : WL_DN2)), M, D, KF}; pg8::StaticOrder S; S.init(M, D, G, bid);
            EpiResid E{(l == 0 && k == 2) ? Ap->in[I_X] : Ap->out, Ap->out, 0.5f};
            pg8::gemm_phase<EpiResid, pg8::StaticOrder, true, true>(lds, g, S, E);
        } else if (EN(4) && k == 4) {
            PHASE_ENTER();
            pg8::Gemm g{(const bf16*)(ws + WS_XN), (const bf16*)(wl + WL_IN), M, NWIN, KD}; pg8::StaticOrder S; S.init(M, NWIN, G, bid);
            EpiWin E{(bf16*)(ws + WS_ZS), (bf16*)(ws + WS_U), (bf16*)(ws + WS_QP), (bf16*)(ws + WS_KP), (bf16*)(ws + WS_V), (float*)(ws + WS_FL)};
            pg8::gemm_phase<EpiWin, pg8::StaticOrder, true, true>(lds, g, S, E);
        } else if (EN(5) && k == 5) {
            PHASE_ENTER();
            prep_phase(Ap, l, lds, tid, wave, lane, bid, G);
        } else if (EN(6) && k == 6) {
            PHASE_ENTER();
            pg8::Gemm g{(const bf16*)(ws + WS_QKN), (const bf16*)(wl + WL_QKV), M, NQKV, KQ}; pg8::StaticOrder S; S.init(M, NQKV, G, bid);
            EpiQKV E{(bf16*)(ws + WS_QP), (bf16*)(ws + WS_KP), (bf16*)(ws + WS_V), (const float*)(ws + WS_ROPE)};
            pg8::gemm_phase<EpiQKV, pg8::StaticOrder, true, true>(lds, g, S, E);
        } else if (EN(7) && k == 7) {
            PHASE_ENTER();
            LAS unsigned* uw = (LAS unsigned*)(lds + LDS_MISC);
            unsigned* ctl = (unsigned*)(ws + WS_CTL);
            for (;;) {
                __syncthreads();
                if (tid == 0) uw[0] = atomicAdd(ctl + 64 * l, 1u);
                __syncthreads();
                const unsigned u = uw[0];
                if (u >= 768u) break;
                const int qb = 15 - (int)(u / 48u), bh = (int)(u % 48u);
                att::attn_unit(lds, (const bf16*)(ws + WS_QP), (const bf16*)(ws + WS_KP), (const bf16*)(ws + WS_V), (bf16*)(ws + WS_XN), bh / 12, bh % 12, qb, tid, wave, lane);
            }
        } else if (EN(8) && k == 8) {
            PHASE_ENTER();
            pg8::Gemm g{(const bf16*)(ws + WS_XN), (const bf16*)(wl + WL_OUT), M, D, KD}; pg8::StaticOrder S; S.init(M, D, G, bid);
            EpiResid E{Ap->out, Ap->out, 1.0f};
            pg8::gemm_phase<EpiResid, pg8::StaticOrder, true, true>(lds, g, S, E);
        }
        if (ph + 1 < ph_hi) grid.sync();
    }
}

extern "C" void kernel_launch(void* const* d_in, const int* in_sizes, int n_in, void* d_out, int out_size, void* d_ws, size_t ws_size, hipStream_t stream) {
    static int grid = 0;
    if (grid == 0) {
        if (n_in != 18 || out_size != M * D || ws_size < WS_END) { fprintf(stderr, "kernel_launch: unexpected problem (n_in %d out %d ws %zu need %zu)\n", n_in, out_size, ws_size, (size_t)WS_END); grid = -1; return; }
        int dev = 0, cus = 0, per_cu = 0;
        hipGetDevice(&dev); hipDeviceGetAttribute(&cus, hipDeviceAttributeMultiprocessorCount, dev);
        if (hipFuncSetAttribute((const void*)mk_fwd, hipFuncAttributeMaxDynamicSharedMemorySize, LDS_BYTES) != hipSuccess) { fprintf(stderr, "kernel_launch: hipFuncSetAttribute failed\n"); grid = -1; return; }
        if (hipOccupancyMaxActiveBlocksPerMultiprocessor(&per_cu, (const void*)mk_fwd, 512, LDS_BYTES) != hipSuccess || per_cu < 1) { fprintf(stderr, "kernel_launch: occupancy query says %d\n", per_cu); per_cu = 1; }
        (void)hipGetLastError();
        grid = cus * per_cu;
        fprintf(stderr, "kernel_launch: grid %d (cus %d x %d)\n", grid, cus, per_cu);
    }
    if (grid < 0) return;
    hipMemsetAsync((char*)d_ws + WS_CTL, 0, 4096, stream);
    Args a{};
    for (int i = 0; i < 18; ++i) a.in[i] = (const float*)d_in[i];
    a.out = (float*)d_out; a.ws = (unsigned char*)d_ws;
#if MK_MULTI
    for (int ph = 0; ph < NPH; ++ph) { a.ph_lo = ph; a.ph_hi = ph + 1; hipLaunchKernelGGL(mk_fwd, dim3(grid), dim3(512), LDS_BYTES, stream, a); }
#else
    a.ph_lo = 0; a.ph_hi = NPH;
    void* args[] = {&a};
    hipError_t e = hipLaunchCooperativeKernel((const void*)mk_fwd, dim3(grid), dim3(512), args, LDS_BYTES, stream);
    if (e != hipSuccess) fprintf(stderr, "kernel_launch: cooperative launch failed: %s (grid %d)\n", hipGetErrorString(e), grid);
#endif
}
```

```cpp
#include <hip/hip_runtime.h>
#include <hip/hip_cooperative_groups.h>
#include <cstdio>
#include <cstdint>
namespace cg = cooperative_groups;
#ifndef MK_MULTI
#define MK_MULTI 0
#endif
namespace pg8 {
#define PG8_LAS __attribute__((address_space(3)))
typedef unsigned short bf16_t;
typedef short bf16x8 __attribute__((ext_vector_type(8)));
typedef float f32x4 __attribute__((ext_vector_type(4)));
typedef unsigned u32x4 __attribute__((ext_vector_type(4)));
constexpr int BM = 256, BK = 64, HALF = 128, HTB = HALF * BK * 2  , STAGE_BYTES = 8 * HTB, NXCD = 8, WGM = 8;

__host__ __device__ __forceinline__ int lds_byte(int r, int c) { const int st = (r >> 4) * 2 + (c >> 5), rr = r & 15, cc = c & 31, ob = rr * 64 + cc * 2; return st * 1024 + (ob ^ (((ob >> 9) & 1) << 5)); }
__host__ __device__ __forceinline__ void stage_rc(int b, int& R, int& C) { const int st = b / 1024, sb = b % 1024, swz = sb ^ (((sb >> 9) & 1) << 5); R = (st >> 1) * 16 + swz / 64; C = (st & 1) * 32 + (swz % 64) / 2; }
__host__ __device__ __forceinline__ int perm32(int rho) { const int n = rho >> 4, i = rho & 15; return 8 * (i >> 2) + 4 * n + (i & 3); }

struct Unit { int pm, pn; };
struct Gemm { const bf16_t* A; const bf16_t* Bt; int M, N, K; };

struct StaticOrder {
    int nM, nN, nwg, G, c;
    __host__ __device__ void init(int M, int N, int G_, int c_) { nM = M / BM; nN = N / BM; nwg = nM * nN; G = G_; c = c_; }
    __host__ __device__ bool next(int i, Unit& u) const {
        const long L = (long)i * G + c; if (L >= nwg) return false;
        int wgid = (int)L; { const int q = nwg / NXCD, r = nwg % NXCD, xcd = wgid % NXCD, off = wgid / NXCD; wgid = (xcd < r ? xcd * (q + 1) : r * (q + 1) + (xcd - r) * q) + off; }
        const int nig = WGM * nN, gid = wgid / nig, fm = gid * WGM, gsz = (nM - fm) < WGM ? (nM - fm) : WGM;
        u.pm = fm + ((wgid % nig) % gsz); u.pn = (wgid % nig) / gsz; return true;
    }
    __device__ __forceinline__ void a_ready(const Unit&) const {}
    __device__ __forceinline__ void done(const Unit&) const {}
};
typedef float f32x2 __attribute__((ext_vector_type(2)));
template <class Epi, class Sched, bool ALIGN_EPI = false, bool SP2 = false>
__device__ __forceinline__ void gemm_phase(PG8_LAS unsigned char* lds, const Gemm g, const Sched& S, const Epi& E) {
    int tid = threadIdx.x; asm volatile("" : "+v"(tid)); const int wid = __builtin_amdgcn_readfirstlane(tid >> 6), lane = tid & 63, wr = wid >> 2, wc = wid & 3, fr = lane & 15, fq = lane >> 4;
    const int K = g.K, nt = K / BK;
    unsigned voffA[2], voffB[2];
#pragma unroll
    for (int i = 0; i < 2; ++i) { int R, C; stage_rc(tid * 16 + i * 8192, R, C); const int Rb = Epi::PERM ? ((R & ~31) + perm32(R & 31)) : R;
        voffA[i] = (unsigned)(R * K + C) * 2u; voffB[i] = (unsigned)(Rb * K + C) * 2u; }
    const size_t kstep = (size_t)(BK * 2);
    const size_t hstep = (size_t)HALF * K * 2;
    const size_t tstep = 2 * hstep;
    const unsigned ldsw = (unsigned)wid * 1024u;
    const int aoff = lds_byte(wr * 64 + fr, fq * 8), boff = lds_byte(wc * 32 + fr, fq * 8);
#define PG8_SA(b, h) (((b) * 2 + (h)) * HTB)
#define PG8_SB(b, h) ((4 + (b) * 2 + (h)) * HTB)
#define PG8_STAGE(bufoff, gbase, voff) do { _Pragma("unroll") for (int _i = 0; _i < 2; ++_i) \
        __builtin_amdgcn_global_load_lds((const unsigned*)((const char*)(gbase) + (voff)[_i]), (PG8_LAS unsigned*)(lds + (bufoff) + ldsw + _i * 8192), 16, 0, 0); } while (0)
#define PG8_LDA(dst, b, h) do { _Pragma("unroll") for (int m = 0; m < 4; ++m) _Pragma("unroll") for (int k = 0; k < 2; ++k) dst[m][k] = *(const PG8_LAS bf16x8*)(lds + PG8_SA(b, h) + aoff + m * 2048 + k * 1024); } while (0)
#define PG8_LDB(dst, b, h) do { _Pragma("unroll") for (int n = 0; n < 2; ++n) _Pragma("unroll") for (int k = 0; k < 2; ++k) dst[n][k] = *(const PG8_LAS bf16x8*)(lds + PG8_SB(b, h) + boff + n * 2048 + k * 1024); } while (0)
#define PG8_MMA(ai, bj, At, Bt) do { __builtin_amdgcn_s_setprio(1); _Pragma("unroll") for (int m = 0; m < 4; ++m) _Pragma("unroll") for (int n = 0; n < 2; ++n) _Pragma("unroll") for (int k = 0; k < 2; ++k) \
        acc[ai][bj][m][n] = __builtin_amdgcn_mfma_f32_16x16x32_bf16(Bt[n][k], At[m][k], acc[ai][bj][m][n], 0, 0, 0); __builtin_amdgcn_s_setprio(0); } while (0)
#define PG8_WAIT_V(n) asm volatile("s_waitcnt vmcnt(" #n ")" ::: "memory")
#define PG8_WAIT_L(n) asm volatile("s_waitcnt lgkmcnt(" #n ")" ::: "memory")
#define PG8_BAR __builtin_amdgcn_s_barrier()
#define PG8_SCHED __builtin_amdgcn_sched_barrier(0)
    Unit cur, nxt; int ui = 0;
    if (!S.next(0, cur)) return;
    f32x4 acc[2][2][4][2];
#pragma unroll
    for (int a = 0; a < 2; ++a)
#pragma unroll
        for (int b = 0; b < 2; ++b)
#pragma unroll
            for (int m = 0; m < 4; ++m)
#pragma unroll
                for (int n = 0; n < 2; ++n) acc[a][b][m][n] = (f32x4){0.f, 0.f, 0.f, 0.f};
    bf16x8 At[4][2], B0[2][2], B1[2][2];
    const char* cA = (const char*)g.A + (size_t)cur.pm * tstep; const char* cB = (const char*)g.Bt + (size_t)cur.pn * tstep;
    S.a_ready(cur);
    if constexpr (SP2) {
        PG8_STAGE(PG8_SB(0, 0), cB, voffB); PG8_STAGE(PG8_SB(0, 1), cB + hstep, voffB); PG8_STAGE(PG8_SA(0, 0), cA, voffA); PG8_STAGE(PG8_SA(0, 1), cA + hstep, voffA);
        if (wr == 1) PG8_BAR;
        PG8_WAIT_V(2); PG8_BAR;
        PG8_STAGE(PG8_SB(1, 0), cB + kstep, voffB); PG8_STAGE(PG8_SA(1, 0), cA + kstep, voffA); PG8_STAGE(PG8_SB(1, 1), cB + hstep + kstep, voffB);
        PG8_WAIT_V(6); PG8_BAR;
    } else {
        PG8_STAGE(PG8_SB(0, 0), cB, voffB); PG8_STAGE(PG8_SA(0, 0), cA, voffA); PG8_STAGE(PG8_SB(0, 1), cB + hstep, voffB); PG8_STAGE(PG8_SA(0, 1), cA + hstep, voffA);
        if (wr == 1) PG8_BAR;
        PG8_WAIT_V(4); PG8_BAR;
        PG8_STAGE(PG8_SB(1, 0), cB + kstep, voffB); PG8_STAGE(PG8_SA(1, 0), cA + kstep, voffA); PG8_STAGE(PG8_SB(1, 1), cB + hstep + kstep, voffB);
        PG8_WAIT_V(6); PG8_BAR;
    }
    for (;;) {
        const bool has_next = S.next(ui + 1, nxt);
        const char* nA = has_next ? (const char*)g.A + (size_t)nxt.pm * tstep : cA; const char* nB = has_next ? (const char*)g.Bt + (size_t)nxt.pn * tstep : cB;
        for (int t = 0; t < nt; t += 2) {
            const bool last = (t == nt - 2);
            const char* a1 = cA + (size_t)(t + 1) * kstep;
            const char* a2 = last ? nA : cA + (size_t)(t + 2) * kstep; const char* b2 = last ? nB : cB + (size_t)(t + 2) * kstep;
            const char* a3 = a2 + kstep; const char* b3 = b2 + kstep;
            if (last && has_next) S.a_ready(nxt);
            if constexpr (SP2) {
            PG8_LDB(B0, 0, 0); PG8_LDB(B1, 0, 1); PG8_SCHED; PG8_LDA(At, 0, 0); PG8_STAGE(PG8_SA(1, 1), a1 + hstep, voffA);
            PG8_WAIT_V(8); PG8_WAIT_L(0); PG8_BAR; PG8_MMA(0, 0, At, B0); PG8_MMA(0, 1, At, B1); PG8_BAR; PG8_SCHED;
            PG8_LDA(At, 0, 1); PG8_STAGE(PG8_SB(0, 0), b2, voffB); PG8_STAGE(PG8_SB(0, 1), b2 + hstep, voffB); PG8_STAGE(PG8_SA(0, 0), a2, voffA);
            PG8_WAIT_V(8); PG8_WAIT_L(0); PG8_BAR; PG8_MMA(1, 0, At, B0); PG8_MMA(1, 1, At, B1); PG8_BAR; PG8_SCHED;
            PG8_LDB(B0, 1, 0); PG8_LDB(B1, 1, 1); PG8_SCHED; PG8_LDA(At, 1, 0); PG8_STAGE(PG8_SA(0, 1), a2 + hstep, voffA);
            PG8_WAIT_V(8); PG8_WAIT_L(0); PG8_BAR; PG8_MMA(0, 0, At, B0); PG8_MMA(0, 1, At, B1); PG8_BAR; PG8_SCHED;
            PG8_LDA(At, 1, 1); PG8_STAGE(PG8_SB(1, 0), b3, voffB); PG8_STAGE(PG8_SB(1, 1), b3 + hstep, voffB); PG8_STAGE(PG8_SA(1, 0), a3, voffA);
            PG8_WAIT_V(8); PG8_WAIT_L(0); PG8_BAR; PG8_MMA(1, 0, At, B0); PG8_MMA(1, 1, At, B1); PG8_BAR; PG8_SCHED;
            } else {
            PG8_LDB(B0, 0, 0); PG8_SCHED; PG8_LDA(At, 0, 0); PG8_STAGE(PG8_SA(1, 1), a1 + hstep, voffA);
            PG8_WAIT_L(8); PG8_BAR; PG8_WAIT_L(0); PG8_MMA(0, 0, At, B0); PG8_BAR; PG8_SCHED;
            PG8_LDB(B1, 0, 1); PG8_STAGE(PG8_SB(0, 0), b2, voffB);
            PG8_BAR; PG8_WAIT_L(0); PG8_MMA(0, 1, At, B1); PG8_BAR;
            PG8_LDA(At, 0, 1); PG8_STAGE(PG8_SA(0, 0), a2, voffA);
            PG8_BAR; PG8_WAIT_L(0); PG8_MMA(1, 0, At, B0); PG8_BAR; PG8_SCHED;
            PG8_STAGE(PG8_SB(0, 1), b2 + hstep, voffB);
            PG8_WAIT_V(6); PG8_BAR; PG8_MMA(1, 1, At, B1); PG8_BAR;
            PG8_LDB(B0, 1, 0); PG8_SCHED; PG8_LDA(At, 1, 0); PG8_STAGE(PG8_SA(0, 1), a2 + hstep, voffA);
            PG8_WAIT_L(8); PG8_BAR; PG8_WAIT_L(0); PG8_MMA(0, 0, At, B0); PG8_BAR; PG8_SCHED;
            PG8_LDB(B1, 1, 1); PG8_STAGE(PG8_SB(1, 0), b3, voffB);
            PG8_BAR; PG8_WAIT_L(0); PG8_MMA(0, 1, At, B1); PG8_BAR;
            PG8_LDA(At, 1, 1); PG8_STAGE(PG8_SA(1, 0), a3, voffA);
            PG8_BAR; PG8_WAIT_L(0); PG8_MMA(1, 0, At, B0); PG8_BAR; PG8_SCHED;
            PG8_STAGE(PG8_SB(1, 1), b3 + hstep, voffB);
            PG8_WAIT_V(6); PG8_BAR; PG8_MMA(1, 1, At, B1); PG8_BAR;
            }
        }
        if constexpr (ALIGN_EPI) { if (wr == 0) PG8_BAR; }
        if constexpr (!Epi::AFTER_DRAIN) { E(acc, cur, wr, wc, fr, fq); S.done(cur); }
        if (!has_next) break;
#pragma unroll
        for (int a = 0; a < 2; ++a)
#pragma unroll
            for (int b = 0; b < 2; ++b)
#pragma unroll
                for (int m = 0; m < 4; ++m)
#pragma unroll
                    for (int n = 0; n < 2; ++n) acc[a][b][m][n] = (f32x4){0.f, 0.f, 0.f, 0.f};
        cur = nxt; cA = nA; cB = nB; ++ui;
        if constexpr (ALIGN_EPI) { if (wr == 1) PG8_BAR; }
    }
    PG8_WAIT_V(0);
    if constexpr (!ALIGN_EPI) { if (wr == 0) PG8_BAR; }
    PG8_BAR;
    if constexpr (Epi::AFTER_DRAIN) { E.fused(acc, cur, wr, wc, fr, fq, lds, wid, lane); S.done(cur); }
#undef PG8_SA
#undef PG8_SB
#undef PG8_STAGE
#undef PG8_LDA
#undef PG8_LDB
#undef PG8_MMA
#undef PG8_WAIT_V
#undef PG8_WAIT_L
#undef PG8_BAR
#undef PG8_SCHED
}
}

constexpr int M = 16384, SEQ = 4096, NB = 4, D = 1024, F = 2816, DEPTH = 2;
constexpr int N_IN = 1830;
constexpr int NGU = 2 * F;
constexpr int NWIN = 2048;
constexpr int NQKV = 1536, KQKV = 384;
constexpr int QP = 1152, VP = 768;
constexpr float EPS = 1e-6f;
constexpr float LOG2E = 1.4426950408889634f;
constexpr float QS_MLA = 0.14724444f;
constexpr float QS_FOX = 0.18033688f;

constexpr size_t MiB = 1u << 20;
constexpr size_t WS_CTL = 0;
constexpr int CW_BAR = 4096;
constexpr size_t WS_ROPE = 1 * MiB;
constexpr size_t WS_FL = 1 * MiB + 512 * 1024;
constexpr size_t WS_W = 2 * MiB;
constexpr size_t WL_GU1 = 0, WL_GU2 = 11 * MiB, WL_DN1 = 22 * MiB, WL_DN2 = 22 * MiB + 5632 * 1024, WL_IN = 33 * MiB, WL_OUT = 37 * MiB, WL_QKV = 39 * MiB;
constexpr size_t WL_STRIDE = 41 * MiB;
constexpr size_t WS_XN = 84 * MiB;
constexpr size_t WS_BIG = 116 * MiB;
constexpr size_t WS_ZS = WS_BIG, WS_U = WS_BIG + 16 * MiB, WS_QKN = WS_BIG + 24 * MiB, WS_QP = WS_BIG + 36 * MiB, WS_KP = WS_BIG + 72 * MiB, WS_V = WS_BIG + 108 * MiB;
constexpr size_t WS_END = WS_BIG + 132 * MiB;
static_assert(WL_QKV + (size_t)NQKV * KQKV * 2 <= WL_STRIDE && WS_W + 2 * WL_STRIDE <= WS_XN, "weights map");
static_assert(WS_QKN + (size_t)M * KQKV * 2 <= WS_QP && WS_V + (size_t)M * VP * 2 <= WS_END && WS_BIG + (size_t)M * F * 2 <= WS_END + 0 * MiB + 0, "act map");

constexpr int LDS_BYTES = 147456;
constexpr int LDS_MISC = 131072 + 4096;

#define LAS __attribute__((address_space(3)))
typedef unsigned short bf16;
typedef float f32x4 __attribute__((ext_vector_type(4)));
typedef float f32x2 __attribute__((ext_vector_type(2)));
typedef float f32x16 __attribute__((ext_vector_type(16)));
typedef unsigned u32x4 __attribute__((ext_vector_type(4)));
typedef unsigned u32x2 __attribute__((ext_vector_type(2)));
typedef short bf16x8 __attribute__((ext_vector_type(8)));
typedef short s16x4 __attribute__((ext_vector_type(4)));
typedef __bf16 bf16x2_t __attribute__((ext_vector_type(2)));

__device__ __forceinline__ unsigned cvtpk(float lo, float hi) { f32x2 v = {lo, hi}; bf16x2_t b = __builtin_convertvector(v, bf16x2_t); return __builtin_bit_cast(unsigned, b); }
__device__ __forceinline__ unsigned f2bf(float f) { unsigned u = __builtin_bit_cast(unsigned, f); return (u + 0x7fffu + ((u >> 16) & 1u)) >> 16; }
__device__ __forceinline__ float bf2f(unsigned b) { return __builtin_bit_cast(float, b << 16); }
__device__ __forceinline__ float lane_xor(float v, int lane, int o) { return __builtin_bit_cast(float, __builtin_amdgcn_ds_bpermute((lane ^ o) << 2, __builtin_bit_cast(int, v))); }
__device__ __forceinline__ float wave_sum(float v, int lane) {
#pragma unroll
    for (int o = 1; o < 64; o <<= 1) v += lane_xor(v, lane, o);
    return v;
}
__device__ __forceinline__ void store8(bf16* p, f32x4 a, f32x4 b) { u32x4 w; w.x = cvtpk(a[0], a[1]); w.y = cvtpk(a[2], a[3]); w.z = cvtpk(b[0], b[1]); w.w = cvtpk(b[2], b[3]); *(u32x4*)p = w; }

struct EpiSwiglu {
    static constexpr bool PERM = true, AFTER_DRAIN = false;
    bf16* O;
    __device__ __forceinline__ void operator()(const pg8::f32x4 (&acc)[2][2][4][2], const pg8::Unit& u, int wr, int wc, int fr, int fq) const {
        asm volatile("" : "+v"(fr), "+v"(fq));
        const int row0 = u.pm * 256 + wr * 64 + fr, col0 = u.pn * 128 + wc * 32 + 8 * fq;
#pragma unroll
        for (int ai = 0; ai < 2; ++ai)
#pragma unroll
            for (int m = 0; m < 4; ++m) {
                bf16* rowp = O + (size_t)(row0 + ai * 128 + m * 16) * F + col0;
                f32x4 r[2];
#pragma unroll
                for (int n = 0; n < 2; ++n) {
                    const f32x4 g = acc[ai][0][m][n], uu = acc[ai][1][m][n];
#pragma unroll
                    for (int j = 0; j < 4; ++j) { const float e = __builtin_amdgcn_exp2f(-g[j] * LOG2E); r[n][j] = g[j] * __builtin_amdgcn_rcpf(1.0f + e) * uu[j]; }
                }
                store8(rowp, r[0], r[1]);
            }
    }
};
struct EpiResid {
    static constexpr bool PERM = false, AFTER_DRAIN = false;
    const float* base; float* out; float scale;
    __device__ __forceinline__ void operator()(const pg8::f32x4 (&acc)[2][2][4][2], const pg8::Unit& u, int wr, int wc, int fr, int fq) const {
        asm volatile("" : "+v"(fr), "+v"(fq));
        const int row0 = u.pm * 256 + wr * 64 + fr, col0 = u.pn * 256 + wc * 32 + 4 * fq;
#pragma unroll
        for (int ai = 0; ai < 2; ++ai)
#pragma unroll
            for (int m = 0; m < 4; ++m) {
                const size_t off = (size_t)(row0 + ai * 128 + m * 16) * D + col0;
#pragma unroll
                for (int bj = 0; bj < 2; ++bj)
#pragma unroll
                    for (int n = 0; n < 2; ++n) { const size_t p = off + bj * 128 + n * 16; const f32x4 b = *(const f32x4*)(base + p); *(f32x4*)(out + p) = b + acc[ai][bj][m][n] * scale; }
                asm volatile("" ::: "memory");
            }
    }
};
struct EpiWin {
    static constexpr bool PERM = true, AFTER_DRAIN = false;
    bf16 *Zs, *U, *Qp, *Kp, *V; float* Fl;
    __device__ __forceinline__ void operator()(const pg8::f32x4 (&acc)[2][2][4][2], const pg8::Unit& u, int wr, int wc, int fr, int fq) const {
        asm volatile("" : "+v"(fr), "+v"(fq));
        const int row0 = u.pm * 256 + wr * 64 + fr;
#pragma unroll
        for (int bj = 0; bj < 2; ++bj) {
            const int c0 = u.pn * 256 + bj * 128 + wc * 32 + 8 * fq;
            bf16* dst; int pitch; float sc = 1.0f; bool f32too = false;
            if (c0 < 512) { dst = Zs + c0; pitch = 512; f32too = (c0 == 416); }
            else if (c0 < 768) { dst = U + (c0 - 512); pitch = 256; }
            else if (c0 < 1920) {
                const int e = c0 - 768, seg = e / 384, w = e - seg * 384, hh = w >> 6, d = w & 63;
                if (seg == 0) { dst = Qp + (6 + hh) * 96 + d; pitch = QP; sc = QS_FOX; }
                else if (seg == 1) { dst = Kp + (6 + hh) * 96 + d; pitch = QP; }
                else { dst = V + (6 + hh) * 64 + d; pitch = VP; }
            } else continue;
#pragma unroll
            for (int ai = 0; ai < 2; ++ai)
#pragma unroll
                for (int m = 0; m < 4; ++m) {
                    const int row = row0 + ai * 128 + m * 16;
                    store8(dst + (size_t)row * pitch, acc[ai][bj][m][0] * sc, acc[ai][bj][m][1] * sc);
                    if (f32too) { *(f32x4*)(Fl + (size_t)row * 8) = acc[ai][bj][m][0]; *(f32x4*)(Fl + (size_t)row * 8 + 4) = acc[ai][bj][m][1]; }
                }
        }
    }
};
struct EpiQKV {
    static constexpr bool PERM = true, AFTER_DRAIN = false;
    bf16 *Qp, *Kp, *V; const float* rope;
    __device__ __forceinline__ void operator()(const pg8::f32x4 (&acc)[2][2][4][2], const pg8::Unit& u, int wr, int wc, int fr, int fq) const {
        asm volatile("" : "+v"(fr), "+v"(fq));
        const int row0 = u.pm * 256 + wr * 64 + fr;
#pragma unroll
        for (int bj = 0; bj < 2; ++bj) {
            const int c0 = u.pn * 256 + bj * 128 + wc * 32 + 8 * fq;
            if (c0 < 576) {
                const int head = c0 / 96, d = c0 - head * 96;
                bf16* dst = Qp + head * 96 + d;
                if (d < 64) {
#pragma unroll
                    for (int ai = 0; ai < 2; ++ai)
#pragma unroll
                        for (int m = 0; m < 4; ++m) { const int row = row0 + ai * 128 + m * 16; store8(dst + (size_t)row * QP, acc[ai][bj][m][0] * QS_MLA, acc[ai][bj][m][1] * QS_MLA); }
                } else {
                    const int a = (d - 64) >> 3;
#pragma unroll
                    for (int ai = 0; ai < 2; ++ai)
#pragma unroll
                        for (int m = 0; m < 4; ++m) {
                            const int row = row0 + ai * 128 + m * 16, pos = row & (SEQ - 1);
                            const f32x4 t0 = *(const f32x4*)(rope + (size_t)(pos * 16 + 4 * a) * 2), t1 = *(const f32x4*)(rope + (size_t)(pos * 16 + 4 * a) * 2 + 4);
                            const f32x4 x = acc[ai][bj][m][0], y = acc[ai][bj][m][1];
                            f32x4 ox, oy;
                            ox[0] = x[0] * t0[0] - x[1] * t0[1]; ox[1] = x[1] * t0[0] + x[0] * t0[1]; ox[2] = x[2] * t0[2] - x[3] * t0[3]; ox[3] = x[3] * t0[2] + x[2] * t0[3];
                            oy[0] = y[0] * t1[0] - y[1] * t1[1]; oy[1] = y[1] * t1[0] + y[0] * t1[1]; oy[2] = y[2] * t1[2] - y[3] * t1[3]; oy[3] = y[3] * t1[2] + y[2] * t1[3];
                            store8(dst + (size_t)row * QP, ox * QS_MLA, oy * QS_MLA);
                            asm volatile("" ::: "memory");
                        }
                }
            } else if (c0 < 1344) {
                const int e = c0 - 576, head = e >> 7, d = e & 127;
                bf16* dst; int pitch;
                if (d < 64) { dst = Kp + head * 96 + d; pitch = QP; } else { dst = V + head * 64 + (d - 64); pitch = VP; }
#pragma unroll
                for (int ai = 0; ai < 2; ++ai)
#pragma unroll
                    for (int m = 0; m < 4; ++m) { const int row = row0 + ai * 128 + m * 16; store8(dst + (size_t)row * pitch, acc[ai][bj][m][0], acc[ai][bj][m][1]); }
            }
        }
    }
};

struct Args {
    const float* in[18];
    float* out; unsigned char* ws;
    int ph_lo, ph_hi;
};
typedef const __attribute__((address_space(4))) Args* CArgsP;
enum { I_X = 0, I_F1N, I_F1GU, I_F1DN, I_MIXN, I_WIN, I_QAN, I_WQB, I_KVAN, I_WKVB, I_POOLW, I_POOLS, I_FOXB, I_WOUT, I_F2N, I_F2GU, I_F2DN, I_FINN };

__device__ __forceinline__ void conv_item(const float* W, int Nsrc, int Ksrc, int sc, int koff, bf16* WT, int Kdst, int k0, int n0, LAS float* scr, int lane) {
#pragma unroll 8
    for (int i = 0; i < 32; ++i) {
        const int kk = 2 * i + (lane >> 5), ks = k0 + kk - koff;
        float v = 0.f;
        if (sc >= 0 && ks >= 0 && ks < Ksrc) v = W[(size_t)ks * Nsrc + sc];
        scr[kk * 33 + (lane & 31)] = v;
    }
    asm volatile("s_waitcnt lgkmcnt(0)" ::: "memory");
    const int c = lane & 7;
#pragma unroll
    for (int j = 0; j < 4; ++j) {
        const int n = (lane >> 3) + 8 * j; const LAS float* s = scr + (8 * c) * 33 + n;
        u32x4 o; o.x = cvtpk(s[0 * 33], s[1 * 33]); o.y = cvtpk(s[2 * 33], s[3 * 33]); o.z = cvtpk(s[4 * 33], s[5 * 33]); o.w = cvtpk(s[6 * 33], s[7 * 33]);
        *(u32x4*)(WT + (size_t)(n0 + n) * Kdst + k0 + 8 * c) = o;
    }
    asm volatile("s_waitcnt lgkmcnt(0)" ::: "memory");
}
constexpr int IT_GU = 16 * (NGU / 32), IT_DN = (F / 64) * (D / 32), IT_IN = 16 * (NWIN / 32), IT_QKV = (KQKV / 64) * (NQKV / 32), IT_OUT = 16 * (D / 32);
constexpr int IT_LAYER = 2 * IT_GU + 2 * IT_DN + IT_IN + IT_QKV + IT_OUT;

__device__ __forceinline__ void prologue(CArgsP Ap, LAS unsigned char* lds, int gw, int NGW, int wave, int lane) {
    LAS float* scr = (LAS float*)(lds + wave * 16384);
    unsigned char* ws = Ap->ws;
    for (int it = gw; it < DEPTH * IT_LAYER; it += NGW) {
        const int l = it / IT_LAYER; int r = it - l * IT_LAYER;
        unsigned char* wl = ws + WS_W + (size_t)l * WL_STRIDE;
        const int nl = lane & 31;
        if (r < 2 * IT_GU) {
            const int f = r / IT_GU; r -= f * IT_GU;
            const float* W = Ap->in[f ? I_F2GU : I_F1GU] + (size_t)l * D * NGU;
            const int nblk = NGU / 32, kb = r / nblk, nb = r - kb * nblk, n = nb * 32 + nl, tile = n >> 8, w = n & 255;
            const int sc = (w < 128) ? tile * 128 + w : F + tile * 128 + (w - 128);
            conv_item(W, NGU, D, sc, 0, (bf16*)(wl + (f ? WL_GU2 : WL_GU1)), D, kb * 64, nb * 32, scr, lane);
            continue;
        }
        r -= 2 * IT_GU;
        if (r < 2 * IT_DN) {
            const int f = r / IT_DN; r -= f * IT_DN;
            const float* W = Ap->in[f ? I_F2DN : I_F1DN] + (size_t)l * F * D;
            const int nblk = D / 32, kb = r / nblk, nb = r - kb * nblk;
            conv_item(W, D, F, nb * 32 + nl, 0, (bf16*)(wl + (f ? WL_DN2 : WL_DN1)), F, kb * 64, nb * 32, scr, lane);
            continue;
        }
        r -= 2 * IT_DN;
        if (r < IT_IN) {
            const float* W = Ap->in[I_WIN] + (size_t)l * D * N_IN;
            const int nblk = NWIN / 32, kb = r / nblk, nb = r - kb * nblk, n = nb * 32 + nl;
            int sc = -1;
            if (n < 416) sc = n; else if (n < 422) sc = 1824 + (n - 416); else if (n < 512) sc = -1; else if (n < 768) sc = 416 + (n - 512); else if (n < 1920) sc = 672 + (n - 768);
            conv_item(W, N_IN, D, sc, 0, (bf16*)(wl + WL_IN), D, kb * 64, nb * 32, scr, lane);
            continue;
        }
        r -= IT_IN;
        if (r < IT_QKV) {
            const int nblk = NQKV / 32, kb = r / nblk, nb = r - kb * nblk, n = nb * 32 + nl;
            if (n < 576) {
                const int head = n / 96, d = n - head * 96; int sd = d;
                if (d >= 64) { const int j2 = d - 64; sd = 64 + (j2 >> 1) + 16 * (j2 & 1); }
                conv_item(Ap->in[I_WQB] + (size_t)l * 256 * 576, 576, 256, head * 96 + sd, 0, (bf16*)(wl + WL_QKV), KQKV, kb * 64, nb * 32, scr, lane);
            } else {
                const int sc = (n < 1344) ? n - 576 : -1;
                conv_item(Ap->in[I_WKVB] + (size_t)l * 128 * 768, 768, 128, sc, 256, (bf16*)(wl + WL_QKV), KQKV, kb * 64, nb * 32, scr, lane);
            }
            continue;
        }
        r -= IT_QKV;
        {
            const float* W = Ap->in[I_WOUT] + (size_t)l * D * D;
            const int nblk = D / 32, kb = r / nblk, nb = r - kb * nblk;
            conv_item(W, D, D, nb * 32 + nl, 0, (bf16*)(wl + WL_OUT), D, kb * 64, nb * 32, scr, lane);
        }
    }
    float* T = (float*)(ws + WS_ROPE);
    for (int e = gw * 64 + lane; e < SEQ * 16; e += NGW * 64) {
        const int pos = e >> 4, j = e & 15;
        const float inv = exp2f(-(float)j * 0.8304820237218405f);
        const float ang = (float)pos * inv;
        const double a = (double)ang, k = __builtin_rint(a * 0.15915494309189535), x = a - k * 6.283185307179586, x2 = x * x;
        double s = x, c = 1.0, ts = x, tc = 1.0;
#pragma unroll 1
        for (int i = 1; i <= 12; ++i) {
            tc = -tc * x2 / (double)((2 * i - 1) * (2 * i)); c += tc;
            ts = -ts * x2 / (double)((2 * i) * (2 * i + 1)); s += ts;
        }
        *(f32x2*)(T + (size_t)e * 2) = (f32x2){(float)c, (float)s};
    }
}

__device__ __forceinline__ void norm_phase(const float* x, const float* g, bf16* xn, float* fout, int gw, int NGW, int lane) {
    f32x4 gv[4];
#pragma unroll
    for (int j = 0; j < 4; ++j) gv[j] = *((const f32x4*)g + lane + 64 * j);
    for (int row = gw; row < M; row += NGW) {
        const f32x4* xr = (const f32x4*)(x + (size_t)row * D) + lane;
        f32x4 v[4]; float s = 0.f;
#pragma unroll
        for (int j = 0; j < 4; ++j) { v[j] = xr[64 * j]; s += (v[j][0] * v[j][0] + v[j][1] * v[j][1]) + (v[j][2] * v[j][2] + v[j][3] * v[j][3]); }
        const float rstd = 1.0f / sqrtf(wave_sum(s, lane) * (1.0f / D) + EPS);
        if (fout) {
            f32x4* o = (f32x4*)(fout + (size_t)row * D) + lane;
#pragma unroll
            for (int j = 0; j < 4; ++j) o[64 * j] = (v[j] * rstd) * gv[j];
        } else {
            u32x2* o = (u32x2*)(xn + (size_t)row * D) + lane;
#pragma unroll
            for (int j = 0; j < 4; ++j) { const f32x4 y = (v[j] * rstd) * gv[j]; o[64 * j] = (u32x2){cvtpk(y[0], y[1]), cvtpk(y[2], y[3])}; }
        }
    }
}

__device__ __forceinline__ void prep_phase(CArgsP Ap, int l, LAS unsigned char* lds, int tid, int wave, int lane, int bid, int G) {
    unsigned char* ws = Ap->ws;
    const bf16* Zs = (const bf16*)(ws + WS_ZS); const bf16* U = (const bf16*)(ws + WS_U);
    bf16* QKn = (bf16*)(ws + WS_QKN); bf16* Qp = (bf16*)(ws + WS_QP); bf16* Kp = (bf16*)(ws + WS_KP); bf16* Y = (bf16*)(ws + WS_XN);
    const float* T = (const float*)(ws + WS_ROPE); const float* Fl = (const float*)(ws + WS_FL);
    const float* qg = Ap->in[I_QAN] + l * 256; const float* kg = Ap->in[I_KVAN] + l * 128;
    const float* pw = Ap->in[I_POOLW] + (size_t)l * 4 * 4096; const float* ps = Ap->in[I_POOLS] + l * 256;
    const float* fb = Ap->in[I_FOXB] + l * 6;
    LAS float* Uw = (LAS float*)lds;
    LAS float* Wg = (LAS float*)(lds + 20480);
    LAS float* Pp = (LAS float*)(lds + 20480 + 16384);
    LAS double* Sd = (LAS double*)(lds + 65536);
    for (int tile = bid; tile < M / 64; tile += G) {
        const int r0 = tile * 64, tloc0 = r0 & (SEQ - 1);
        for (int i = 0; i < 8; ++i) {
            const int row = r0 + wave * 8 + i, pos = row & (SEQ - 1);
            const bf16* z = Zs + (size_t)row * 512;
            const u32x2 qa = *(const u32x2*)(z + 4 * lane); const unsigned ka = *(const unsigned*)(z + 256 + 2 * lane);
            float q0 = bf2f(qa.x & 0xffffu), q1 = bf2f(qa.x >> 16), q2 = bf2f(qa.y & 0xffffu), q3 = bf2f(qa.y >> 16);
            float k0 = bf2f(ka & 0xffffu), k1 = bf2f(ka >> 16);
            const float sq = wave_sum((q0 * q0 + q1 * q1) + (q2 * q2 + q3 * q3), lane), sk = wave_sum(k0 * k0 + k1 * k1, lane);
            const float rq = 1.0f / sqrtf(sq * (1.0f / 256.0f) + EPS), rk = 1.0f / sqrtf(sk * (1.0f / 128.0f) + EPS);
            const f32x4 g4 = *(const f32x4*)(qg + 4 * lane); const f32x2 g2 = *(const f32x2*)(kg + 2 * lane);
            bf16* o = QKn + (size_t)row * KQKV;
            *(u32x2*)(o + 4 * lane) = (u32x2){cvtpk(q0 * rq * g4[0], q1 * rq * g4[1]), cvtpk(q2 * rq * g4[2], q3 * rq * g4[3])};
            *(unsigned*)(o + 256 + 2 * lane) = cvtpk(k0 * rk * g2[0], k1 * rk * g2[1]);
            if (lane < 16) {
                const float x1 = bf2f(z[384 + lane]), x2 = bf2f(z[400 + lane]);
                const f32x2 cs = *(const f32x2*)(T + (size_t)(pos * 16 + lane) * 2);
                const unsigned pk = cvtpk(x1 * cs[0] - x2 * cs[1], x2 * cs[0] + x1 * cs[1]);
                bf16* kp = Kp + (size_t)row * QP + 64 + 2 * lane;
#pragma unroll
                for (int hh = 0; hh < 6; ++hh) *(unsigned*)(kp + hh * 96) = pk;
            }
        }
        for (int g = 0; g < 4; ++g) {
            __syncthreads();
            for (int idx = tid; idx < 79 * 64; idx += 512) {
                const int i = idx >> 6, c = idx & 63; float v = 0.f;
                if (tloc0 - 15 + i >= 0) v = bf2f(U[(size_t)(r0 - 15 + i) * 256 + g * 64 + c]);
                Uw[idx] = v;
            }
            for (int idx = tid; idx < 4096; idx += 512) Wg[idx] = pw[g * 4096 + idx];
            __syncthreads();
            const int w = 2 << g;
            for (int idx = tid; idx < 4096; idx += 512) {
                const int tt = idx >> 6, c = idx & 63; float s = 0.f;
                for (int i = 0; i < w; ++i) s += Uw[(15 + tt - i) * 64 + c];
                const int cnt = min(tloc0 + tt + 1, w);
                Pp[tt * 65 + c] = s / (float)cnt - Uw[(15 + tt) * 64 + c];
            }
            __syncthreads();
            const int tt = tid >> 3, dd = tid & 7;
            f32x4 a0 = {0.f, 0.f, 0.f, 0.f}, a1 = {0.f, 0.f, 0.f, 0.f};
            for (int c = 0; c < 64; ++c) {
                const float p = Pp[tt * 65 + c];
                const f32x4 w0 = *(const LAS f32x4*)(Wg + c * 64 + dd * 8), w1 = *(const LAS f32x4*)(Wg + c * 64 + dd * 8 + 4);
                a0 += w0 * p; a1 += w1 * p;
            }
            const f32x4 s0 = *(const f32x4*)(ps + g * 64 + dd * 8), s1 = *(const f32x4*)(ps + g * 64 + dd * 8 + 4);
            store8(Y + (size_t)(r0 + tt) * D + 384 + g * 64 + dd * 8, a0 * s0, a1 * s1);
        }
        __syncthreads();
    }
    for (int s = bid; s < NB * 6; s += G) {
        const int b = s / 6, h = s - b * 6;
        const float bias = fb[h];
        double pre[8]; double run = 0.0;
#pragma unroll
        for (int j = 0; j < 8; ++j) {
            const float x = Fl[(size_t)(b * SEQ + tid * 8 + j) * 8 + h] + bias;
            const float ls = fminf(x, 0.f) - log1pf(expf(-fabsf(x)));
            run += (double)ls; pre[j] = run;
        }
        double inc = run;
#pragma unroll
        for (int o = 1; o < 64; o <<= 1) { const long long iv = __builtin_bit_cast(long long, inc); const int src = ((lane - o) & 63) << 2; const unsigned lo = (unsigned)__builtin_amdgcn_ds_bpermute(src, (int)(unsigned)iv), hi = (unsigned)__builtin_amdgcn_ds_bpermute(src, (int)(unsigned)(iv >> 32)); const double t = __builtin_bit_cast(double, ((unsigned long long)hi << 32) | lo); if (lane >= o) inc += t; }
        __syncthreads();
        if (lane == 63) Sd[wave] = inc;
        __syncthreads();
        double off = inc - run;
        for (int w2 = 0; w2 < wave; ++w2) off += Sd[w2];
#pragma unroll
        for (int j = 0; j < 8; ++j) {
            const double C = (off + pre[j]) * 1.4426950408889634;
            const unsigned c1 = f2bf((float)C); const double r1 = C - (double)bf2f(c1);
            const unsigned c2 = f2bf((float)r1); const double r2 = r1 - (double)bf2f(c2);
            const unsigned c3 = f2bf((float)r2);
            const size_t row = (size_t)b * SEQ + tid * 8 + j;
            u32x4* q = (u32x4*)(Qp + row * QP + (6 + h) * 96 + 64); u32x4* k = (u32x4*)(Kp + row * QP + (6 + h) * 96 + 64);
            const u32x4 z4 = {0u, 0u, 0u, 0u};
            q[0] = (u32x4){c1 | (c2 << 16), c3 | (0x3F80u << 16), 0x3F803F80u, 0u}; q[1] = z4; q[2] = z4; q[3] = z4;
            k[0] = (u32x4){0x3F803F80u, 0x3F80u | ((c1 ^ 0x8000u) << 16), (c2 ^ 0x8000u) | ((c3 ^ 0x8000u) << 16), 0u}; k[1] = z4; k[2] = z4; k[3] = z4;
        }
        __syncthreads();
    }
}

namespace att {
constexpr int KSTR = 208, KBUF = 64 * KSTR, VBUF = 8192, BUF = KBUF + VBUF;
__device__ __forceinline__ int crow(int i, int h) { return (i & 3) + 8 * (i >> 2) + 4 * h; }
typedef short v4i16_t __attribute__((ext_vector_type(4)));
__device__ __forceinline__ s16x4 vtr(const LAS unsigned char* p) { return __builtin_bit_cast(s16x4, __builtin_amdgcn_ds_read_tr16_b64_v4i16((LAS v4i16_t*)p)); }

__device__ __forceinline__ void attn_unit(LAS unsigned char* lds, const bf16* Qp, const bf16* Kp, const bf16* V, bf16* Y, int b, int head, int qb, int tid, int w, int lane) {
    const int r = lane & 31, h = lane >> 5;
    const size_t rowbase = (size_t)b * SEQ; const int q0 = qb * 256;
    const bf16* qptr = Qp + (rowbase + q0 + 32 * w + r) * QP + head * 96 + 8 * h;
    bf16x8 qf[6];
#pragma unroll
    for (int s = 0; s < 6; ++s) qf[s] = *(const bf16x8*)(qptr + 16 * s);
    f32x16 o0, o1;
#pragma unroll
    for (int i = 0; i < 16; ++i) { o0[i] = 0.f; o1[i] = 0.f; }
    float mrun = -INFINITY, lrun = 0.f;
    const int NT = 4 * (qb + 1);
    const bool lowhalf = tid < 256;
    const bf16* gA = Kp + (rowbase + tid / 12) * QP + head * 96 + (tid % 12) * 8; const int lA = (tid / 12) * KSTR + (tid % 12) * 16;
    const bf16* gB; int lB; size_t stB;
    if (lowhalf) { const int c = tid + 512; gB = Kp + (rowbase + c / 12) * QP + head * 96 + (c % 12) * 8; lB = (c / 12) * KSTR + (c % 12) * 16; stB = (size_t)64 * QP; }
    else { const int c = tid - 256, row = c >> 3, part = c & 7; gB = V + (rowbase + row) * VP + head * 64 + part * 8; lB = KBUF + (part >> 2) * 4096 + row * 64 + (part & 3) * 16; stB = (size_t)64 * VP; }
    const bf16* gC; int lC;
    { const int c = tid + 256, row = c >> 3, part = c & 7; gC = V + (rowbase + row) * VP + head * 64 + part * 8; lC = KBUF + (part >> 2) * 4096 + row * 64 + (part & 3) * 16; }
    u32x4 ra, rb, rc = {0u, 0u, 0u, 0u};
    ra = *(const u32x4*)gA; rb = *(const u32x4*)gB; if (lowhalf) rc = *(const u32x4*)gC;
    *(LAS u32x4*)(lds + lA) = ra; *(LAS u32x4*)(lds + lB) = rb; if (lowhalf) *(LAS u32x4*)(lds + lC) = rc;
    __syncthreads();
    const int i16 = lane & 15, q4 = i16 >> 2, p4 = i16 & 3, blk = (lane >> 4) & 1;
    const int voff = (4 * h + q4) * 64 + blk * 32 + p4 * 8;
    const int qmin = q0 + 32 * w, qme = qmin + r;
    for (int t = 0; t < NT; ++t) {
        const int buf = (t & 1) * BUF, nbuf = BUF - buf;
        const bool more = (t + 1 < NT);
        if (more) {
            gA += (size_t)64 * QP; gB += stB; ra = *(const u32x4*)gA; rb = *(const u32x4*)gB;
            if (lowhalf) { gC += (size_t)64 * VP; rc = *(const u32x4*)gC; }
        }
        const int kmin = 64 * t;
        if (kmin <= qmin + 31) {
            f32x16 s0, s1;
#pragma unroll
            for (int i = 0; i < 16; ++i) { s0[i] = 0.f; s1[i] = 0.f; }
            const LAS unsigned char* kb = lds + buf + r * KSTR + h * 16;
#pragma unroll
            for (int st = 0; st < 6; ++st) {
                const bf16x8 a0 = *(const LAS bf16x8*)(kb + st * 32), a1 = *(const LAS bf16x8*)(kb + 32 * KSTR + st * 32);
                s0 = __builtin_amdgcn_mfma_f32_32x32x16_bf16(a0, qf[st], s0, 0, 0, 0);
                s1 = __builtin_amdgcn_mfma_f32_32x32x16_bf16(a1, qf[st], s1, 0, 0, 0);
            }
            if (kmin + 63 > qmin) {
#pragma unroll
                for (int i = 0; i < 16; ++i) { const int key = kmin + crow(i, h); if (key > qme) s0[i] = -INFINITY; if (key + 32 > qme) s1[i] = -INFINITY; }
            }
            float mx = fmaxf(s0[0], s1[0]);
#pragma unroll
            for (int i = 1; i < 16; ++i) mx = fmaxf(mx, fmaxf(s0[i], s1[i]));
            mx = fmaxf(mx, lane_xor(mx, lane, 32));
            const float mnew = fmaxf(mrun, mx);
            const float alpha = __builtin_amdgcn_exp2f(mrun - mnew);
            mrun = mnew;
            float sum = 0.f;
#pragma unroll
            for (int i = 0; i < 16; ++i) { s0[i] = __builtin_amdgcn_exp2f(s0[i] - mnew); s1[i] = __builtin_amdgcn_exp2f(s1[i] - mnew); sum += s0[i] + s1[i]; }
            lrun = lrun * alpha + sum;
#pragma unroll
            for (int i = 0; i < 16; ++i) { o0[i] *= alpha; o1[i] *= alpha; }
            bf16x8 pf[2][2];
#pragma unroll
            for (int s = 0; s < 2; ++s) {
                u32x4 a = {cvtpk(s0[8 * s], s0[8 * s + 1]), cvtpk(s0[8 * s + 2], s0[8 * s + 3]), cvtpk(s0[8 * s + 4], s0[8 * s + 5]), cvtpk(s0[8 * s + 6], s0[8 * s + 7])};
                u32x4 c = {cvtpk(s1[8 * s], s1[8 * s + 1]), cvtpk(s1[8 * s + 2], s1[8 * s + 3]), cvtpk(s1[8 * s + 4], s1[8 * s + 5]), cvtpk(s1[8 * s + 6], s1[8 * s + 7])};
                pf[0][s] = __builtin_bit_cast(bf16x8, a); pf[1][s] = __builtin_bit_cast(bf16x8, c);
            }
            const LAS unsigned char* vb = lds + buf + KBUF + voff;
#pragma unroll
            for (int kb2 = 0; kb2 < 2; ++kb2)
#pragma unroll
                for (int s = 0; s < 2; ++s) {
                    const LAS unsigned char* vp = vb + (32 * kb2 + 16 * s) * 64;
                    const s16x4 l0 = vtr(vp), h0 = vtr(vp + 8 * 64), l1 = vtr(vp + 4096), h1 = vtr(vp + 4096 + 8 * 64);
                    const bf16x8 v0 = __builtin_shufflevector(l0, h0, 0, 1, 2, 3, 4, 5, 6, 7), v1 = __builtin_shufflevector(l1, h1, 0, 1, 2, 3, 4, 5, 6, 7);
                    o0 = __builtin_amdgcn_mfma_f32_32x32x16_bf16(v0, pf[kb2][s], o0, 0, 0, 0);
                    o1 = __builtin_amdgcn_mfma_f32_32x32x16_bf16(v1, pf[kb2][s], o1, 0, 0, 0);
                }
        }
        if (more) { *(LAS u32x4*)(lds + nbuf + lA) = ra; *(LAS u32x4*)(lds + nbuf + lB) = rb; if (lowhalf) *(LAS u32x4*)(lds + nbuf + lC) = rc; }
        __syncthreads();
    }
    const float lt = lrun + lane_xor(lrun, lane, 32);
    const float inv = 1.0f / lt;
    const int ycol = (head < 6) ? head * 64 : 640 + (head - 6) * 64;
    bf16* yp = Y + (rowbase + qme) * D + ycol + 4 * h;
#pragma unroll
    for (int g = 0; g < 4; ++g) {
        *(u32x2*)(yp + 8 * g) = (u32x2){cvtpk(o0[4 * g] * inv, o0[4 * g + 1] * inv), cvtpk(o0[4 * g + 2] * inv, o0[4 * g + 3] * inv)};
        *(u32x2*)(yp + 32 + 8 * g) = (u32x2){cvtpk(o1[4 * g] * inv, o1[4 * g + 1] * inv), cvtpk(o1[4 * g + 2] * inv, o1[4 * g + 3] * inv)};
    }
}
}

#define XB_TMO      128
#define XB_XCNT(j)  (256  + 64 * (j))
#define XB_XSUB(j)  (1280 + 64 * (j))
#define XB_XGEN(j)  (2304 + 64 * (j))
#define XB_TOP      3328
#define XB_TOPGEN   3392
#define XCD_BAR_WORDS 3456
#define XB_SPIN_CAP (1u << 18)

__device__ __forceinline__ unsigned xb_ld(unsigned* p)              { return __hip_atomic_load(p, __ATOMIC_RELAXED, __HIP_MEMORY_SCOPE_AGENT); }
__device__ __forceinline__ unsigned xb_add(unsigned* p, unsigned v) { return __hip_atomic_fetch_add(p, v, __ATOMIC_RELAXED, __HIP_MEMORY_SCOPE_AGENT); }
__device__ __forceinline__ unsigned xb_xcc_id() { return (unsigned)__builtin_amdgcn_s_getreg((3 << 11) | 20) & 0xFu; }
#define XB_SPIN(cond, bar) do { unsigned _sp = 0; while (cond) { __builtin_amdgcn_s_sleep(1); \
    if ((++_sp & 255u) == 0u) { if (xb_ld(&(bar)[XB_TMO])) break; if (_sp > XB_SPIN_CAP) { atomicAdd(&(bar)[XB_TMO], 1u); break; } } } } while (0)

struct XcdBarrier {
    unsigned* bar; unsigned x;
    volatile LAS unsigned* st;
};

__device__ __forceinline__ XcdBarrier xcd_barrier_post(unsigned* bar, volatile LAS unsigned* st) {
    XcdBarrier b; b.bar = bar; b.x = xb_xcc_id(); b.st = st;
    if (threadIdx.x == 0) (void)xb_add(&bar[XB_XCNT(b.x)], 1u);
    return b;
}
__device__ __forceinline__ void xcd_barrier_complete(unsigned* bar, unsigned x, unsigned& nloc, unsigned& nx) {
    const unsigned G = gridDim.x * gridDim.y * gridDim.z;
    unsigned sum, cnt, mine, sp = 0u;
    for (;;) {
        sum = 0u; cnt = 0u; mine = 0u;
#pragma unroll
        for (unsigned j = 0; j < 16; ++j) { const unsigned c = xb_ld(&bar[XB_XCNT(j)]); sum += c; cnt += (c > 0u) ? 1u : 0u; mine = (j == x) ? c : mine; }
        if (sum == G) break;
        __builtin_amdgcn_s_sleep(1);
        if ((++sp & 255u) == 0u) { if (xb_ld(&bar[XB_TMO])) break; if (sp > XB_SPIN_CAP) { atomicAdd(&bar[XB_TMO], 1u); break; } }
    }
    nloc = mine > 0u ? mine : 1u; nx = cnt > 0u ? cnt : 1u;
}

__device__ __forceinline__ void xcd_barrier(const XcdBarrier& b) {
    asm volatile("s_waitcnt vmcnt(0)" ::: "memory");
    __syncthreads();
    if (threadIdx.x == 0) {
        unsigned* bar = b.bar;
        __builtin_amdgcn_s_waitcnt(0);
        unsigned nloc = b.st[0], nx = b.st[1];
        if (nloc == 0u) { xcd_barrier_complete(bar, b.x, nloc, nx); b.st[0] = nloc; b.st[1] = nx; }
        const unsigned old = xb_add(&bar[XB_XSUB(b.x)], 1u);
        const unsigned gen = old / nloc;
        if (old + 1u == (gen + 1u) * nloc) {
            __builtin_amdgcn_fence(__ATOMIC_RELEASE, "agent");
            asm volatile("s_waitcnt vmcnt(0)" ::: "memory");
            const unsigned og = xb_add(&bar[XB_TOP], 1u);
            const unsigned tg = og / nx;
            if (og + 1u == (tg + 1u) * nx) xb_add(&bar[XB_TOPGEN], 1u);
            else XB_SPIN(xb_ld(&bar[XB_TOPGEN]) == tg, bar);
            __builtin_amdgcn_fence(__ATOMIC_ACQUIRE, "agent");
            xb_add(&bar[XB_XGEN(b.x)], 1u);
            asm volatile("s_waitcnt vmcnt(0)" ::: "memory");
        } else {
            XB_SPIN(xb_ld(&bar[XB_XGEN(b.x)]) == gen, bar);
            __builtin_amdgcn_fence(__ATOMIC_ACQUIRE, "agent");
            asm volatile("s_waitcnt vmcnt(0)" ::: "memory");
        }
    }
    __syncthreads();
}

constexpr int NPH = 2 + 12 * DEPTH;
#ifndef PH_EN
#define PH_EN 0xffff
#endif
#define EN(b) ((PH_EN >> (b)) & 1)
__global__ void __launch_bounds__(512, 2) mk_fwd(Args A_unused) {
    extern __shared__ __attribute__((aligned(16))) unsigned char lds_raw[];
    LAS unsigned char* lds = (LAS unsigned char*)lds_raw;
    cg::grid_group grid = cg::this_grid();
    const int ph_lo = A_unused.ph_lo, ph_hi = A_unused.ph_hi;
    if (threadIdx.x < 64) ((LAS unsigned*)(lds + LDS_MISC))[threadIdx.x] = 0u;
    __syncthreads();
    XcdBarrier bar = xcd_barrier_post((unsigned*)(A_unused.ws + WS_CTL) + CW_BAR, (volatile LAS unsigned*)(lds + LDS_MISC) + 8);
#define PHASE_ENTER() \
    CArgsP Ap = (CArgsP)__builtin_amdgcn_kernarg_segment_ptr(); asm volatile("" : "+s"(Ap)); \
    int tid = threadIdx.x; asm volatile("" : "+v"(tid)); \
    const int lane = tid & 63, wave = __builtin_amdgcn_readfirstlane(tid >> 6); \
    int bid = blockIdx.x, G = gridDim.x; asm volatile("" : "+s"(bid), "+s"(G)); \
    const int gw = bid * 8 + wave, NGW = G * 8; \
    unsigned char* ws = Ap->ws; asm volatile("" : "+s"(ws)); \
    unsigned char* wl = ws + WS_W + (size_t)l * WL_STRIDE; \
    int KD = D, KF = F, KQ = KQKV; asm volatile("" : "+s"(KD), "+s"(KF), "+s"(KQ)); \
    (void)lane; (void)gw; (void)NGW; (void)wl; (void)tid; (void)KD; (void)KF; (void)KQ;
    for (int ph = ph_lo; ph < ph_hi; ++ph) {
        int l = 0, k = -1;
        if (ph == 0) k = 12; else if (ph == NPH - 1) k = 13; else { l = (ph - 1) / 12; k = (ph - 1) % 12; }
        asm volatile("" : "+s"(k), "+s"(l));
        if (k == 12) {
            PHASE_ENTER();
            if (EN(12)) prologue(Ap, lds, gw, NGW, wave, lane);
        } else if (k == 13) {
            PHASE_ENTER();
            if (EN(0)) norm_phase(Ap->out, Ap->in[I_FINN], nullptr, Ap->out, gw, NGW, lane);
        } else if (EN(0) && (k == 0 || k == 3 || k == 9)) {
            PHASE_ENTER();
            const float* src = (l == 0 && k == 0) ? Ap->in[I_X] : Ap->out;
            const float* g = Ap->in[k == 0 ? I_F1N : (k == 3 ? I_MIXN : I_F2N)] + l * D;
            norm_phase(src, g, (bf16*)(ws + WS_XN), nullptr, gw, NGW, lane);
        } else if (EN(1) && (k == 1 || k == 10)) {
            PHASE_ENTER();
            pg8::Gemm g{(const bf16*)(ws + WS_XN), (const bf16*)(wl + (k == 1 ? WL_GU1 : WL_GU2)), M, NGU, KD}; pg8::StaticOrder S; S.init(M, NGU, G, bid);
            EpiSwiglu E{(bf16*)(ws + WS_BIG)};
            pg8::gemm_phase<EpiSwiglu, pg8::StaticOrder, true, true>(lds, g, S, E);
        } else if (EN(2) && (k == 2 || k == 11)) {
            PHASE_ENTER();
            pg8::Gemm g{(const bf16*)(ws + WS_BIG), (const bf16*)(wl + (k == 2 ? WL_DN1 : WL_DN2)), M, D, KF}; pg8::StaticOrder S; S.init(M, D, G, bid);
            EpiResid E{(l == 0 && k == 2) ? Ap->in[I_X] : Ap->out, Ap->out, 0.5f};
            pg8::gemm_phase<EpiResid, pg8::StaticOrder, true, true>(lds, g, S, E);
        } else if (EN(4) && k == 4) {
            PHASE_ENTER();
            pg8::Gemm g{(const bf16*)(ws + WS_XN), (const bf16*)(wl + WL_IN), M, NWIN, KD}; pg8::StaticOrder S; S.init(M, NWIN, G, bid);
            EpiWin E{(bf16*)(ws + WS_ZS), (bf16*)(ws + WS_U), (bf16*)(ws + WS_QP), (bf16*)(ws + WS_KP), (bf16*)(ws + WS_V), (float*)(ws + WS_FL)};
            pg8::gemm_phase<EpiWin, pg8::StaticOrder, true, true>(lds, g, S, E);
        } else if (EN(5) && k == 5) {
            PHASE_ENTER();
            prep_phase(Ap, l, lds, tid, wave, lane, bid, G);
        } else if (EN(6) && k == 6) {
            PHASE_ENTER();
            pg8::Gemm g{(const bf16*)(ws + WS_QKN), (const bf16*)(wl + WL_QKV), M, NQKV, KQ}; pg8::StaticOrder S; S.init(M, NQKV, G, bid);
            EpiQKV E{(bf16*)(ws + WS_QP), (bf16*)(ws + WS_KP), (bf16*)(ws + WS_V), (const float*)(ws + WS_ROPE)};
            pg8::gemm_phase<EpiQKV, pg8::StaticOrder, true, true>(lds, g, S, E);
        } else if (EN(7) && k == 7) {
            PHASE_ENTER();
            LAS unsigned* uw = (LAS unsigned*)(lds + LDS_MISC);
            unsigned* ctl = (unsigned*)(ws + WS_CTL);
            for (;;) {
                __syncthreads();
                if (tid == 0) uw[0] = atomicAdd(ctl + 64 * l, 1u);
                __syncthreads();
                const unsigned u = uw[0];
                if (u >= 768u) break;
                const int qb = 15 - (int)(u / 48u), bh = (int)(u % 48u);
                att::attn_unit(lds, (const bf16*)(ws + WS_QP), (const bf16*)(ws + WS_KP), (const bf16*)(ws + WS_V), (bf16*)(ws + WS_XN), bh / 12, bh % 12, qb, tid, wave, lane);
            }
        } else if (EN(8) && k == 8) {
            PHASE_ENTER();
            pg8::Gemm g{(const bf16*)(ws + WS_XN), (const bf16*)(wl + WL_OUT), M, D, KD}; pg8::StaticOrder S; S.init(M, D, G, bid);
            EpiResid E{Ap->out, Ap->out, 1.0f};
            pg8::gemm_phase<EpiResid, pg8::StaticOrder, true, true>(lds, g, S, E);
        }
        if (ph + 1 < ph_hi) { if (ph_hi > 1000) grid.sync(); xcd_barrier(bar); }
    }
}

extern "C" void kernel_launch(void* const* d_in, const int* in_sizes, int n_in, void* d_out, int out_size, void* d_ws, size_t ws_size, hipStream_t stream) {
    static int grid = 0;
    if (grid == 0) {
        if (n_in != 18 || out_size != M * D || ws_size < WS_END) { fprintf(stderr, "kernel_launch: unexpected problem (n_in %d out %d ws %zu need %zu)\n", n_in, out_size, ws_size, (size_t)WS_END); grid = -1; return; }
        int dev = 0, cus = 0, per_cu = 0;
        hipGetDevice(&dev); hipDeviceGetAttribute(&cus, hipDeviceAttributeMultiprocessorCount, dev);
        if (hipFuncSetAttribute((const void*)mk_fwd, hipFuncAttributeMaxDynamicSharedMemorySize, LDS_BYTES) != hipSuccess) { fprintf(stderr, "kernel_launch: hipFuncSetAttribute failed\n"); grid = -1; return; }
        if (hipOccupancyMaxActiveBlocksPerMultiprocessor(&per_cu, (const void*)mk_fwd, 512, LDS_BYTES) != hipSuccess || per_cu < 1) { fprintf(stderr, "kernel_launch: occupancy query says %d\n", per_cu); per_cu = 1; }
        (void)hipGetLastError();
        grid = cus * per_cu;
        fprintf(stderr, "kernel_launch: grid %d (cus %d x %d)\n", grid, cus, per_cu);
    }
    if (grid < 0) return;
    (void)hipMemsetAsync((char*)d_ws + WS_CTL, 0, 65536, stream);
    Args a{};
    for (int i = 0; i < 18; ++i) a.in[i] = (const float*)d_in[i];
    a.out = (float*)d_out; a.ws = (unsigned char*)d_ws;
#if MK_MULTI
    for (int ph = 0; ph < NPH; ++ph) { a.ph_lo = ph; a.ph_hi = ph + 1; hipLaunchKernelGGL(mk_fwd, dim3(grid), dim3(512), LDS_BYTES, stream, a); }
#else
    a.ph_lo = 0; a.ph_hi = NPH;
    void* args[] = {&a};
    hipError_t e = hipLaunchCooperativeKernel((const void*)mk_fwd, dim3(grid), dim3(512), args, LDS_BYTES, stream);
    if (e != hipSuccess) fprintf(stderr, "kernel_launch: cooperative launch failed: %s (grid %d)\n", hipGetErrorString(e), grid);
#endif
}
```

```cpp
#include <hip/hip_runtime.h>
#include <hip/hip_cooperative_groups.h>
#include <cstdio>
#include <cstdint>
namespace cg = cooperative_groups;
#ifndef MK_MULTI
#define MK_MULTI 0
#endif
namespace pg8 {
#define PG8_LAS __attribute__((address_space(3)))
typedef unsigned short bf16_t;
typedef short bf16x8 __attribute__((ext_vector_type(8)));
typedef float f32x4 __attribute__((ext_vector_type(4)));
typedef unsigned u32x4 __attribute__((ext_vector_type(4)));
constexpr int BM = 256, BK = 64, HALF = 128, HTB = HALF * BK * 2  , STAGE_BYTES = 8 * HTB, NXCD = 8, WGM = 8;

__host__ __device__ __forceinline__ int lds_byte(int r, int c) { const int st = (r >> 4) * 2 + (c >> 5), rr = r & 15, cc = c & 31, ob = rr * 64 + cc * 2; return st * 1024 + (ob ^ (((ob >> 9) & 1) << 5)); }
__host__ __device__ __forceinline__ void stage_rc(int b, int& R, int& C) { const int st = b / 1024, sb = b % 1024, swz = sb ^ (((sb >> 9) & 1) << 5); R = (st >> 1) * 16 + swz / 64; C = (st & 1) * 32 + (swz % 64) / 2; }
__host__ __device__ __forceinline__ int perm32(int rho) { const int n = rho >> 4, i = rho & 15; return 8 * (i >> 2) + 4 * n + (i & 3); }

struct Unit { int pm, pn; };
struct Gemm { const bf16_t* A; const bf16_t* Bt; int M, N, K; };

struct StaticOrder {
    int nM, nN, nwg, G, c;
    __host__ __device__ void init(int M, int N, int G_, int c_) { nM = M / BM; nN = N / BM; nwg = nM * nN; G = G_; c = c_; }
    __host__ __device__ bool next(int i, Unit& u) const {
        const long L = (long)i * G + c; if (L >= nwg) return false;
        int wgid = (int)L; { const int q = nwg / NXCD, r = nwg % NXCD, xcd = wgid % NXCD, off = wgid / NXCD; wgid = (xcd < r ? xcd * (q + 1) : r * (q + 1) + (xcd - r) * q) + off; }
        const int nig = WGM * nN, gid = wgid / nig, fm = gid * WGM, gsz = (nM - fm) < WGM ? (nM - fm) : WGM;
        u.pm = fm + ((wgid % nig) % gsz); u.pn = (wgid % nig) / gsz; return true;
    }
    __device__ __forceinline__ void a_ready(const Unit&) const {}
    __device__ __forceinline__ void done(const Unit&) const {}
};
typedef float f32x2 __attribute__((ext_vector_type(2)));
template <class Epi, class Sched, bool ALIGN_EPI = false, bool SP2 = false>
__device__ __forceinline__ void gemm_phase(PG8_LAS unsigned char* lds, const Gemm g, const Sched& S, const Epi& E) {
    int tid = threadIdx.x; asm volatile("" : "+v"(tid)); const int wid = __builtin_amdgcn_readfirstlane(tid >> 6), lane = tid & 63, wr = wid >> 2, wc = wid & 3, fr = lane & 15, fq = lane >> 4;
    const int K = g.K, nt = K / BK;
    unsigned voffA[2], voffB[2];
#pragma unroll
    for (int i = 0; i < 2; ++i) { int R, C; stage_rc(tid * 16 + i * 8192, R, C); const int Rb = Epi::PERM ? ((R & ~31) + perm32(R & 31)) : R;
        voffA[i] = (unsigned)(R * K + C) * 2u; voffB[i] = (unsigned)(Rb * K + C) * 2u; }
    const size_t kstep = (size_t)(BK * 2);
    const size_t hstep = (size_t)HALF * K * 2;
    const size_t tstep = 2 * hstep;
    const unsigned ldsw = (unsigned)wid * 1024u;
    const int aoff = lds_byte(wr * 64 + fr, fq * 8), boff = lds_byte(wc * 32 + fr, fq * 8);
#define PG8_SA(b, h) (((b) * 2 + (h)) * HTB)
#define PG8_SB(b, h) ((4 + (b) * 2 + (h)) * HTB)
#define PG8_STAGE(bufoff, gbase, voff) do { _Pragma("unroll") for (int _i = 0; _i < 2; ++_i) \
        __builtin_amdgcn_global_load_lds((const unsigned*)((const char*)(gbase) + (voff)[_i]), (PG8_LAS unsigned*)(lds + (bufoff) + ldsw + _i * 8192), 16, 0, 0); } while (0)
#define PG8_LDA(dst, b, h) do { _Pragma("unroll") for (int m = 0; m < 4; ++m) _Pragma("unroll") for (int k = 0; k < 2; ++k) dst[m][k] = *(const PG8_LAS bf16x8*)(lds + PG8_SA(b, h) + aoff + m * 2048 + k * 1024); } while (0)
#define PG8_LDB(dst, b, h) do { _Pragma("unroll") for (int n = 0; n < 2; ++n) _Pragma("unroll") for (int k = 0; k < 2; ++k) dst[n][k] = *(const PG8_LAS bf16x8*)(lds + PG8_SB(b, h) + boff + n * 2048 + k * 1024); } while (0)
#define PG8_MMA(ai, bj, At, Bt) do { __builtin_amdgcn_s_setprio(1); _Pragma("unroll") for (int m = 0; m < 4; ++m) _Pragma("unroll") for (int n = 0; n < 2; ++n) _Pragma("unroll") for (int k = 0; k < 2; ++k) \
        acc[ai][bj][m][n] = __builtin_amdgcn_mfma_f32_16x16x32_bf16(Bt[n][k], At[m][k], acc[ai][bj][m][n], 0, 0, 0); __builtin_amdgcn_s_setprio(0); } while (0)
#define PG8_WAIT_V(n) asm volatile("s_waitcnt vmcnt(" #n ")" ::: "memory")
#define PG8_WAIT_L(n) asm volatile("s_waitcnt lgkmcnt(" #n ")" ::: "memory")
#define PG8_BAR __builtin_amdgcn_s_barrier()
#define PG8_SCHED __builtin_amdgcn_sched_barrier(0)
    Unit cur, nxt; int ui = 0;
    if (!S.next(0, cur)) return;
    f32x4 acc[2][2][4][2];
#pragma unroll
    for (int a = 0; a < 2; ++a)
#pragma unroll
        for (int b = 0; b < 2; ++b)
#pragma unroll
            for (int m = 0; m < 4; ++m)
#pragma unroll
                for (int n = 0; n < 2; ++n) acc[a][b][m][n] = (f32x4){0.f, 0.f, 0.f, 0.f};
    bf16x8 At[4][2], B0[2][2], B1[2][2];
    const char* cA = (const char*)g.A + (size_t)cur.pm * tstep; const char* cB = (const char*)g.Bt + (size_t)cur.pn * tstep;
    S.a_ready(cur);
    if constexpr (SP2) {
        PG8_STAGE(PG8_SB(0, 0), cB, voffB); PG8_STAGE(PG8_SB(0, 1), cB + hstep, voffB); PG8_STAGE(PG8_SA(0, 0), cA, voffA); PG8_STAGE(PG8_SA(0, 1), cA + hstep, voffA);
        if (wr == 1) PG8_BAR;
        PG8_WAIT_V(2); PG8_BAR;
        PG8_STAGE(PG8_SB(1, 0), cB + kstep, voffB); PG8_STAGE(PG8_SA(1, 0), cA + kstep, voffA); PG8_STAGE(PG8_SB(1, 1), cB + hstep + kstep, voffB);
        PG8_WAIT_V(6); PG8_BAR;
    } else {
        PG8_STAGE(PG8_SB(0, 0), cB, voffB); PG8_STAGE(PG8_SA(0, 0), cA, voffA); PG8_STAGE(PG8_SB(0, 1), cB + hstep, voffB); PG8_STAGE(PG8_SA(0, 1), cA + hstep, voffA);
        if (wr == 1) PG8_BAR;
        PG8_WAIT_V(4); PG8_BAR;
        PG8_STAGE(PG8_SB(1, 0), cB + kstep, voffB); PG8_STAGE(PG8_SA(1, 0), cA + kstep, voffA); PG8_STAGE(PG8_SB(1, 1), cB + hstep + kstep, voffB);
        PG8_WAIT_V(6); PG8_BAR;
    }
    for (;;) {
        const bool has_next = S.next(ui + 1, nxt);
        const char* nA = has_next ? (const char*)g.A + (size_t)nxt.pm * tstep : cA; const char* nB = has_next ? (const char*)g.Bt + (size_t)nxt.pn * tstep : cB;
        for (int t = 0; t < nt; t += 2) {
            const bool last = (t == nt - 2);
            const char* a1 = cA + (size_t)(t + 1) * kstep;
            const char* a2 = last ? nA : cA + (size_t)(t + 2) * kstep; const char* b2 = last ? nB : cB + (size_t)(t + 2) * kstep;
            const char* a3 = a2 + kstep; const char* b3 = b2 + kstep;
            if (last && has_next) S.a_ready(nxt);
            if constexpr (SP2) {
            PG8_LDB(B0, 0, 0); PG8_LDB(B1, 0, 1); PG8_SCHED; PG8_LDA(At, 0, 0); PG8_STAGE(PG8_SA(1, 1), a1 + hstep, voffA);
            PG8_WAIT_V(8); PG8_WAIT_L(0); PG8_BAR; PG8_MMA(0, 0, At, B0); PG8_MMA(0, 1, At, B1); PG8_BAR; PG8_SCHED;
            PG8_LDA(At, 0, 1); PG8_STAGE(PG8_SB(0, 0), b2, voffB); PG8_STAGE(PG8_SB(0, 1), b2 + hstep, voffB); PG8_STAGE(PG8_SA(0, 0), a2, voffA);
            PG8_WAIT_V(8); PG8_WAIT_L(0); PG8_BAR; PG8_MMA(1, 0, At, B0); PG8_MMA(1, 1, At, B1); PG8_BAR; PG8_SCHED;
            PG8_LDB(B0, 1, 0); PG8_LDB(B1, 1, 1); PG8_SCHED; PG8_LDA(At, 1, 0); PG8_STAGE(PG8_SA(0, 1), a2 + hstep, voffA);
            PG8_WAIT_V(8); PG8_WAIT_L(0); PG8_BAR; PG8_MMA(0, 0, At, B0); PG8_MMA(0, 1, At, B1); PG8_BAR; PG8_SCHED;
            PG8_LDA(At, 1, 1); PG8_STAGE(PG8_SB(1, 0), b3, voffB); PG8_STAGE(PG8_SB(1, 1), b3 + hstep, voffB); PG8_STAGE(PG8_SA(1, 0), a3, voffA);
            PG8_WAIT_V(8); PG8_WAIT_L(0); PG8_BAR; PG8_MMA(1, 0, At, B0); PG8_MMA(1, 1, At, B1); PG8_BAR; PG8_SCHED;
            } else {
            PG8_LDB(B0, 0, 0); PG8_SCHED; PG8_LDA(At, 0, 0); PG8_STAGE(PG8_SA(1, 1), a1 + hstep, voffA);
            PG8_WAIT_L(8); PG8_BAR; PG8_WAIT_L(0); PG8_MMA(0, 0, At, B0); PG8_BAR; PG8_SCHED;
            PG8_LDB(B1, 0, 1); PG8_STAGE(PG8_SB(0, 0), b2, voffB);
            PG8_BAR; PG8_WAIT_L(0); PG8_MMA(0, 1, At, B1); PG8_BAR;
            PG8_LDA(At, 0, 1); PG8_STAGE(PG8_SA(0, 0), a2, voffA);
            PG8_BAR; PG8_WAIT_L(0); PG8_MMA(1, 0, At, B0); PG8_BAR; PG8_SCHED;
            PG8_STAGE(PG8_SB(0, 1), b2 + hstep, voffB);
            PG8_WAIT_V(6); PG8_BAR; PG8_MMA(1, 1, At, B1); PG8_BAR;
            PG8_LDB(B0, 1, 0); PG8_SCHED; PG8_LDA(At, 1, 0); PG8_STAGE(PG8_SA(0, 1), a2 + hstep, voffA);
            PG8_WAIT_L(8); PG8_BAR; PG8_WAIT_L(0); PG8_MMA(0, 0, At, B0); PG8_BAR; PG8_SCHED;
            PG8_LDB(B1, 1, 1); PG8_STAGE(PG8_SB(1, 0), b3, voffB);
            PG8_BAR; PG8_WAIT_L(0); PG8_MMA(0, 1, At, B1); PG8_BAR;
            PG8_LDA(At, 1, 1); PG8_STAGE(PG8_SA(1, 0), a3, voffA);
            PG8_BAR; PG8_WAIT_L(0); PG8_MMA(1, 0, At, B0); PG8_BAR; PG8_SCHED;
            PG8_STAGE(PG8_SB(1, 1), b3 + hstep, voffB);
            PG8_WAIT_V(6); PG8_BAR; PG8_MMA(1, 1, At, B1); PG8_BAR;
            }
        }
        if constexpr (ALIGN_EPI) { if (wr == 0) PG8_BAR; }
        if constexpr (!Epi::AFTER_DRAIN) { E(acc, cur, wr, wc, fr, fq); S.done(cur); }
        if (!has_next) break;
#pragma unroll
        for (int a = 0; a < 2; ++a)
#pragma unroll
            for (int b = 0; b < 2; ++b)
#pragma unroll
                for (int m = 0; m < 4; ++m)
#pragma unroll
                    for (int n = 0; n < 2; ++n) acc[a][b][m][n] = (f32x4){0.f, 0.f, 0.f, 0.f};
        cur = nxt; cA = nA; cB = nB; ++ui;
        if constexpr (ALIGN_EPI) { if (wr == 1) PG8_BAR; }
    }
    PG8_WAIT_V(0);
    if constexpr (!ALIGN_EPI) { if (wr == 0) PG8_BAR; }
    PG8_BAR;
    if constexpr (Epi::AFTER_DRAIN) { E.fused(acc, cur, wr, wc, fr, fq, lds, wid, lane); S.done(cur); }
#undef PG8_SA
#undef PG8_SB
#undef PG8_STAGE
#undef PG8_LDA
#undef PG8_LDB
#undef PG8_MMA
#undef PG8_WAIT_V
#undef PG8_WAIT_L
#undef PG8_BAR
#undef PG8_SCHED
}
}

constexpr int M = 16384, SEQ = 4096, NB = 4, D = 1024, F = 2816, DEPTH = 2;
constexpr int N_IN = 1830;
constexpr int NGU = 2 * F;
constexpr int NWIN = 2048;
constexpr int NQKV = 1536, KQKV = 384;
constexpr int QP = 1152, VP = 768;
constexpr float EPS = 1e-6f;
constexpr float LOG2E = 1.4426950408889634f;
constexpr float QS_MLA = 0.14724444f;
constexpr float QS_FOX = 0.18033688f;

constexpr size_t MiB = 1u << 20;
constexpr size_t WS_CTL = 0;
constexpr int CW_BAR = 4096;
constexpr size_t WS_SSQ = 65536;
constexpr size_t CTL_BYTES = 65536 + 7 * 65536;
constexpr size_t WS_ROPE = 1 * MiB;
constexpr size_t WS_C2 = 512 * 1024;
constexpr size_t WS_BND = 960 * 1024;
constexpr size_t WS_FL = 1 * MiB + 512 * 1024;
constexpr size_t WS_W = 2 * MiB;
constexpr size_t WL_GU1 = 0, WL_GU2 = 11 * MiB, WL_DN1 = 22 * MiB, WL_DN2 = 22 * MiB + 5632 * 1024, WL_IN = 33 * MiB, WL_OUT = 37 * MiB, WL_QKV = 39 * MiB;
constexpr size_t WL_STRIDE = 41 * MiB;
constexpr size_t WS_XB = 43 * MiB;
constexpr size_t WS_XN = 75 * MiB;
constexpr size_t WS_BIG = 107 * MiB;
constexpr size_t WS_ZS = WS_BIG, WS_U = WS_BIG + 16 * MiB, WS_QKN = WS_BIG + 24 * MiB, WS_QP = WS_BIG + 36 * MiB, WS_KP = WS_BIG + 72 * MiB, WS_V = WS_BIG + 108 * MiB;
constexpr size_t WS_END = WS_BIG + 132 * MiB;
static_assert(WL_QKV + (size_t)NQKV * KQKV * 2 <= WL_STRIDE && WS_W + WL_STRIDE <= WS_XB, "weights map");
static_assert(WS_QKN + (size_t)M * KQKV * 2 <= WS_QP && WS_V + (size_t)M * VP * 2 <= WS_END && WS_BIG + (size_t)M * F * 2 <= WS_END, "act map");

constexpr int LDS_BYTES = 147456;
constexpr int LDS_MISC = 131072 + 4096;

#define LAS __attribute__((address_space(3)))
typedef unsigned short bf16;
typedef float f32x4 __attribute__((ext_vector_type(4)));
typedef float f32x2 __attribute__((ext_vector_type(2)));
typedef float f32x16 __attribute__((ext_vector_type(16)));
typedef unsigned u32x4 __attribute__((ext_vector_type(4)));
typedef unsigned u32x2 __attribute__((ext_vector_type(2)));
typedef short bf16x8 __attribute__((ext_vector_type(8)));
typedef short s16x4 __attribute__((ext_vector_type(4)));
typedef __bf16 bf16x2_t __attribute__((ext_vector_type(2)));

__device__ __forceinline__ unsigned cvtpk(float lo, float hi) { f32x2 v = {lo, hi}; bf16x2_t b = __builtin_convertvector(v, bf16x2_t); return __builtin_bit_cast(unsigned, b); }
__device__ __forceinline__ unsigned f2bf(float f) { unsigned u = __builtin_bit_cast(unsigned, f); return (u + 0x7fffu + ((u >> 16) & 1u)) >> 16; }
__device__ __forceinline__ float bf2f(unsigned b) { return __builtin_bit_cast(float, b << 16); }
__device__ __forceinline__ float lane_xor(float v, int lane, int o) { return __builtin_bit_cast(float, __builtin_amdgcn_ds_bpermute((lane ^ o) << 2, __builtin_bit_cast(int, v))); }
__device__ __forceinline__ float wave_sum(float v, int lane) {
#pragma unroll
    for (int o = 1; o < 64; o <<= 1) v += lane_xor(v, lane, o);
    return v;
}
__device__ __forceinline__ void store8nt(bf16* p, f32x4 a, f32x4 b) { u32x4 w; w.x = cvtpk(a[0], a[1]); w.y = cvtpk(a[2], a[3]); w.z = cvtpk(b[0], b[1]); w.w = cvtpk(b[2], b[3]); __builtin_nontemporal_store(w, (u32x4*)p); }
__device__ __forceinline__ void store8(bf16* p, f32x4 a, f32x4 b) { u32x4 w; w.x = cvtpk(a[0], a[1]); w.y = cvtpk(a[2], a[3]); w.z = cvtpk(b[0], b[1]); w.w = cvtpk(b[2], b[3]); *(u32x4*)p = w; }

struct EpiSwiglu {
    static constexpr bool PERM = true, AFTER_DRAIN = false;
    bf16* O; const float* ssq; const LAS float* tbl; mutable int ucount;
    __device__ __forceinline__ void operator()(const pg8::f32x4 (&acc)[2][2][4][2], const pg8::Unit& u, int wr, int wc, int fr, int fq) const {
        asm volatile("" : "+v"(fr), "+v"(fq));
        const int row0 = u.pm * 256 + wr * 64 + fr, col0 = u.pn * 128 + wc * 32 + 8 * fq;
#pragma unroll
        for (int ai = 0; ai < 2; ++ai)
#pragma unroll
            for (int m = 0; m < 4; ++m) {
                bf16* rowp = O + (size_t)(row0 + ai * 128 + m * 16) * F + col0;
                const float rs = tbl[(ucount & 7) * 256 + wr * 64 + fr + ai * 128 + m * 16], nrs = -rs * LOG2E;
                f32x4 r[2];
#pragma unroll
                for (int n = 0; n < 2; ++n) {
                    const f32x4 g = acc[ai][0][m][n], uu = acc[ai][1][m][n];
#pragma unroll
                    for (int j = 0; j < 4; ++j) { const float e = __builtin_amdgcn_exp2f(g[j] * nrs); r[n][j] = (g[j] * rs) * __builtin_amdgcn_rcpf(1.0f + e) * (uu[j] * rs); }
                }
                store8nt(rowp, r[0], r[1]);
            }
        ++ucount;
    }
};
struct EpiResid {
    static constexpr bool PERM = true, AFTER_DRAIN = false;
    const float* base; float* out; bf16* xb; float* ssq; float scale;
    __device__ __forceinline__ void operator()(const pg8::f32x4 (&acc)[2][2][4][2], const pg8::Unit& u, int wr, int wc, int fr, int fq) const {
        asm volatile("" : "+v"(fr), "+v"(fq));
        const int row0 = u.pm * 256 + wr * 64 + fr, col0 = u.pn * 256 + wc * 32 + 8 * fq;
#pragma unroll
        for (int ai = 0; ai < 2; ++ai)
#pragma unroll
            for (int m = 0; m < 4; ++m) {
                const size_t off = (size_t)(row0 + ai * 128 + m * 16) * D + col0;
                float sq = 0.f;
#pragma unroll
                for (int bj = 0; bj < 2; ++bj) {
                    const size_t p = off + bj * 128;
                    const f32x4 b0 = __builtin_nontemporal_load((const f32x4*)(base + p)), b1 = __builtin_nontemporal_load((const f32x4*)(base + p + 4));
                    const f32x4 o0 = b0 + acc[ai][bj][m][0] * scale, o1 = b1 + acc[ai][bj][m][1] * scale;
                    __builtin_nontemporal_store(o0, (f32x4*)(out + p)); __builtin_nontemporal_store(o1, (f32x4*)(out + p + 4));
                    store8(xb + p, o0, o1);
                    sq += ((o0[0] * o0[0] + o0[1] * o0[1]) + (o0[2] * o0[2] + o0[3] * o0[3])) + ((o1[0] * o1[0] + o1[1] * o1[1]) + (o1[2] * o1[2] + o1[3] * o1[3]));
                }
                { const int ln = fq * 16 + fr; sq += lane_xor(sq, ln, 16); sq += lane_xor(sq, ln, 32); if (fq == 0) atomicAdd(ssq + row0 + ai * 128 + m * 16, sq); }
                asm volatile("" ::: "memory");
            }
    }
};
struct EpiWin {
    static constexpr bool PERM = true, AFTER_DRAIN = false;
    bf16 *Zs, *U, *Qp, *Kp, *V; float* Fl; const float* ssq; unsigned* nrm; const LAS float* tbl; mutable int ucount;
    __device__ __forceinline__ void operator()(const pg8::f32x4 (&acc)[2][2][4][2], const pg8::Unit& u, int wr, int wc, int fr, int fq) const {
        asm volatile("" : "+v"(fr), "+v"(fq));
        const int row0 = u.pm * 256 + wr * 64 + fr;
#pragma unroll
        for (int bj = 0; bj < 2; ++bj) {
            const int c0 = u.pn * 256 + bj * 128 + wc * 32 + 8 * fq;
            bf16* dst; int pitch; float sc = 1.0f; bool f32too = false; int nslot = -1;
            if (c0 < 512) { dst = Zs + c0; pitch = 512; f32too = (c0 == 416); }
            else if (c0 < 768) { dst = U + (c0 - 512); pitch = 256; }
            else if (c0 < 1920) {
                const int e = c0 - 768, seg = e / 384, w = e - seg * 384, hh = w >> 6, d = w & 63;
                if (seg == 0) { dst = Qp + (6 + hh) * 96 + d; pitch = QP; sc = QS_FOX; nslot = hh * 4 + (d >> 5); }
                else if (seg == 1) { dst = Kp + (6 + hh) * 96 + d; pitch = QP; nslot = hh * 4 + 2 + (d >> 5); }
                else { dst = V + (6 + hh) * 64 + d; pitch = VP; }
            } else continue;
            float nmax = 0.f;
#pragma unroll
            for (int ai = 0; ai < 2; ++ai)
#pragma unroll
                for (int m = 0; m < 4; ++m) {
                    const int row = row0 + ai * 128 + m * 16;
                    const float rs = tbl[(ucount & 7) * 256 + wr * 64 + fr + ai * 128 + m * 16], scr = sc * rs;
                    const f32x4 v0 = acc[ai][bj][m][0] * scr, v1 = acc[ai][bj][m][1] * scr;
                    store8(dst + (size_t)row * pitch, v0, v1);
                    if (nslot >= 0) { float s2 = ((v0[0] * v0[0] + v0[1] * v0[1]) + (v0[2] * v0[2] + v0[3] * v0[3])) + ((v1[0] * v1[0] + v1[1] * v1[1]) + (v1[2] * v1[2] + v1[3] * v1[3]));
                        const int ln = fq * 16 + fr; s2 += lane_xor(s2, ln, 16); s2 += lane_xor(s2, ln, 32); nmax = fmaxf(nmax, s2); }
                    if (f32too) { *(f32x4*)(Fl + (size_t)row * 8) = acc[ai][bj][m][0] * rs; *(f32x4*)(Fl + (size_t)row * 8 + 4) = acc[ai][bj][m][1] * rs; }
                }
            if (nslot >= 0) { const int ln = fq * 16 + fr;
#pragma unroll
                for (int o = 1; o < 16; o <<= 1) nmax = fmaxf(nmax, lane_xor(nmax, ln, o));
                if (fr == 0 && fq == 0) atomicMax(nrm + ((u.pm >> 4) * 6) * 4 + nslot, __builtin_bit_cast(unsigned, nmax)); }
        }
        ++ucount;
    }
};
struct EpiQKV {
    static constexpr bool PERM = true, AFTER_DRAIN = false;
    bf16 *Qp, *Kp, *V; const float* rope;
    __device__ __forceinline__ void operator()(const pg8::f32x4 (&acc)[2][2][4][2], const pg8::Unit& u, int wr, int wc, int fr, int fq) const {
        asm volatile("" : "+v"(fr), "+v"(fq));
        const int row0 = u.pm * 256 + wr * 64 + fr;
#pragma unroll
        for (int bj = 0; bj < 2; ++bj) {
            const int c0 = u.pn * 256 + bj * 128 + wc * 32 + 8 * fq;
            if (c0 < 576) {
                const int head = c0 / 96, d = c0 - head * 96;
                bf16* dst = Qp + head * 96 + d;
                if (d < 64) {
#pragma unroll
                    for (int ai = 0; ai < 2; ++ai)
#pragma unroll
                        for (int m = 0; m < 4; ++m) { const int row = row0 + ai * 128 + m * 16; store8(dst + (size_t)row * QP, acc[ai][bj][m][0] * QS_MLA, acc[ai][bj][m][1] * QS_MLA); }
                } else {
                    const int a = (d - 64) >> 3;
                    f32x4 t0[2][4], t1[2][4];
#pragma unroll
                    for (int ai = 0; ai < 2; ++ai)
#pragma unroll
                        for (int m = 0; m < 4; ++m) { const int pos = (row0 + ai * 128 + m * 16) & (SEQ - 1);
                            t0[ai][m] = *(const f32x4*)(rope + (size_t)(pos * 16 + 4 * a) * 2); t1[ai][m] = *(const f32x4*)(rope + (size_t)(pos * 16 + 4 * a) * 2 + 4); }
                    asm volatile("" ::: "memory");
#pragma unroll
                    for (int ai = 0; ai < 2; ++ai)
#pragma unroll
                        for (int m = 0; m < 4; ++m) {
                            const int row = row0 + ai * 128 + m * 16;
                            const f32x4 x = acc[ai][bj][m][0], y = acc[ai][bj][m][1], c0v = t0[ai][m], c1v = t1[ai][m];
                            f32x4 ox, oy;
                            ox[0] = x[0] * c0v[0] - x[1] * c0v[1]; ox[1] = x[1] * c0v[0] + x[0] * c0v[1]; ox[2] = x[2] * c0v[2] - x[3] * c0v[3]; ox[3] = x[3] * c0v[2] + x[2] * c0v[3];
                            oy[0] = y[0] * c1v[0] - y[1] * c1v[1]; oy[1] = y[1] * c1v[0] + y[0] * c1v[1]; oy[2] = y[2] * c1v[2] - y[3] * c1v[3]; oy[3] = y[3] * c1v[2] + y[2] * c1v[3];
                            store8(dst + (size_t)row * QP, ox * QS_MLA, oy * QS_MLA);
                        }
                }
            } else if (c0 < 1344) {
                const int e = c0 - 576, head = e >> 7, d = e & 127;
                bf16* dst; int pitch;
                if (d < 64) { dst = Kp + head * 96 + d; pitch = QP; } else { dst = V + head * 64 + (d - 64); pitch = VP; }
#pragma unroll
                for (int ai = 0; ai < 2; ++ai)
#pragma unroll
                    for (int m = 0; m < 4; ++m) { const int row = row0 + ai * 128 + m * 16; store8(dst + (size_t)row * pitch, acc[ai][bj][m][0], acc[ai][bj][m][1]); }
            }
        }
    }
};

struct Args {
    const float* in[18];
    float* out; unsigned char* ws;
    int ph_lo, ph_hi;
};
typedef const __attribute__((address_space(4))) Args* CArgsP;
enum { I_X = 0, I_F1N, I_F1GU, I_F1DN, I_MIXN, I_WIN, I_QAN, I_WQB, I_KVAN, I_WKVB, I_POOLW, I_POOLS, I_FOXB, I_WOUT, I_F2N, I_F2GU, I_F2DN, I_FINN };

struct ConvDesc { const float* wp; const float* gain; bf16* wt; int Nsrc, Ksrc, koff, Kdst, k0; bool okc; };
__device__ __forceinline__ void conv_set(ConvDesc& d, const float* W, int Nsrc, int Ksrc, int sc, int koff, bf16* WT, int Kdst, int k0, int n0, int lane, const float* gain) {
    d.okc = sc >= 0; d.Nsrc = Nsrc; d.Ksrc = Ksrc; d.koff = koff; d.Kdst = Kdst; d.k0 = k0;
    d.wp = W + (size_t)(k0 - koff + (lane >> 5)) * Nsrc + (d.okc ? sc : 0);
    d.wt = WT + (size_t)n0 * Kdst + k0; d.gain = gain ? gain + k0 : nullptr;
}
__device__ __forceinline__ void conv_load(const ConvDesc& d, float (&v)[32], int lane) {
#pragma unroll
    for (int i = 0; i < 32; ++i) {
        const int ks = d.k0 + 2 * i + (lane >> 5) - d.koff;
        const bool ok = d.okc && ks >= 0 && ks < d.Ksrc;
        v[i] = ok ? __builtin_nontemporal_load(d.wp + (size_t)(2 * i) * d.Nsrc) : 0.f;
    }
}
__device__ __forceinline__ void conv_store(const ConvDesc& d, const float (&v)[32], LAS float* scr, int lane) {
    const int c = lane & 7;
    f32x4 g0 = {1.f, 1.f, 1.f, 1.f}, g1 = {1.f, 1.f, 1.f, 1.f};
    if (d.gain) { g0 = *(const f32x4*)(d.gain + 8 * c); g1 = *(const f32x4*)(d.gain + 8 * c + 4); }
#pragma unroll
    for (int i = 0; i < 32; ++i) scr[(2 * i + (lane >> 5)) * 33 + (lane & 31)] = v[i];
    asm volatile("s_waitcnt lgkmcnt(0)" ::: "memory");
#pragma unroll
    for (int j = 0; j < 4; ++j) {
        const int n = (lane >> 3) + 8 * j; const LAS float* s = scr + (8 * c) * 33 + n;
        u32x4 o; o.x = cvtpk(s[0 * 33] * g0[0], s[1 * 33] * g0[1]); o.y = cvtpk(s[2 * 33] * g0[2], s[3 * 33] * g0[3]); o.z = cvtpk(s[4 * 33] * g1[0], s[5 * 33] * g1[1]); o.w = cvtpk(s[6 * 33] * g1[2], s[7 * 33] * g1[3]);
        *(u32x4*)(d.wt + (size_t)n * d.Kdst + 8 * c) = o;
    }
    asm volatile("s_waitcnt lgkmcnt(0)" ::: "memory");
}
constexpr int IT_GU = 16 * (NGU / 32), IT_DN = (F / 64) * (D / 32), IT_IN = 16 * (NWIN / 32), IT_QKV = (KQKV / 64) * (NQKV / 32), IT_OUT = 16 * (D / 32);
constexpr int IT_LAYER = 2 * IT_GU + 2 * IT_DN + IT_IN + IT_QKV + IT_OUT;
__device__ __forceinline__ void conv_decode(ConvDesc& d, CArgsP Ap, int l, unsigned char* wl, int it, int lane) {
    int r = it; const int nl = lane & 31;
    if (r < 2 * IT_GU) {
        const int f = r / IT_GU; r -= f * IT_GU;
        const float* W = Ap->in[f ? I_F2GU : I_F1GU] + (size_t)l * D * NGU;
        const int nblk = NGU / 32, kb = r / nblk, nb = r - kb * nblk, n = nb * 32 + nl, tile = n >> 8, w = n & 255;
        const int sc = (w < 128) ? tile * 128 + w : F + tile * 128 + (w - 128);
        conv_set(d, W, NGU, D, sc, 0, (bf16*)(wl + (f ? WL_GU2 : WL_GU1)), D, kb * 64, nb * 32, lane, Ap->in[f ? I_F2N : I_F1N] + l * D);
        return;
    }
    r -= 2 * IT_GU;
    if (r < 2 * IT_DN) {
        const int f = r / IT_DN; r -= f * IT_DN;
        const float* W = Ap->in[f ? I_F2DN : I_F1DN] + (size_t)l * F * D;
        const int nblk = D / 32, kb = r / nblk, nb = r - kb * nblk;
        conv_set(d, W, D, F, nb * 32 + nl, 0, (bf16*)(wl + (f ? WL_DN2 : WL_DN1)), F, kb * 64, nb * 32, lane, nullptr);
        return;
    }
    r -= 2 * IT_DN;
    if (r < IT_IN) {
        const float* W = Ap->in[I_WIN] + (size_t)l * D * N_IN;
        const int nblk = NWIN / 32, kb = r / nblk, nb = r - kb * nblk, n = nb * 32 + nl;
        int sc = -1;
        if (n < 416) sc = n; else if (n < 422) sc = 1824 + (n - 416); else if (n < 512) sc = -1; else if (n < 768) sc = 416 + (n - 512); else if (n < 1920) sc = 672 + (n - 768);
        conv_set(d, W, N_IN, D, sc, 0, (bf16*)(wl + WL_IN), D, kb * 64, nb * 32, lane, Ap->in[I_MIXN] + l * D);
        return;
    }
    r -= IT_IN;
    if (r < IT_QKV) {
        const int nblk = NQKV / 32, kb = r / nblk, nb = r - kb * nblk, n = nb * 32 + nl;
        if (n < 576) {
            const int head = n / 96, dd = n - head * 96; int sd = dd;
            if (dd >= 64) { const int j2 = dd - 64; sd = 64 + (j2 >> 1) + 16 * (j2 & 1); }
            conv_set(d, Ap->in[I_WQB] + (size_t)l * 256 * 576, 576, 256, head * 96 + sd, 0, (bf16*)(wl + WL_QKV), KQKV, kb * 64, nb * 32, lane, nullptr);
        } else {
            const int sc = (n < 1344) ? n - 576 : -1;
            conv_set(d, Ap->in[I_WKVB] + (size_t)l * 128 * 768, 768, 128, sc, 256, (bf16*)(wl + WL_QKV), KQKV, kb * 64, nb * 32, lane, nullptr);
        }
        return;
    }
    r -= IT_QKV;
    {
        const float* W = Ap->in[I_WOUT] + (size_t)l * D * D;
        const int nblk = D / 32, kb = r / nblk, nb = r - kb * nblk;
        conv_set(d, W, D, D, nb * 32 + nl, 0, (bf16*)(wl + WL_OUT), D, kb * 64, nb * 32, lane, nullptr);
    }
}

constexpr int IT_P0 = 2 * IT_GU, IT_P1 = IT_LAYER - IT_P0 - IT_DN, IT_P3 = IT_DN;
__device__ __forceinline__ int conv_remap(int pass, int x) {
    if (pass == 2 || pass == 0) return x;
    if (pass == 3) return 2 * IT_GU + IT_DN + x;
    return (x < IT_DN) ? 2 * IT_GU + x : 2 * IT_GU + IT_DN + x;
}
__device__ __forceinline__ void convert_items(CArgsP Ap, int l, LAS unsigned char* lds, int pass, int gw, int NGW, int wave, int lane) {
    LAS float* scr = (LAS float*)(lds + wave * 16384);
    unsigned char* wl = Ap->ws + WS_W;
    const int NIT = (pass == 2) ? IT_LAYER : (pass == 0 ? IT_P0 : (pass == 1 ? IT_P1 : IT_P3));
    ConvDesc dA, dB; float va[32], vb[32];
    int it = gw;
    if (it < NIT) { conv_decode(dA, Ap, l, wl, conv_remap(pass, it), lane); conv_load(dA, va, lane); }
    while (it < NIT) {
        const int it2 = it + NGW; const bool has2 = it2 < NIT;
        if (has2) { conv_decode(dB, Ap, l, wl, conv_remap(pass, it2), lane); conv_load(dB, vb, lane); }
        conv_store(dA, va, scr, lane);
        if (!has2) break;
        const int it3 = it2 + NGW; const bool has3 = it3 < NIT;
        if (has3) { conv_decode(dA, Ap, l, wl, conv_remap(pass, it3), lane); conv_load(dA, va, lane); }
        conv_store(dB, vb, scr, lane);
        if (!has3) break;
        it = it3;
    }
}
__device__ __forceinline__ void prologue(CArgsP Ap, int l, LAS unsigned char* lds, int gw, int NGW, int wave, int lane) {
    unsigned char* ws = Ap->ws;
    convert_items(Ap, l, lds, (NGW == 2048) ? 0 : 2, gw, NGW, wave, lane);
    if (l != 0) return;
    {
        const float* x = Ap->in[I_X]; bf16* xb = (bf16*)(ws + WS_XB); float* ssq = (float*)(ws + WS_SSQ);
        for (int row = gw; row < M; row += NGW) {
            const f32x4* xr = (const f32x4*)(x + (size_t)row * D) + lane; u32x2* o = (u32x2*)(xb + (size_t)row * D) + lane; float s = 0.f;
#pragma unroll
            for (int j = 0; j < 4; ++j) { const f32x4 v = __builtin_nontemporal_load(xr + 64 * j); s += (v[0] * v[0] + v[1] * v[1]) + (v[2] * v[2] + v[3] * v[3]); o[64 * j] = (u32x2){cvtpk(v[0], v[1]), cvtpk(v[2], v[3])}; }
            s = wave_sum(s, lane);
            if (lane == 0) ssq[row] = s;
        }
    }
    float* T = (float*)(ws + WS_ROPE);
    for (int e = gw * 64 + lane; e < SEQ * 16; e += NGW * 64) {
        const int pos = e >> 4, j = e & 15;
        const float inv = exp2f(-(float)j * 0.8304820237218405f);
        const float ang = (float)pos * inv;
        const double a = (double)ang, k = __builtin_rint(a * 0.15915494309189535), x = a - k * 6.283185307179586, x2 = x * x;
        double s = x, c = 1.0, ts = x, tc = 1.0;
#pragma unroll 1
        for (int i = 1; i <= 12; ++i) {
            tc = -tc * x2 / (double)((2 * i - 1) * (2 * i)); c += tc;
            ts = -ts * x2 / (double)((2 * i) * (2 * i + 1)); s += ts;
        }
        *(f32x2*)(T + (size_t)e * 2) = (f32x2){(float)c, (float)s};
    }
}

__device__ __forceinline__ void norm_phase(const float* x, const float* g, bf16* xn, float* fout, int gw, int NGW, int lane) {
    f32x4 gv[4];
#pragma unroll
    for (int j = 0; j < 4; ++j) gv[j] = *((const f32x4*)g + lane + 64 * j);
    for (int row = gw; row < M; row += NGW) {
        const f32x4* xr = (const f32x4*)(x + (size_t)row * D) + lane;
        f32x4 v[4]; float s = 0.f;
#pragma unroll
        for (int j = 0; j < 4; ++j) { v[j] = xr[64 * j]; s += (v[j][0] * v[j][0] + v[j][1] * v[j][1]) + (v[j][2] * v[j][2] + v[j][3] * v[j][3]); }
        const float rstd = 1.0f / sqrtf(wave_sum(s, lane) * (1.0f / D) + EPS);
        if (fout) {
            f32x4* o = (f32x4*)(fout + (size_t)row * D) + lane;
#pragma unroll
            for (int j = 0; j < 4; ++j) o[64 * j] = (v[j] * rstd) * gv[j];
        } else {
            u32x2* o = (u32x2*)(xn + (size_t)row * D) + lane;
#pragma unroll
            for (int j = 0; j < 4; ++j) { const f32x4 y = (v[j] * rstd) * gv[j]; o[64 * j] = (u32x2){cvtpk(y[0], y[1]), cvtpk(y[2], y[3])}; }
        }
    }
}

__device__ __forceinline__ void prep_phase(CArgsP Ap, int l, LAS unsigned char* lds, int tid, int wave, int lane, int bid, int G) {
    unsigned char* ws = Ap->ws;
    const bf16* Zs = (const bf16*)(ws + WS_ZS); const bf16* U = (const bf16*)(ws + WS_U);
    bf16* QKn = (bf16*)(ws + WS_QKN); bf16* Qp = (bf16*)(ws + WS_QP); bf16* Kp = (bf16*)(ws + WS_KP); bf16* Y = (bf16*)(ws + WS_XN);
    const float* T = (const float*)(ws + WS_ROPE); const float* Fl = (const float*)(ws + WS_FL);
    const float* qg = Ap->in[I_QAN] + l * 256; const float* kg = Ap->in[I_KVAN] + l * 128;
    const float* pw = Ap->in[I_POOLW] + (size_t)l * 4 * 4096; const float* ps = Ap->in[I_POOLS] + l * 256;
    const float* fb = Ap->in[I_FOXB] + l * 6;
    LAS unsigned char* Uw = lds;
    LAS unsigned char* Wt = lds + 40960;
    LAS unsigned char* Pb = lds + 40960 + 36864;
    LAS double* Sd = (LAS double*)(lds + 114688);
    for (int idx = tid; idx < 4096; idx += 512) {
        const int g = idx >> 10, c = (idx >> 4) & 63, d4 = (idx & 15) * 4;
        const f32x4 w = *(const f32x4*)(pw + g * 4096 + c * 64 + d4);
#pragma unroll
        for (int i = 0; i < 4; ++i) *(LAS unsigned short*)(Wt + ((g * 64 + d4 + i) * 72 + c) * 2) = (unsigned short)f2bf(w[i]);
    }
    for (int tile = bid; tile < M / 64; tile += G) {
        const int r0 = tile * 64, tloc0 = r0 & (SEQ - 1);
        __syncthreads();
        for (int idx = tid; idx < 79 * 32; idx += 512) {
            const int i = idx >> 5, c8 = (idx & 31) * 8; u32x4 v = {0u, 0u, 0u, 0u};
            if (tloc0 - 15 + i >= 0) v = *(const u32x4*)(U + (size_t)(r0 - 15 + i) * 256 + c8);
            *(LAS u32x4*)(Uw + i * 512 + c8 * 2) = v;
        }
        {
            u32x2 qa[8]; unsigned ka[8]; unsigned short r1[8], r2[8];
#pragma unroll
            for (int i = 0; i < 8; ++i) {
                const bf16* z = Zs + (size_t)(r0 + wave * 8 + i) * 512;
                qa[i] = *(const u32x2*)(z + 4 * lane); ka[i] = *(const unsigned*)(z + 256 + 2 * lane);
                r1[i] = z[384 + (lane & 15)]; r2[i] = z[400 + (lane & 15)];
            }
            const f32x4 g4 = *(const f32x4*)(qg + 4 * lane); const f32x2 g2 = *(const f32x2*)(kg + 2 * lane);
#pragma unroll
            for (int i = 0; i < 8; ++i) {
                const int row = r0 + wave * 8 + i, pos = row & (SEQ - 1);
                const float q0 = bf2f(qa[i].x & 0xffffu), q1 = bf2f(qa[i].x >> 16), q2 = bf2f(qa[i].y & 0xffffu), q3 = bf2f(qa[i].y >> 16);
                const float k0 = bf2f(ka[i] & 0xffffu), k1 = bf2f(ka[i] >> 16);
                const float sq = wave_sum((q0 * q0 + q1 * q1) + (q2 * q2 + q3 * q3), lane), sk = wave_sum(k0 * k0 + k1 * k1, lane);
                const float rq = 1.0f / sqrtf(sq * (1.0f / 256.0f) + EPS), rk = 1.0f / sqrtf(sk * (1.0f / 128.0f) + EPS);
                bf16* o = QKn + (size_t)row * KQKV;
                *(u32x2*)(o + 4 * lane) = (u32x2){cvtpk(q0 * rq * g4[0], q1 * rq * g4[1]), cvtpk(q2 * rq * g4[2], q3 * rq * g4[3])};
                *(unsigned*)(o + 256 + 2 * lane) = cvtpk(k0 * rk * g2[0], k1 * rk * g2[1]);
                if (lane < 16) {
                    const float x1 = bf2f(r1[i]), x2 = bf2f(r2[i]);
                    const f32x2 cs = *(const f32x2*)(T + (size_t)(pos * 16 + lane) * 2);
                    const unsigned pk = cvtpk(x1 * cs[0] - x2 * cs[1], x2 * cs[0] + x1 * cs[1]);
                    bf16* kp = Kp + (size_t)row * QP + 64 + 2 * lane;
#pragma unroll
                    for (int hh = 0; hh < 6; ++hh) *(unsigned*)(kp + hh * 96) = pk;
                }
            }
        }
        asm volatile("s_waitcnt lgkmcnt(0)\n\ts_barrier" ::: "memory");
        {
            const int g = wave >> 1, sub = (wave & 1) * 64 + lane;
#define WSUM(W) do { _Pragma("unroll 4") for (int it_ = 0; it_ < 16; ++it_) { const int id_ = sub + 128 * it_, tt = id_ >> 5, cp = g * 32 + (id_ & 31); \
                unsigned v_[W]; _Pragma("unroll") for (int i = 0; i < W; ++i) v_[i] = *(const LAS unsigned*)(Uw + (15 + tt - i) * 512 + cp * 4); \
                float s0 = 0.f, s1 = 0.f; _Pragma("unroll") for (int i = 0; i < W; ++i) { s0 += bf2f(v_[i] & 0xffffu); s1 += bf2f(v_[i] >> 16); } \
                const float inv = 1.0f / (float)min(tloc0 + tt + 1, W); \
                *(LAS unsigned*)(Pb + tt * 528 + cp * 4) = cvtpk(s0 * inv - bf2f(v_[0] & 0xffffu), s1 * inv - bf2f(v_[0] >> 16)); } } while (0)
            if (g == 0) WSUM(2); else if (g == 1) WSUM(4); else if (g == 2) WSUM(8); else WSUM(16);
#undef WSUM
        }
        asm volatile("s_waitcnt lgkmcnt(0)\n\ts_barrier" ::: "memory");
        {
            const int g = wave >> 1, tb = wave & 1, r = lane & 31, h = lane >> 5;
#pragma unroll
            for (int db = 0; db < 2; ++db) {
                f32x16 acc;
#pragma unroll
                for (int i = 0; i < 16; ++i) acc[i] = 0.f;
#pragma unroll
                for (int ks = 0; ks < 4; ++ks) {
                    const bf16x8 a = *(const LAS bf16x8*)(Wt + ((g * 64 + 32 * db + r) * 72 + 16 * ks + 8 * h) * 2);
                    const bf16x8 b = *(const LAS bf16x8*)(Pb + (32 * tb + r) * 528 + (g * 64 + 16 * ks + 8 * h) * 2);
                    acc = __builtin_amdgcn_mfma_f32_32x32x16_bf16(a, b, acc, 0, 0, 0);
                }
                bf16* yp = Y + (size_t)(r0 + 32 * tb + r) * D + 384 + g * 64 + 32 * db + 4 * h;
                const float* sp = ps + g * 64 + 32 * db + 4 * h;
#pragma unroll
                for (int q = 0; q < 4; ++q) {
                    const f32x4 s4 = *(const f32x4*)(sp + 8 * q);
                    *(u32x2*)(yp + 8 * q) = (u32x2){cvtpk(acc[4 * q] * s4[0], acc[4 * q + 1] * s4[1]), cvtpk(acc[4 * q + 2] * s4[2], acc[4 * q + 3] * s4[3])};
                }
            }
        }
    }
    __syncthreads();
}

__device__ __forceinline__ void scan_phase(CArgsP Ap, int l, LAS unsigned char* lds, int tid, int wave, int lane, int sbid, int SG) {
    unsigned char* ws = Ap->ws;
    bf16* Qp = (bf16*)(ws + WS_QP); bf16* Kp = (bf16*)(ws + WS_KP);
    const float* Fl = (const float*)(ws + WS_FL); const float* fb = Ap->in[I_FOXB] + l * 6;
    LAS double* Sd = (LAS double*)(lds + 114688);
    const int bid = sbid, G = SG;
    for (int sb = bid; sb < NB * 6 * 4; sb += G) {
        const int s = sb >> 2, quarter = sb & 3;
        const int b = s / 6, h = s - b * 6;
        const float bias = fb[h];
        double pre[8]; double run = 0.0;
#pragma unroll
        for (int j = 0; j < 8; ++j) {
            const float x = Fl[(size_t)(b * SEQ + tid * 8 + j) * 8 + h] + bias;
            const float ls = fminf(x, 0.f) - log1pf(expf(-fabsf(x)));
            run += (double)ls; pre[j] = run;
        }
        double inc = run;
#pragma unroll
        for (int o = 1; o < 64; o <<= 1) { const long long iv = __builtin_bit_cast(long long, inc); const int src = ((lane - o) & 63) << 2; const unsigned lo = (unsigned)__builtin_amdgcn_ds_bpermute(src, (int)(unsigned)iv), hi = (unsigned)__builtin_amdgcn_ds_bpermute(src, (int)(unsigned)(iv >> 32)); const double t = __builtin_bit_cast(double, ((unsigned long long)hi << 32) | lo); if (lane >= o) inc += t; }
        __syncthreads();
        if (lane == 63) Sd[wave] = inc;
        __syncthreads();
        double off = inc - run;
        for (int w2 = 0; w2 < wave; ++w2) off += Sd[w2];
        float* C2 = (float*)(ws + WS_C2) + (size_t)s * SEQ;
        if ((tid >> 7) == quarter)
#pragma unroll
        for (int j = 0; j < 8; ++j) {
            const double C = (off + pre[j]) * 1.4426950408889634;
            C2[tid * 8 + j] = (float)C;
            const unsigned c1 = f2bf((float)C); const double r1 = C - (double)bf2f(c1);
            const unsigned c2 = f2bf((float)r1); const double r2 = r1 - (double)bf2f(c2);
            const unsigned c3 = f2bf((float)r2);
            const size_t row = (size_t)b * SEQ + tid * 8 + j;
            u32x4* q = (u32x4*)(Qp + row * QP + (6 + h) * 96 + 64); u32x4* k = (u32x4*)(Kp + row * QP + (6 + h) * 96 + 64);
            const u32x4 z4 = {0u, 0u, 0u, 0u};
            q[0] = (u32x4){c1 | (c2 << 16), c3 | (0x3F80u << 16), 0x3F803F80u, 0u}; q[1] = z4; q[2] = z4; q[3] = z4;
            k[0] = (u32x4){0x3F803F80u, 0x3F80u | ((c1 ^ 0x8000u) << 16), (c2 ^ 0x8000u) | ((c3 ^ 0x8000u) << 16), 0u}; k[1] = z4; k[2] = z4; k[3] = z4;
        }
        __syncthreads();
    }
}

namespace att {
constexpr int KSTR = 208, KBUF = 64 * KSTR, VBUF = 8192, VB0 = 2 * KBUF;
__device__ __forceinline__ int crow(int i, int h) { return (i & 3) + 8 * (i >> 2) + 4 * h; }
typedef short v4i16_t __attribute__((ext_vector_type(4)));
__device__ __forceinline__ s16x4 vtr(const LAS unsigned char* p) { return __builtin_bit_cast(s16x4, __builtin_amdgcn_ds_read_tr16_b64_v4i16((LAS v4i16_t*)p)); }
#define MFMA32(a, b, c) __builtin_amdgcn_mfma_f32_32x32x16_bf16((a), (b), (c), 0, 0, 0)

__device__ __forceinline__ void glds16(const void* gsrc, unsigned lds_dst) { unsigned keep;
    asm volatile("s_mov_b32 %0, m0\n\ts_mov_b32 m0, %2\n\ts_nop 0\n\tglobal_load_lds_dwordx4 %1, off\n\ts_mov_b32 m0, %0" : "=&s"(keep) : "v"(gsrc), "s"(lds_dst) : "memory"); }
constexpr int NSLOT = 4, SLOT = 20480, VOFF = 12288;

__device__ __forceinline__ void attn_unit(LAS unsigned char* lds, const bf16* Qp, const bf16* Kp, const bf16* V, bf16* Y, int b, int head, int qb, int tbase, int tid, int w, int lane) {
    const int r = lane & 31, h = lane >> 5;
    const size_t rowbase = (size_t)b * SEQ; const int q0 = qb * 256;
    const bf16* qptr = Qp + (rowbase + q0 + 32 * w + r) * QP + head * 96 + 8 * h;
    bf16x8 qf[6];
#pragma unroll
    for (int s = 0; s < 6; ++s) qf[s] = *(const bf16x8*)(qptr + 16 * s);
    f32x16 o0, o1, s0, s1;
#pragma unroll
    for (int i = 0; i < 16; ++i) { o0[i] = 0.f; o1[i] = 0.f; s0[i] = 0.f; s1[i] = 0.f; }
    float mref = 0.f, lrun = 0.f;
    f32x16 negm;
#pragma unroll
    for (int i = 0; i < 16; ++i) negm[i] = 0.f;
    const int NT = 4 * (qb + 1) - tbase;
    const size_t rowk = rowbase + (size_t)tbase * 64;
    const bool low = w < 4;
    const unsigned lbase = (unsigned)(uintptr_t)lds;
    const bf16* gA = Kp + (rowk + lane) * QP + head * 96 + w * 8; const unsigned lA = w * 1024;
    const bf16* gB; unsigned lB; size_t stB;
    if (low) { gB = Kp + (rowk + lane) * QP + head * 96 + (w + 8) * 8; lB = (w + 8) * 1024; stB = (size_t)64 * QP; }
    else { gB = V + (rowk + 16 * (w - 4) + (lane >> 2)) * VP + head * 64 + (lane & 3) * 8; lB = VOFF + (w - 4) * 1024; stB = (size_t)64 * VP; }
    const bf16* gC = V + (rowk + 16 * (w & 3) + (lane >> 2)) * VP + head * 64 + 32 + (lane & 3) * 8; const unsigned lC = VOFF + 4096 + (w & 3) * 1024;
#define ISSUE(tt) do { const unsigned sl_ = lbase + ((tt) & 3) * SLOT; \
        glds16(gA, (unsigned)__builtin_amdgcn_readfirstlane(sl_ + lA)); gA += (size_t)64 * QP; \
        glds16(gB, (unsigned)__builtin_amdgcn_readfirstlane(sl_ + lB)); gB += stB; \
        if (low) { glds16(gC, (unsigned)__builtin_amdgcn_readfirstlane(sl_ + lC)); gC += (size_t)64 * VP; } } while (0)
#define WAIT_BAR_DMA(pending) do { if (pending) { if (low) asm volatile("s_waitcnt vmcnt(3) lgkmcnt(0)\n\ts_barrier" ::: "memory"); else asm volatile("s_waitcnt vmcnt(2) lgkmcnt(0)\n\ts_barrier" ::: "memory"); } \
        else asm volatile("s_waitcnt vmcnt(0) lgkmcnt(0)\n\ts_barrier" ::: "memory"); } while (0)
    ISSUE(0); ISSUE(1); ISSUE(2);
    WAIT_BAR_DMA(true);
    const int i16 = lane & 15, q4 = i16 >> 2, p4 = i16 & 3, blk = (lane >> 4) & 1;
    const int voff = VOFF + (4 * h + q4) * 64 + blk * 32 + p4 * 8;
    const int qmin = q0 + 32 * w, qme = qmin + r;
    const LAS unsigned char* kb0 = lds + h * 1024 + r * 16;
    {
#pragma unroll
        for (int st = 0; st < 6; ++st) {
            const bf16x8 a0 = *(const LAS bf16x8*)(kb0 + st * 2048), a1 = *(const LAS bf16x8*)(kb0 + st * 2048 + 512);
            s0 = MFMA32(a0, qf[st], s0); s1 = MFMA32(a1, qf[st], s1);
        }
    }
    asm volatile("s_nop 15\n\ts_nop 15" : "+v"(s0), "+v"(s1));
#define MAX3(a, b, c) __builtin_fmaxf(__builtin_fmaxf((a), (b)), (c))
#define ROWMAX(S0, S1, MX) do { float mxa_ = MAX3(S0[0], S0[1], S1[0]), mxb_ = MAX3(S0[2], S0[3], S1[1]); mxa_ = MAX3(mxa_, S1[2], S1[3]); \
        _Pragma("unroll") for (int i = 4; i < 16; i += 4) { mxa_ = MAX3(mxa_, S0[i], S0[i + 1]); mxb_ = MAX3(mxb_, S0[i + 2], S0[i + 3]); mxa_ = MAX3(mxa_, S1[i], S1[i + 1]); mxb_ = MAX3(mxb_, S1[i + 2], S1[i + 3]); } \
        MX = MAX3(mxa_, mxb_, mxb_); { const float ot_ = lane_xor(MX, lane, 32); MX = MAX3(MX, ot_, ot_); } } while (0)
#define MASK(S0, S1, TT) do { const int kmin_ = 64 * ((TT) + tbase); if (kmin_ + 63 > qmin) { \
        _Pragma("unroll") for (int i = 0; i < 16; ++i) { const int key = kmin_ + crow(i, h); if (key > qme) S0[i] = -INFINITY; if (key + 32 > qme) S1[i] = -INFINITY; } } } while (0)
    { if (NT == 4) MASK(s0, s1, 0); float mx; ROWMAX(s0, s1, mx); mref = mx;
#pragma unroll
      for (int i = 0; i < 16; ++i) { s0[i] -= mx; s1[i] -= mx; negm[i] = -mx; } }
    bool cur_act = true;
#define ATT_ITER(BAND) do { \
        const int kslot = ((t + 1) & 3) * SLOT, vslot = (t & 3) * SLOT; \
        const bool more1 = (t + 1 < NT), more3 = (t + 3 < NT); \
        if (more3) ISSUE(t + 3); \
        const bool next_act = (BAND) ? (more1 && (64 * (t + 1 + tbase) <= qmin + 31)) : true; \
        f32x16 n0, n1; n0 = negm; n1 = negm; \
        const LAS unsigned char* kb = kb0 + kslot; \
        float mx = -INFINITY; \
        if (!(BAND) || cur_act) { \
            bf16x8 pf[2][2]; \
            { \
                if (next_act) { bf16x8 kf[12]; _Pragma("unroll") for (int st = 0; st < 6; ++st) { kf[2 * st] = *(const LAS bf16x8*)(kb + st * 2048); kf[2 * st + 1] = *(const LAS bf16x8*)(kb + st * 2048 + 512); } \
                    _Pragma("unroll") for (int st = 0; st < 6; ++st) { n0 = MFMA32(kf[2 * st], qf[st], n0); n1 = MFMA32(kf[2 * st + 1], qf[st], n1); } } \
                f32x2 sum2 = {0.f, 0.f}; \
                _Pragma("unroll") for (int i = 0; i < 16; i += 2) { \
                    f32x2 a, c; \
                    a[0] = __builtin_amdgcn_exp2f(s0[i]); a[1] = __builtin_amdgcn_exp2f(s0[i + 1]); c[0] = __builtin_amdgcn_exp2f(s1[i]); c[1] = __builtin_amdgcn_exp2f(s1[i + 1]); \
                    s0[i] = a[0]; s0[i + 1] = a[1]; s1[i] = c[0]; s1[i + 1] = c[1]; sum2 += a; sum2 += c; } \
                lrun += sum2[0] + sum2[1]; \
                _Pragma("unroll") for (int s = 0; s < 2; ++s) { \
                    u32x4 a = {cvtpk(s0[8 * s], s0[8 * s + 1]), cvtpk(s0[8 * s + 2], s0[8 * s + 3]), cvtpk(s0[8 * s + 4], s0[8 * s + 5]), cvtpk(s0[8 * s + 6], s0[8 * s + 7])}; \
                    u32x4 c = {cvtpk(s1[8 * s], s1[8 * s + 1]), cvtpk(s1[8 * s + 2], s1[8 * s + 3]), cvtpk(s1[8 * s + 4], s1[8 * s + 5]), cvtpk(s1[8 * s + 6], s1[8 * s + 7])}; \
                    pf[0][s] = __builtin_bit_cast(bf16x8, a); pf[1][s] = __builtin_bit_cast(bf16x8, c); } \
                if (!(BAND)) {   \
                    __builtin_amdgcn_sched_group_barrier(0x100, 4, 0); \
                    _Pragma("unroll") for (int g_ = 0; g_ < 8; ++g_) { __builtin_amdgcn_sched_group_barrier(0x008, 1, 0); __builtin_amdgcn_sched_group_barrier(0x100, 1, 0); __builtin_amdgcn_sched_group_barrier(0x400, 3, 0); __builtin_amdgcn_sched_group_barrier(0x002, 4, 0); } \
                    _Pragma("unroll") for (int g_ = 0; g_ < 4; ++g_) { __builtin_amdgcn_sched_group_barrier(0x008, 1, 0); __builtin_amdgcn_sched_group_barrier(0x400, 3, 0); __builtin_amdgcn_sched_group_barrier(0x002, 4, 0); } } \
            } \
            __builtin_amdgcn_sched_barrier(0); \
            { \
                const LAS unsigned char* vb = lds + vslot + voff; \
                _Pragma("unroll") for (int kb2 = 0; kb2 < 2; ++kb2) \
                    _Pragma("unroll") for (int s = 0; s < 2; ++s) { \
                        const LAS unsigned char* vp = vb + (32 * kb2 + 16 * s) * 64; \
                        const s16x4 l0 = vtr(vp), h0 = vtr(vp + 8 * 64), l1 = vtr(vp + 4096), h1 = vtr(vp + 4096 + 8 * 64); \
                        const bf16x8 v0 = __builtin_shufflevector(l0, h0, 0, 1, 2, 3, 4, 5, 6, 7), v1 = __builtin_shufflevector(l1, h1, 0, 1, 2, 3, 4, 5, 6, 7); \
                        o0 = MFMA32(v0, pf[kb2][s], o0); o1 = MFMA32(v1, pf[kb2][s], o1); } \
                if (next_act) { if (BAND) MASK(n0, n1, t + 1); ROWMAX(n0, n1, mx); } \
            } \
        } else if (next_act) { \
            _Pragma("unroll") for (int st = 0; st < 6; ++st) { const bf16x8 a0 = *(const LAS bf16x8*)(kb + st * 2048), a1 = *(const LAS bf16x8*)(kb + st * 2048 + 512); n0 = MFMA32(a0, qf[st], n0); n1 = MFMA32(a1, qf[st], n1); } \
            MASK(n0, n1, t + 1); ROWMAX(n0, n1, mx); \
        } \
        WAIT_BAR_DMA(more3);                             \
        s0 = n0; s1 = n1; cur_act = next_act; \
        if (__builtin_amdgcn_ballot_w64(mx > 8.0f) != 0ull) { \
            const float dl = fmaxf(mx, 0.f), f = __builtin_amdgcn_exp2f(-dl); \
            mref += dl; lrun *= f; \
            _Pragma("unroll") for (int i = 0; i < 16; ++i) { s0[i] -= dl; s1[i] -= dl; o0[i] *= f; o1[i] *= f; } \
            _Pragma("unroll") for (int i = 0; i < 16; ++i) negm[i] = -mref; \
        } \
    } while (0)
    int t = 0;
    for (; t + 5 < NT; ++t) ATT_ITER(false);
    for (; t < NT; ++t) ATT_ITER(true);
#undef ROWMAX
#undef MASK
#undef ATT_ITER
#undef MAX3
#undef ISSUE
#undef WAIT_BAR_DMA
    const float lt = lrun + lane_xor(lrun, lane, 32);
    const float inv = 1.0f / lt;
    const int ycol = (head < 6) ? head * 64 : 640 + (head - 6) * 64;
    bf16* yp = Y + (rowbase + qme) * D + ycol + 4 * h;
#pragma unroll
    for (int g = 0; g < 4; ++g) {
        *(u32x2*)(yp + 8 * g) = (u32x2){cvtpk(o0[4 * g] * inv, o0[4 * g + 1] * inv), cvtpk(o0[4 * g + 2] * inv, o0[4 * g + 3] * inv)};
        *(u32x2*)(yp + 32 + 8 * g) = (u32x2){cvtpk(o1[4 * g] * inv, o1[4 * g + 1] * inv), cvtpk(o1[4 * g + 2] * inv, o1[4 * g + 3] * inv)};
    }
}
}

#define XB_TMO      128
#define XB_XCNT(j)  (256  + 64 * (j))
#define XB_XSUB(j)  (1280 + 64 * (j))
#define XB_XGEN(j)  (2304 + 64 * (j))
#define XB_TOP      3328
#define XB_TOPGEN   3392
#define XCD_BAR_WORDS 3456
#define XB_SPIN_CAP (1u << 18)

__device__ __forceinline__ unsigned xb_ld(unsigned* p)              { return __hip_atomic_load(p, __ATOMIC_RELAXED, __HIP_MEMORY_SCOPE_AGENT); }
__device__ __forceinline__ unsigned xb_add(unsigned* p, unsigned v) { return __hip_atomic_fetch_add(p, v, __ATOMIC_RELAXED, __HIP_MEMORY_SCOPE_AGENT); }
__device__ __forceinline__ unsigned xb_xcc_id() { return (unsigned)__builtin_amdgcn_s_getreg((3 << 11) | 20) & 0xFu; }
#define XB_SPIN(cond, bar) do { unsigned _sp = 0; while (cond) { __builtin_amdgcn_s_sleep(1); \
    if ((++_sp & 255u) == 0u) { if (xb_ld(&(bar)[XB_TMO])) break; if (_sp > XB_SPIN_CAP) { atomicAdd(&(bar)[XB_TMO], 1u); break; } } } } while (0)

struct XcdBarrier {
    unsigned* bar; unsigned x;
    volatile LAS unsigned* st;
};

__device__ __forceinline__ XcdBarrier xcd_barrier_post(unsigned* bar, volatile LAS unsigned* st) {
    XcdBarrier b; b.bar = bar; b.x = xb_xcc_id(); b.st = st;
    if (threadIdx.x == 0) (void)xb_add(&bar[XB_XCNT(b.x)], 1u);
    return b;
}
__device__ __forceinline__ void xcd_barrier_complete(unsigned* bar, unsigned x, unsigned& nloc, unsigned& nx) {
    const unsigned G = gridDim.x * gridDim.y * gridDim.z;
    unsigned sum, cnt, mine, sp = 0u;
    for (;;) {
        sum = 0u; cnt = 0u; mine = 0u;
#pragma unroll
        for (unsigned j = 0; j < 16; ++j) { const unsigned c = xb_ld(&bar[XB_XCNT(j)]); sum += c; cnt += (c > 0u) ? 1u : 0u; mine = (j == x) ? c : mine; }
        if (sum == G) break;
        __builtin_amdgcn_s_sleep(1);
        if ((++sp & 255u) == 0u) { if (xb_ld(&bar[XB_TMO])) break; if (sp > XB_SPIN_CAP) { atomicAdd(&bar[XB_TMO], 1u); break; } }
    }
    nloc = mine > 0u ? mine : 1u; nx = cnt > 0u ? cnt : 1u;
}

__device__ __forceinline__ void xcd_barrier(const XcdBarrier& b) {
    asm volatile("s_waitcnt vmcnt(0)" ::: "memory");
    __syncthreads();
    if (threadIdx.x == 0) {
        unsigned* bar = b.bar;
        __builtin_amdgcn_s_waitcnt(0);
        unsigned nloc = b.st[0], nx = b.st[1];
        if (nloc == 0u) { xcd_barrier_complete(bar, b.x, nloc, nx); b.st[0] = nloc; b.st[1] = nx; }
        const unsigned old = xb_add(&bar[XB_XSUB(b.x)], 1u);
        const unsigned gen = old / nloc;
        if (old + 1u == (gen + 1u) * nloc) {
            __builtin_amdgcn_fence(__ATOMIC_RELEASE, "agent");
            asm volatile("s_waitcnt vmcnt(0)" ::: "memory");
            const unsigned og = xb_add(&bar[XB_TOP], 1u);
            const unsigned tg = og / nx;
            if (og + 1u == (tg + 1u) * nx) xb_add(&bar[XB_TOPGEN], 1u);
            else XB_SPIN(xb_ld(&bar[XB_TOPGEN]) == tg, bar);
            __builtin_amdgcn_fence(__ATOMIC_ACQUIRE, "agent");
            xb_add(&bar[XB_XGEN(b.x)], 1u);
            asm volatile("s_waitcnt vmcnt(0)" ::: "memory");
        } else {
            XB_SPIN(xb_ld(&bar[XB_XGEN(b.x)]) == gen, bar);
            __builtin_amdgcn_fence(__ATOMIC_ACQUIRE, "agent");
            asm volatile("s_waitcnt vmcnt(0)" ::: "memory");
        }
    }
    __syncthreads();
}

constexpr int LDS_RSTD = LDS_MISC + 256;
__device__ __forceinline__ void fill_rstd(LAS unsigned char* lds, const pg8::StaticOrder& S, const float* ssq, int tid) {
    LAS float* tbl = (LAS float*)(lds + LDS_RSTD);
    pg8::Unit u;
    if (tid < 256) for (int i = 0; i < 8 && S.next(i, u); ++i) tbl[i * 256 + tid] = 1.0f / sqrtf(ssq[u.pm * 256 + tid] * (1.0f / D) + EPS);
    __syncthreads();
}

constexpr int NPH = 1 + 10 * DEPTH;
#ifndef PH_EN
#define PH_EN 0xffff
#endif
#define EN(b) ((PH_EN >> (b)) & 1)
__global__ void __launch_bounds__(512, 2) mk_fwd(Args A_unused) {
    extern __shared__ __attribute__((aligned(16))) unsigned char lds_raw[];
    LAS unsigned char* lds = (LAS unsigned char*)lds_raw;
    cg::grid_group grid = cg::this_grid();
    const int ph_lo = A_unused.ph_lo, ph_hi = A_unused.ph_hi;
    if (threadIdx.x < 64) ((LAS unsigned*)(lds + LDS_MISC))[threadIdx.x] = 0u;
    __syncthreads();
    XcdBarrier bar = xcd_barrier_post((unsigned*)(A_unused.ws + WS_CTL) + CW_BAR, (volatile LAS unsigned*)(lds + LDS_MISC) + 8);
#define PHASE_ENTER() \
    CArgsP Ap = (CArgsP)__builtin_amdgcn_kernarg_segment_ptr(); asm volatile("" : "+s"(Ap)); \
    int tid = threadIdx.x; asm volatile("" : "+v"(tid)); \
    const int lane = tid & 63, wave = __builtin_amdgcn_readfirstlane(tid >> 6); \
    int bid = blockIdx.x, G = gridDim.x; asm volatile("" : "+s"(bid), "+s"(G)); \
    const int gw = bid * 8 + wave, NGW = G * 8; \
    unsigned char* ws = Ap->ws; asm volatile("" : "+s"(ws)); \
    unsigned char* wl = ws + WS_W; \
    int KD = D, KF = F, KQ = KQKV; asm volatile("" : "+s"(KD), "+s"(KF), "+s"(KQ)); \
    (void)lane; (void)gw; (void)NGW; (void)wl; (void)tid; (void)KD; (void)KF; (void)KQ;
#ifdef PROBE_MASK
    unsigned long long tacc = 0;
#endif
    for (int ph = ph_lo; ph < ph_hi; ++ph) {
#ifdef PROBE_MASK
        const unsigned long long tph0 = __builtin_amdgcn_s_memrealtime();
#endif
        int l = 0, k = -1;
        if (ph == NPH - 1) k = 13; else { l = ph / 10; k = ph % 10; }
        asm volatile("" : "+s"(k), "+s"(l));
        if (k == 0) {
            PHASE_ENTER();
            if (EN(12)) prologue(Ap, l, lds, gw, NGW, wave, lane);
        } else if (k == 13) {
            PHASE_ENTER();
            if (EN(0)) norm_phase(Ap->out, Ap->in[I_FINN], nullptr, Ap->out, gw, NGW, lane);
        } else if (EN(1) && (k == 1 || k == 8)) {
            PHASE_ENTER();
            pg8::Gemm g{(const bf16*)(ws + WS_XB), (const bf16*)(wl + (k == 1 ? WL_GU1 : WL_GU2)), M, NGU, KD}; pg8::StaticOrder S; S.init(M, NGU, G, bid);
            const float* ssqp = (const float*)(ws + WS_SSQ) + (size_t)(l * 3 + (k == 1 ? 0 : 2)) * M;
            fill_rstd(lds, S, ssqp, tid);
            EpiSwiglu E{(bf16*)(ws + WS_BIG), ssqp, (const LAS float*)(lds + LDS_RSTD), 0};
            pg8::gemm_phase<EpiSwiglu, pg8::StaticOrder, true, true>(lds, g, S, E);
            if (G == 256 && bid >= 128) convert_items(Ap, l, lds, (k == 1) ? 1 : 3, (bid - 128) * 8 + wave, 1024, wave, lane);
        } else if (EN(2) && (k == 2 || k == 9)) {
            PHASE_ENTER();
            pg8::Gemm g{(const bf16*)(ws + WS_BIG), (const bf16*)(wl + (k == 2 ? WL_DN1 : WL_DN2)), M, D, KF}; pg8::StaticOrder S; S.init(M, D, G, bid);
            EpiResid E{(l == 0 && k == 2) ? Ap->in[I_X] : Ap->out, Ap->out, (bf16*)(ws + WS_XB), (float*)(ws + WS_SSQ) + (size_t)(k == 2 ? l * 3 + 1 : l * 3 + 3) * M, 0.5f};
            pg8::gemm_phase<EpiResid, pg8::StaticOrder, true, true>(lds, g, S, E);
        } else if (EN(4) && k == 3) {
            PHASE_ENTER();
            pg8::Gemm g{(const bf16*)(ws + WS_XB), (const bf16*)(wl + WL_IN), M, NWIN, KD}; pg8::StaticOrder S; S.init(M, NWIN, G, bid);
            fill_rstd(lds, S, (const float*)(ws + WS_SSQ) + (size_t)(l * 3 + 1) * M, tid);
            EpiWin E{(bf16*)(ws + WS_ZS), (bf16*)(ws + WS_U), (bf16*)(ws + WS_QP), (bf16*)(ws + WS_KP), (bf16*)(ws + WS_V), (float*)(ws + WS_FL), (const float*)(ws + WS_SSQ) + (size_t)(l * 3 + 1) * M, (unsigned*)(ws + WS_CTL) + 2048 + l * 96, (const LAS float*)(lds + LDS_RSTD), 0};
            pg8::gemm_phase<EpiWin, pg8::StaticOrder, true, true>(lds, g, S, E);
        } else if (EN(5) && k == 4) {
            PHASE_ENTER();
            prep_phase(Ap, l, lds, tid, wave, lane, bid, G);
        } else if (EN(6) && k == 5) {
            PHASE_ENTER();
            pg8::Gemm g{(const bf16*)(ws + WS_QKN), (const bf16*)(wl + WL_QKV), M, NQKV, KQ}; pg8::StaticOrder S; S.init(M, NQKV, G, bid);
            EpiQKV E{(bf16*)(ws + WS_QP), (bf16*)(ws + WS_KP), (bf16*)(ws + WS_V), (const float*)(ws + WS_ROPE)};
            pg8::gemm_phase<EpiQKV, pg8::StaticOrder, true, true>(lds, g, S, E);
            if (G >= 160) { if (bid >= 128) scan_phase(Ap, l, lds, tid, wave, lane, bid - 128, G - 128); }
            else scan_phase(Ap, l, lds, tid, wave, lane, bid, G);
        } else if (EN(7) && k == 6) {
            PHASE_ENTER();
            LAS unsigned* uw = (LAS unsigned*)(lds + LDS_MISC);
            unsigned* ctl = (unsigned*)(ws + WS_CTL);
            __syncthreads();
            for (int par = 0;; par ^= 1) {
                if (tid == 0) uw[par] = atomicAdd(ctl + 64 * l, 1u);
                asm volatile("s_waitcnt lgkmcnt(0)\n\ts_barrier" ::: "memory");
                const unsigned u = uw[par];
                if (u >= 768u) break;
                const unsigned v = (u < 384u) ? u : u - 384u;
                const int qb = 15 - (int)(v / 24u), bi = (int)(v % 24u), bb = bi / 6, hd = bi % 6 + ((u < 384u) ? 0 : 6);
                int tbase = 0;
                if (hd >= 6) {
                    const float* C2 = (const float*)(ws + WS_C2) + (size_t)(bb * 6 + hd - 6) * SEQ;
                    const float* nr = (const float*)(ws + WS_CTL) + 2048 + l * 96 + (bb * 6 + hd - 6) * 4;
                    const float B2 = 2.0f * (sqrtf((nr[0] + nr[1]) * (nr[2] + nr[3])) * 1.02f + 1.0f);
                    const float cq = C2[qb * 256];
                    const bool skip = (lane < 4 * (qb + 1) - 4) && (B2 + cq - C2[64 * lane + 63] < -160.0f);
                    const unsigned long long mk = __builtin_amdgcn_ballot_w64(skip);
                    tbase = (~mk == 0ull) ? 0 : __builtin_ctzll(~mk);
                    tbase = __builtin_amdgcn_readfirstlane(tbase);
                }
                att::attn_unit(lds, (const bf16*)(ws + WS_QP), (const bf16*)(ws + WS_KP), (const bf16*)(ws + WS_V), (bf16*)(ws + WS_XN), bb, hd, qb, tbase, tid, wave, lane);
            }
        } else if (EN(8) && k == 7) {
            PHASE_ENTER();
            pg8::Gemm g{(const bf16*)(ws + WS_XN), (const bf16*)(wl + WL_OUT), M, D, KD}; pg8::StaticOrder S; S.init(M, D, G, bid);
            EpiResid E{Ap->out, Ap->out, (bf16*)(ws + WS_XB), (float*)(ws + WS_SSQ) + (size_t)(l * 3 + 2) * M, 1.0f};
            pg8::gemm_phase<EpiResid, pg8::StaticOrder, true, true>(lds, g, S, E);
        }
        if (ph + 1 < ph_hi) { if (ph_hi > 1000) grid.sync(); xcd_barrier(bar); }
#ifdef PROBE_MASK
        if ((PROBE_MASK >> k) & 1) tacc += __builtin_amdgcn_s_memrealtime() - tph0;
#endif
    }
#ifdef PROBE_MASK
    if (blockIdx.x == 0) { const unsigned long long tend = __builtin_amdgcn_s_memrealtime() + 4ull * tacc; while (__builtin_amdgcn_s_memrealtime() < tend) __builtin_amdgcn_s_sleep(32); }
#endif
}

extern "C" void kernel_launch(void* const* d_in, const int* in_sizes, int n_in, void* d_out, int out_size, void* d_ws, size_t ws_size, hipStream_t stream) {
    static int grid = 0;
    if (grid == 0) {
        if (n_in != 18 || out_size != M * D || ws_size < WS_END) { fprintf(stderr, "kernel_launch: unexpected problem (n_in %d out %d ws %zu need %zu)\n", n_in, out_size, ws_size, (size_t)WS_END); grid = -1; return; }
        int dev = 0, cus = 0, per_cu = 0;
        hipGetDevice(&dev); hipDeviceGetAttribute(&cus, hipDeviceAttributeMultiprocessorCount, dev);
        if (hipFuncSetAttribute((const void*)mk_fwd, hipFuncAttributeMaxDynamicSharedMemorySize, LDS_BYTES) != hipSuccess) { fprintf(stderr, "kernel_launch: hipFuncSetAttribute failed\n"); grid = -1; return; }
        if (hipOccupancyMaxActiveBlocksPerMultiprocessor(&per_cu, (const void*)mk_fwd, 512, LDS_BYTES) != hipSuccess || per_cu < 1) { fprintf(stderr, "kernel_launch: occupancy query says %d\n", per_cu); per_cu = 1; }
        (void)hipGetLastError();
        grid = cus * per_cu;
        fprintf(stderr, "kernel_launch: grid %d (cus %d x %d)\n", grid, cus, per_cu);
        if (grid < 192) fprintf(stderr, "kernel_launch: this build keeps per-unit row scales for at most 8 GEMM units per workgroup (needs >= 176 workgroups); grid %d is too small\n", grid);
    }
    if (grid < 0) return;
    (void)hipMemsetAsync((char*)d_ws + WS_CTL, 0, CTL_BYTES, stream);
    Args a{};
    for (int i = 0; i < 18; ++i) a.in[i] = (const float*)d_in[i];
    a.out = (float*)d_out; a.ws = (unsigned char*)d_ws;
#if MK_MULTI
    for (int ph = 0; ph < NPH; ++ph) { a.ph_lo = ph; a.ph_hi = ph + 1; hipLaunchKernelGGL(mk_fwd, dim3(grid), dim3(512), LDS_BYTES, stream, a); }
#else
    a.ph_lo = 0; a.ph_hi = NPH;
    void* args[] = {&a};
    hipError_t e = hipLaunchCooperativeKernel((const void*)mk_fwd, dim3(grid), dim3(512), args, LDS_BYTES, stream);
    if (e != hipSuccess) fprintf(stderr, "kernel_launch: cooperative launch failed: %s (grid %d)\n", hipGetErrorString(e), grid);
#endif
}
```

```cpp
#include <hip/hip_runtime.h>
#include <hip/hip_cooperative_groups.h>
#include <cstdio>
#include <cstdint>
namespace cg = cooperative_groups;
#ifndef MK_MULTI
#define MK_MULTI 0
#endif
namespace pg8 {
#define PG8_LAS __attribute__((address_space(3)))
typedef unsigned short bf16_t;
typedef short bf16x8 __attribute__((ext_vector_type(8)));
typedef float f32x4 __attribute__((ext_vector_type(4)));
typedef unsigned u32x4 __attribute__((ext_vector_type(4)));
constexpr int BM = 256, BK = 64, HALF = 128, HTB = HALF * BK * 2  , STAGE_BYTES = 8 * HTB, NXCD = 8, WGM = 8;

__host__ __device__ __forceinline__ int lds_byte(int r, int c) { const int st = (r >> 4) * 2 + (c >> 5), rr = r & 15, cc = c & 31, ob = rr * 64 + cc * 2; return st * 1024 + (ob ^ (((ob >> 9) & 1) << 5)); }
__host__ __device__ __forceinline__ void stage_rc(int b, int& R, int& C) { const int st = b / 1024, sb = b % 1024, swz = sb ^ (((sb >> 9) & 1) << 5); R = (st >> 1) * 16 + swz / 64; C = (st & 1) * 32 + (swz % 64) / 2; }
__host__ __device__ __forceinline__ int perm32(int rho) { const int n = rho >> 4, i = rho & 15; return 8 * (i >> 2) + 4 * n + (i & 3); }

struct Unit { int pm, pn; };
struct Gemm { const bf16_t* A; const bf16_t* Bt; int M, N, K; };

struct StaticOrder {
    int nM, nN, nwg, G, c;
    __host__ __device__ void init(int M, int N, int G_, int c_) { nM = M / BM; nN = N / BM; nwg = nM * nN; G = G_; c = c_; }
    __host__ __device__ bool next(int i, Unit& u) const {
        const long L = (long)i * G + c; if (L >= nwg) return false;
        int wgid = (int)L; { const int q = nwg / NXCD, r = nwg % NXCD, xcd = wgid % NXCD, off = wgid / NXCD; wgid = (xcd < r ? xcd * (q + 1) : r * (q + 1) + (xcd - r) * q) + off; }
        const int nig = WGM * nN, gid = wgid / nig, fm = gid * WGM, gsz = (nM - fm) < WGM ? (nM - fm) : WGM;
        u.pm = fm + ((wgid % nig) % gsz); u.pn = (wgid % nig) / gsz; return true;
    }
    __device__ __forceinline__ void a_ready(const Unit&) const {}
    __device__ __forceinline__ void done(const Unit&) const {}
};
typedef float f32x2 __attribute__((ext_vector_type(2)));
template <class Epi, class Sched, bool ALIGN_EPI = false, bool SP2 = false>
__device__ __forceinline__ void gemm_phase(PG8_LAS unsigned char* lds, const Gemm g, const Sched& S, const Epi& E) {
    int tid = threadIdx.x; asm volatile("" : "+v"(tid)); const int wid = __builtin_amdgcn_readfirstlane(tid >> 6), lane = tid & 63, wr = wid >> 2, wc = wid & 3, fr = lane & 15, fq = lane >> 4;
    const int K = g.K, nt = K / BK;
    unsigned voffA[2], voffB[2];
#pragma unroll
    for (int i = 0; i < 2; ++i) { int R, C; stage_rc(tid * 16 + i * 8192, R, C); const int Rb = Epi::PERM ? ((R & ~31) + perm32(R & 31)) : R;
        voffA[i] = (unsigned)(R * K + C) * 2u; voffB[i] = (unsigned)(Rb * K + C) * 2u; }
    const size_t kstep = (size_t)(BK * 2);
    const size_t hstep = (size_t)HALF * K * 2;
    const size_t tstep = 2 * hstep;
    const unsigned ldsw = (unsigned)wid * 1024u;
    const int aoff = lds_byte(wr * 64 + fr, fq * 8), boff = lds_byte(wc * 32 + fr, fq * 8);
#define PG8_SA(b, h) (((b) * 2 + (h)) * HTB)
#define PG8_SB(b, h) ((4 + (b) * 2 + (h)) * HTB)
#define PG8_STAGE(bufoff, gbase, voff) do { _Pragma("unroll") for (int _i = 0; _i < 2; ++_i) \
        __builtin_amdgcn_global_load_lds((const unsigned*)((const char*)(gbase) + (voff)[_i]), (PG8_LAS unsigned*)(lds + (bufoff) + ldsw + _i * 8192), 16, 0, 0); } while (0)
#define PG8_LDA(dst, b, h) do { _Pragma("unroll") for (int m = 0; m < 4; ++m) _Pragma("unroll") for (int k = 0; k < 2; ++k) dst[m][k] = *(const PG8_LAS bf16x8*)(lds + PG8_SA(b, h) + aoff + m * 2048 + k * 1024); } while (0)
#define PG8_LDB(dst, b, h) do { _Pragma("unroll") for (int n = 0; n < 2; ++n) _Pragma("unroll") for (int k = 0; k < 2; ++k) dst[n][k] = *(const PG8_LAS bf16x8*)(lds + PG8_SB(b, h) + boff + n * 2048 + k * 1024); } while (0)
#define PG8_MMA(ai, bj, At, Bt) do { __builtin_amdgcn_s_setprio(1); _Pragma("unroll") for (int m = 0; m < 4; ++m) _Pragma("unroll") for (int n = 0; n < 2; ++n) _Pragma("unroll") for (int k = 0; k < 2; ++k) \
        acc[ai][bj][m][n] = __builtin_amdgcn_mfma_f32_16x16x32_bf16(Bt[n][k], At[m][k], acc[ai][bj][m][n], 0, 0, 0); __builtin_amdgcn_s_setprio(0); } while (0)
#define PG8_WAIT_V(n) asm volatile("s_waitcnt vmcnt(" #n ")" ::: "memory")
#define PG8_WAIT_L(n) asm volatile("s_waitcnt lgkmcnt(" #n ")" ::: "memory")
#define PG8_BAR __builtin_amdgcn_s_barrier()
#define PG8_SCHED __builtin_amdgcn_sched_barrier(0)
    Unit cur, nxt; int ui = 0;
    if (!S.next(0, cur)) return;
    f32x4 acc[2][2][4][2];
#pragma unroll
    for (int a = 0; a < 2; ++a)
#pragma unroll
        for (int b = 0; b < 2; ++b)
#pragma unroll
            for (int m = 0; m < 4; ++m)
#pragma unroll
                for (int n = 0; n < 2; ++n) acc[a][b][m][n] = (f32x4){0.f, 0.f, 0.f, 0.f};
    bf16x8 At[4][2], B0[2][2], B1[2][2];
    const char* cA = (const char*)g.A + (size_t)cur.pm * tstep; const char* cB = (const char*)g.Bt + (size_t)cur.pn * tstep;
    S.a_ready(cur);
    if constexpr (SP2) {
        PG8_STAGE(PG8_SB(0, 0), cB, voffB); PG8_STAGE(PG8_SB(0, 1), cB + hstep, voffB); PG8_STAGE(PG8_SA(0, 0), cA, voffA); PG8_STAGE(PG8_SA(0, 1), cA + hstep, voffA);
        if (wr == 1) PG8_BAR;
        PG8_WAIT_V(2); PG8_BAR;
        PG8_STAGE(PG8_SB(1, 0), cB + kstep, voffB); PG8_STAGE(PG8_SA(1, 0), cA + kstep, voffA); PG8_STAGE(PG8_SB(1, 1), cB + hstep + kstep, voffB);
        PG8_WAIT_V(6); PG8_BAR;
    } else {
        PG8_STAGE(PG8_SB(0, 0), cB, voffB); PG8_STAGE(PG8_SA(0, 0), cA, voffA); PG8_STAGE(PG8_SB(0, 1), cB + hstep, voffB); PG8_STAGE(PG8_SA(0, 1), cA + hstep, voffA);
        if (wr == 1) PG8_BAR;
        PG8_WAIT_V(4); PG8_BAR;
        PG8_STAGE(PG8_SB(1, 0), cB + kstep, voffB); PG8_STAGE(PG8_SA(1, 0), cA + kstep, voffA); PG8_STAGE(PG8_SB(1, 1), cB + hstep + kstep, voffB);
        PG8_WAIT_V(6); PG8_BAR;
    }
    for (;;) {
        const bool has_next = S.next(ui + 1, nxt);
        const char* nA = has_next ? (const char*)g.A + (size_t)nxt.pm * tstep : cA; const char* nB = has_next ? (const char*)g.Bt + (size_t)nxt.pn * tstep : cB;
        for (int t = 0; t < nt; t += 2) {
            const bool last = (t == nt - 2);
            const char* a1 = cA + (size_t)(t + 1) * kstep;
            const char* a2 = last ? nA : cA + (size_t)(t + 2) * kstep; const char* b2 = last ? nB : cB + (size_t)(t + 2) * kstep;
            const char* a3 = a2 + kstep; const char* b3 = b2 + kstep;
            if (last && has_next) S.a_ready(nxt);
            if constexpr (SP2) {
            PG8_LDB(B0, 0, 0); PG8_LDB(B1, 0, 1); PG8_SCHED; PG8_LDA(At, 0, 0); PG8_STAGE(PG8_SA(1, 1), a1 + hstep, voffA);
            PG8_WAIT_V(8); PG8_WAIT_L(0); PG8_BAR; PG8_MMA(0, 0, At, B0); PG8_MMA(0, 1, At, B1); PG8_BAR; PG8_SCHED;
            PG8_LDA(At, 0, 1); PG8_STAGE(PG8_SB(0, 0), b2, voffB); PG8_STAGE(PG8_SB(0, 1), b2 + hstep, voffB); PG8_STAGE(PG8_SA(0, 0), a2, voffA);
            PG8_WAIT_V(8); PG8_WAIT_L(0); PG8_BAR; PG8_MMA(1, 0, At, B0); PG8_MMA(1, 1, At, B1); PG8_BAR; PG8_SCHED;
            PG8_LDB(B0, 1, 0); PG8_LDB(B1, 1, 1); PG8_SCHED; PG8_LDA(At, 1, 0); PG8_STAGE(PG8_SA(0, 1), a2 + hstep, voffA);
            PG8_WAIT_V(8); PG8_WAIT_L(0); PG8_BAR; PG8_MMA(0, 0, At, B0); PG8_MMA(0, 1, At, B1); PG8_BAR; PG8_SCHED;
            PG8_LDA(At, 1, 1); PG8_STAGE(PG8_SB(1, 0), b3, voffB); PG8_STAGE(PG8_SB(1, 1), b3 + hstep, voffB); PG8_STAGE(PG8_SA(1, 0), a3, voffA);
            PG8_WAIT_V(8); PG8_WAIT_L(0); PG8_BAR; PG8_MMA(1, 0, At, B0); PG8_MMA(1, 1, At, B1); PG8_BAR; PG8_SCHED;
            } else {
            PG8_LDB(B0, 0, 0); PG8_SCHED; PG8_LDA(At, 0, 0); PG8_STAGE(PG8_SA(1, 1), a1 + hstep, voffA);
            PG8_WAIT_L(8); PG8_BAR; PG8_WAIT_L(0); PG8_MMA(0, 0, At, B0); PG8_BAR; PG8_SCHED;
            PG8_LDB(B1, 0, 1); PG8_STAGE(PG8_SB(0, 0), b2, voffB);
            PG8_BAR; PG8_WAIT_L(0); PG8_MMA(0, 1, At, B1); PG8_BAR;
            PG8_LDA(At, 0, 1); PG8_STAGE(PG8_SA(0, 0), a2, voffA);
            PG8_BAR; PG8_WAIT_L(0); PG8_MMA(1, 0, At, B0); PG8_BAR; PG8_SCHED;
            PG8_STAGE(PG8_SB(0, 1), b2 + hstep, voffB);
            PG8_WAIT_V(6); PG8_BAR; PG8_MMA(1, 1, At, B1); PG8_BAR;
            PG8_LDB(B0, 1, 0); PG8_SCHED; PG8_LDA(At, 1, 0); PG8_STAGE(PG8_SA(0, 1), a2 + hstep, voffA);
            PG8_WAIT_L(8); PG8_BAR; PG8_WAIT_L(0); PG8_MMA(0, 0, At, B0); PG8_BAR; PG8_SCHED;
            PG8_LDB(B1, 1, 1); PG8_STAGE(PG8_SB(1, 0), b3, voffB);
            PG8_BAR; PG8_WAIT_L(0); PG8_MMA(0, 1, At, B1); PG8_BAR;
            PG8_LDA(At, 1, 1); PG8_STAGE(PG8_SA(1, 0), a3, voffA);
            PG8_BAR; PG8_WAIT_L(0); PG8_MMA(1, 0, At, B0); PG8_BAR; PG8_SCHED;
            PG8_STAGE(PG8_SB(1, 1), b3 + hstep, voffB);
            PG8_WAIT_V(6); PG8_BAR; PG8_MMA(1, 1, At, B1); PG8_BAR;
            }
        }
        if constexpr (ALIGN_EPI) { if (wr == 0) PG8_BAR; }
        if constexpr (!Epi::AFTER_DRAIN) { E(acc, cur, wr, wc, fr, fq); S.done(cur); }
        if (!has_next) break;
#pragma unroll
        for (int a = 0; a < 2; ++a)
#pragma unroll
            for (int b = 0; b < 2; ++b)
#pragma unroll
                for (int m = 0; m < 4; ++m)
#pragma unroll
                    for (int n = 0; n < 2; ++n) acc[a][b][m][n] = (f32x4){0.f, 0.f, 0.f, 0.f};
        cur = nxt; cA = nA; cB = nB; ++ui;
        if constexpr (ALIGN_EPI) { if (wr == 1) PG8_BAR; }
    }
    PG8_WAIT_V(0);
    if constexpr (!ALIGN_EPI) { if (wr == 0) PG8_BAR; }
    PG8_BAR;
    if constexpr (Epi::AFTER_DRAIN) { E.fused(acc, cur, wr, wc, fr, fq, lds, wid, lane); S.done(cur); }
#undef PG8_SA
#undef PG8_SB
#undef PG8_STAGE
#undef PG8_LDA
#undef PG8_LDB
#undef PG8_MMA
#undef PG8_WAIT_V
#undef PG8_WAIT_L
#undef PG8_BAR
#undef PG8_SCHED
}
}

constexpr int M = 16384, SEQ = 4096, NB = 4, D = 1024, F = 2816, DEPTH = 2;
constexpr int N_IN = 1830;
constexpr int NGU = 2 * F;
constexpr int NWIN = 2048;
constexpr int NQKV = 1536, KQKV = 384;
constexpr int QP = 1152, VP = 768;
constexpr float EPS = 1e-6f;
constexpr float LOG2E = 1.4426950408889634f;
constexpr float QS_MLA = 0.14724444f;
constexpr float QS_FOX = 0.18033688f;

constexpr size_t MiB = 1u << 20;
constexpr size_t WS_CTL = 0;
constexpr int CW_BAR = 4096;
constexpr size_t WS_SSQ = 65536;
constexpr size_t CTL_BYTES = 65536 + 7 * 65536;
constexpr size_t WS_ROPE = 1 * MiB;
constexpr size_t WS_C2 = 512 * 1024;
constexpr size_t WS_BND = 960 * 1024;
constexpr size_t WS_FL = 1 * MiB + 512 * 1024;
constexpr size_t WS_W = 2 * MiB;
constexpr size_t WL_GU1 = 0, WL_GU2 = 11 * MiB, WL_DN1 = 22 * MiB, WL_DN2 = 22 * MiB + 5632 * 1024, WL_IN = 33 * MiB, WL_OUT = 37 * MiB, WL_QKV = 39 * MiB;
constexpr size_t WL_STRIDE = 41 * MiB;
constexpr size_t WS_XB = 43 * MiB;
constexpr size_t WS_XN = 75 * MiB;
constexpr size_t WS_BIG = 107 * MiB;
constexpr size_t WS_ZS = WS_BIG, WS_U = WS_BIG + 16 * MiB, WS_QKN = WS_BIG + 24 * MiB, WS_QP = WS_BIG + 36 * MiB, WS_KP = WS_BIG + 72 * MiB, WS_V = WS_BIG + 108 * MiB;
constexpr size_t WS_END = WS_BIG + 132 * MiB;
static_assert(WL_QKV + (size_t)NQKV * KQKV * 2 <= WL_STRIDE && WS_W + WL_STRIDE <= WS_XB, "weights map");
static_assert(WS_QKN + (size_t)M * KQKV * 2 <= WS_QP && WS_V + (size_t)M * VP * 2 <= WS_END && WS_BIG + (size_t)M * F * 2 <= WS_END, "act map");

constexpr int LDS_BYTES = 147456;
constexpr int LDS_MISC = 131072 + 4096;

#define LAS __attribute__((address_space(3)))
typedef unsigned short bf16;
typedef float f32x4 __attribute__((ext_vector_type(4)));
typedef float f32x2 __attribute__((ext_vector_type(2)));
typedef float f32x16 __attribute__((ext_vector_type(16)));
typedef unsigned u32x4 __attribute__((ext_vector_type(4)));
typedef unsigned u32x2 __attribute__((ext_vector_type(2)));
typedef short bf16x8 __attribute__((ext_vector_type(8)));
typedef short s16x4 __attribute__((ext_vector_type(4)));
typedef __bf16 bf16x2_t __attribute__((ext_vector_type(2)));

__device__ __forceinline__ unsigned cvtpk(float lo, float hi) { f32x2 v = {lo, hi}; bf16x2_t b = __builtin_convertvector(v, bf16x2_t); return __builtin_bit_cast(unsigned, b); }
__device__ __forceinline__ unsigned f2bf(float f) { unsigned u = __builtin_bit_cast(unsigned, f); return (u + 0x7fffu + ((u >> 16) & 1u)) >> 16; }
__device__ __forceinline__ float bf2f(unsigned b) { return __builtin_bit_cast(float, b << 16); }
__device__ __forceinline__ float lane_xor(float v, int lane, int o) { return __builtin_bit_cast(float, __builtin_amdgcn_ds_bpermute((lane ^ o) << 2, __builtin_bit_cast(int, v))); }
__device__ __forceinline__ float wave_sum(float v, int lane) {
#pragma unroll
    for (int o = 1; o < 64; o <<= 1) v += lane_xor(v, lane, o);
    return v;
}
__device__ __forceinline__ void store8nt(bf16* p, f32x4 a, f32x4 b) { u32x4 w; w.x = cvtpk(a[0], a[1]); w.y = cvtpk(a[2], a[3]); w.z = cvtpk(b[0], b[1]); w.w = cvtpk(b[2], b[3]); __builtin_nontemporal_store(w, (u32x4*)p); }
__device__ __forceinline__ void store8(bf16* p, f32x4 a, f32x4 b) { u32x4 w; w.x = cvtpk(a[0], a[1]); w.y = cvtpk(a[2], a[3]); w.z = cvtpk(b[0], b[1]); w.w = cvtpk(b[2], b[3]); *(u32x4*)p = w; }

struct EpiSwiglu {
    static constexpr bool PERM = true, AFTER_DRAIN = false;
    bf16* O; const float* ssq; const LAS float* tbl; mutable int ucount;
    __device__ __forceinline__ void operator()(const pg8::f32x4 (&acc)[2][2][4][2], const pg8::Unit& u, int wr, int wc, int fr, int fq) const {
        asm volatile("" : "+v"(fr), "+v"(fq));
        const int row0 = u.pm * 256 + wr * 64 + fr, col0 = u.pn * 128 + wc * 32 + 8 * fq;
#pragma unroll
        for (int ai = 0; ai < 2; ++ai)
#pragma unroll
            for (int m = 0; m < 4; ++m) {
                bf16* rowp = O + (size_t)(row0 + ai * 128 + m * 16) * F + col0;
                const float rs = tbl[(ucount & 7) * 256 + wr * 64 + fr + ai * 128 + m * 16], nrs = -rs * LOG2E;
                f32x4 r[2];
#pragma unroll
                for (int n = 0; n < 2; ++n) {
                    const f32x4 g = acc[ai][0][m][n], uu = acc[ai][1][m][n];
#pragma unroll
                    for (int j = 0; j < 4; ++j) { const float e = __builtin_amdgcn_exp2f(g[j] * nrs); r[n][j] = (g[j] * rs) * __builtin_amdgcn_rcpf(1.0f + e) * (uu[j] * rs); }
                }
                store8nt(rowp, r[0], r[1]);
            }
        ++ucount;
    }
};
struct EpiResid {
    static constexpr bool PERM = true, AFTER_DRAIN = false;
    const float* base; float* out; bf16* xb; float* ssq; float scale;
    __device__ __forceinline__ void operator()(const pg8::f32x4 (&acc)[2][2][4][2], const pg8::Unit& u, int wr, int wc, int fr, int fq) const {
        asm volatile("" : "+v"(fr), "+v"(fq));
        const int row0 = u.pm * 256 + wr * 64 + fr, col0 = u.pn * 256 + wc * 32 + 8 * fq;
#pragma unroll
        for (int ai = 0; ai < 2; ++ai)
#pragma unroll
            for (int m = 0; m < 4; ++m) {
                const size_t off = (size_t)(row0 + ai * 128 + m * 16) * D + col0;
                float sq = 0.f;
#pragma unroll
                for (int bj = 0; bj < 2; ++bj) {
                    const size_t p = off + bj * 128;
                    const f32x4 b0 = __builtin_nontemporal_load((const f32x4*)(base + p)), b1 = __builtin_nontemporal_load((const f32x4*)(base + p + 4));
                    const f32x4 o0 = b0 + acc[ai][bj][m][0] * scale, o1 = b1 + acc[ai][bj][m][1] * scale;
                    __builtin_nontemporal_store(o0, (f32x4*)(out + p)); __builtin_nontemporal_store(o1, (f32x4*)(out + p + 4));
                    store8(xb + p, o0, o1);
                    sq += ((o0[0] * o0[0] + o0[1] * o0[1]) + (o0[2] * o0[2] + o0[3] * o0[3])) + ((o1[0] * o1[0] + o1[1] * o1[1]) + (o1[2] * o1[2] + o1[3] * o1[3]));
                }
                { const int ln = fq * 16 + fr; sq += lane_xor(sq, ln, 16); sq += lane_xor(sq, ln, 32); if (fq == 0) atomicAdd(ssq + row0 + ai * 128 + m * 16, sq); }
                asm volatile("" ::: "memory");
            }
    }
};
struct EpiWin {
    static constexpr bool PERM = true, AFTER_DRAIN = false;
    bf16 *Zs, *U, *Qp, *Kp, *V; float* Fl; const float* ssq; unsigned* nrm; const LAS float* tbl; mutable int ucount;
    __device__ __forceinline__ void operator()(const pg8::f32x4 (&acc)[2][2][4][2], const pg8::Unit& u, int wr, int wc, int fr, int fq) const {
        asm volatile("" : "+v"(fr), "+v"(fq));
        const int row0 = u.pm * 256 + wr * 64 + fr;
#pragma unroll
        for (int bj = 0; bj < 2; ++bj) {
            const int c0 = u.pn * 256 + bj * 128 + wc * 32 + 8 * fq;
            bf16* dst; int pitch; float sc = 1.0f; bool f32too = false; int nslot = -1;
            if (c0 < 512) { dst = Zs + c0; pitch = 512; f32too = (c0 == 416); }
            else if (c0 < 768) { dst = U + (c0 - 512); pitch = 256; }
            else if (c0 < 1920) {
                const int e = c0 - 768, seg = e / 384, w = e - seg * 384, hh = w >> 6, d = w & 63;
                if (seg == 0) { dst = Qp + (6 + hh) * 96 + d; pitch = QP; sc = QS_FOX; nslot = hh * 4 + (d >> 5); }
                else if (seg == 1) { dst = Kp + (6 + hh) * 96 + d; pitch = QP; nslot = hh * 4 + 2 + (d >> 5); }
                else { dst = V + (6 + hh) * 64 + d; pitch = VP; }
            } else continue;
            float nmax = 0.f;
#pragma unroll
            for (int ai = 0; ai < 2; ++ai)
#pragma unroll
                for (int m = 0; m < 4; ++m) {
                    const int row = row0 + ai * 128 + m * 16;
                    const float rs = tbl[(ucount & 7) * 256 + wr * 64 + fr + ai * 128 + m * 16], scr = sc * rs;
                    const f32x4 v0 = acc[ai][bj][m][0] * scr, v1 = acc[ai][bj][m][1] * scr;
                    store8(dst + (size_t)row * pitch, v0, v1);
                    if (nslot >= 0) { float s2 = ((v0[0] * v0[0] + v0[1] * v0[1]) + (v0[2] * v0[2] + v0[3] * v0[3])) + ((v1[0] * v1[0] + v1[1] * v1[1]) + (v1[2] * v1[2] + v1[3] * v1[3]));
                        const int ln = fq * 16 + fr; s2 += lane_xor(s2, ln, 16); s2 += lane_xor(s2, ln, 32); nmax = fmaxf(nmax, s2); }
                    if (f32too) { *(f32x4*)(Fl + (size_t)row * 8) = acc[ai][bj][m][0] * rs; *(f32x4*)(Fl + (size_t)row * 8 + 4) = acc[ai][bj][m][1] * rs; }
                }
            if (nslot >= 0) { const int ln = fq * 16 + fr;
#pragma unroll
                for (int o = 1; o < 16; o <<= 1) nmax = fmaxf(nmax, lane_xor(nmax, ln, o));
                if (fr == 0 && fq == 0) atomicMax(nrm + ((u.pm >> 4) * 6) * 4 + nslot, __builtin_bit_cast(unsigned, nmax)); }
        }
        ++ucount;
    }
};
struct EpiQKV {
    static constexpr bool PERM = true, AFTER_DRAIN = false;
    bf16 *Qp, *Kp, *V; const float* rope;
    __device__ __forceinline__ void operator()(const pg8::f32x4 (&acc)[2][2][4][2], const pg8::Unit& u, int wr, int wc, int fr, int fq) const {
        asm volatile("" : "+v"(fr), "+v"(fq));
        const int row0 = u.pm * 256 + wr * 64 + fr;
#pragma unroll
        for (int bj = 0; bj < 2; ++bj) {
            const int c0 = u.pn * 256 + bj * 128 + wc * 32 + 8 * fq;
            if (c0 < 576) {
                const int head = c0 / 96, d = c0 - head * 96;
                bf16* dst = Qp + head * 96 + d;
                if (d < 64) {
#pragma unroll
                    for (int ai = 0; ai < 2; ++ai)
#pragma unroll
                        for (int m = 0; m < 4; ++m) { const int row = row0 + ai * 128 + m * 16; store8(dst + (size_t)row * QP, acc[ai][bj][m][0] * QS_MLA, acc[ai][bj][m][1] * QS_MLA); }
                } else {
                    const int a = (d - 64) >> 3;
                    f32x4 t0[2][4], t1[2][4];
#pragma unroll
                    for (int ai = 0; ai < 2; ++ai)
#pragma unroll
                        for (int m = 0; m < 4; ++m) { const int pos = (row0 + ai * 128 + m * 16) & (SEQ - 1);
                            t0[ai][m] = *(const f32x4*)(rope + (size_t)(pos * 16 + 4 * a) * 2); t1[ai][m] = *(const f32x4*)(rope + (size_t)(pos * 16 + 4 * a) * 2 + 4); }
                    asm volatile("" ::: "memory");
#pragma unroll
                    for (int ai = 0; ai < 2; ++ai)
#pragma unroll
                        for (int m = 0; m < 4; ++m) {
                            const int row = row0 + ai * 128 + m * 16;
                            const f32x4 x = acc[ai][bj][m][0], y = acc[ai][bj][m][1], c0v = t0[ai][m], c1v = t1[ai][m];
                            f32x4 ox, oy;
                            ox[0] = x[0] * c0v[0] - x[1] * c0v[1]; ox[1] = x[1] * c0v[0] + x[0] * c0v[1]; ox[2] = x[2] * c0v[2] - x[3] * c0v[3]; ox[3] = x[3] * c0v[2] + x[2] * c0v[3];
                            oy[0] = y[0] * c1v[0] - y[1] * c1v[1]; oy[1] = y[1] * c1v[0] + y[0] * c1v[1]; oy[2] = y[2] * c1v[2] - y[3] * c1v[3]; oy[3] = y[3] * c1v[2] + y[2] * c1v[3];
                            store8(dst + (size_t)row * QP, ox * QS_MLA, oy * QS_MLA);
                        }
                }
            } else if (c0 < 1344) {
                const int e = c0 - 576, head = e >> 7, d = e & 127;
                bf16* dst; int pitch;
                if (d < 64) { dst = Kp + head * 96 + d; pitch = QP; } else { dst = V + head * 64 + (d - 64); pitch = VP; }
#pragma unroll
                for (int ai = 0; ai < 2; ++ai)
#pragma unroll
                    for (int m = 0; m < 4; ++m) { const int row = row0 + ai * 128 + m * 16; store8(dst + (size_t)row * pitch, acc[ai][bj][m][0], acc[ai][bj][m][1]); }
            }
        }
    }
};

struct Args {
    const float* in[18];
    float* out; unsigned char* ws;
    int ph_lo, ph_hi;
};
typedef const __attribute__((address_space(4))) Args* CArgsP;
enum { I_X = 0, I_F1N, I_F1GU, I_F1DN, I_MIXN, I_WIN, I_QAN, I_WQB, I_KVAN, I_WKVB, I_POOLW, I_POOLS, I_FOXB, I_WOUT, I_F2N, I_F2GU, I_F2DN, I_FINN };

struct ConvDesc { const float* wp; const float* gain; bf16* wt; int Nsrc, Ksrc, koff, Kdst, k0; bool okc; };
__device__ __forceinline__ void conv_set(ConvDesc& d, const float* W, int Nsrc, int Ksrc, int sc, int koff, bf16* WT, int Kdst, int k0, int n0, int lane, const float* gain) {
    d.okc = sc >= 0; d.Nsrc = Nsrc; d.Ksrc = Ksrc; d.koff = koff; d.Kdst = Kdst; d.k0 = k0;
    d.wp = W + (size_t)(k0 - koff + (lane >> 5)) * Nsrc + (d.okc ? sc : 0);
    d.wt = WT + (size_t)n0 * Kdst + k0; d.gain = gain ? gain + k0 : nullptr;
}
__device__ __forceinline__ void conv_load(const ConvDesc& d, float (&v)[32], int lane) {
#pragma unroll
    for (int i = 0; i < 32; ++i) {
        const int ks = d.k0 + 2 * i + (lane >> 5) - d.koff;
        const bool ok = d.okc && ks >= 0 && ks < d.Ksrc;
        v[i] = ok ? __builtin_nontemporal_load(d.wp + (size_t)(2 * i) * d.Nsrc) : 0.f;
    }
}
__device__ __forceinline__ void conv_store(const ConvDesc& d, const float (&v)[32], LAS float* scr, int lane) {
    const int c = lane & 7;
    f32x4 g0 = {1.f, 1.f, 1.f, 1.f}, g1 = {1.f, 1.f, 1.f, 1.f};
    if (d.gain) { g0 = *(const f32x4*)(d.gain + 8 * c); g1 = *(const f32x4*)(d.gain + 8 * c + 4); }
#pragma unroll
    for (int i = 0; i < 32; ++i) scr[(2 * i + (lane >> 5)) * 33 + (lane & 31)] = v[i];
    asm volatile("s_waitcnt lgkmcnt(0)" ::: "memory");
#pragma unroll
    for (int j = 0; j < 4; ++j) {
        const int n = (lane >> 3) + 8 * j; const LAS float* s = scr + (8 * c) * 33 + n;
        u32x4 o; o.x = cvtpk(s[0 * 33] * g0[0], s[1 * 33] * g0[1]); o.y = cvtpk(s[2 * 33] * g0[2], s[3 * 33] * g0[3]); o.z = cvtpk(s[4 * 33] * g1[0], s[5 * 33] * g1[1]); o.w = cvtpk(s[6 * 33] * g1[2], s[7 * 33] * g1[3]);
        *(u32x4*)(d.wt + (size_t)n * d.Kdst + 8 * c) = o;
    }
    asm volatile("s_waitcnt lgkmcnt(0)" ::: "memory");
}
constexpr int IT_GU = 16 * (NGU / 32), IT_DN = (F / 64) * (D / 32), IT_IN = 16 * (NWIN / 32), IT_QKV = (KQKV / 64) * (NQKV / 32), IT_OUT = 16 * (D / 32);
constexpr int IT_LAYER = 2 * IT_GU + 2 * IT_DN + IT_IN + IT_QKV + IT_OUT;
__device__ __forceinline__ void conv_decode(ConvDesc& d, CArgsP Ap, int l, unsigned char* wl, int it, int lane) {
    int r = it; const int nl = lane & 31;
    if (r < 2 * IT_GU) {
        const int f = r / IT_GU; r -= f * IT_GU;
        const float* W = Ap->in[f ? I_F2GU : I_F1GU] + (size_t)l * D * NGU;
        const int nblk = NGU / 32, kb = r / nblk, nb = r - kb * nblk, n = nb * 32 + nl, tile = n >> 8, w = n & 255;
        const int sc = (w < 128) ? tile * 128 + w : F + tile * 128 + (w - 128);
        conv_set(d, W, NGU, D, sc, 0, (bf16*)(wl + (f ? WL_GU2 : WL_GU1)), D, kb * 64, nb * 32, lane, Ap->in[f ? I_F2N : I_F1N] + l * D);
        return;
    }
    r -= 2 * IT_GU;
    if (r < 2 * IT_DN) {
        const int f = r / IT_DN; r -= f * IT_DN;
        const float* W = Ap->in[f ? I_F2DN : I_F1DN] + (size_t)l * F * D;
        const int nblk = D / 32, kb = r / nblk, nb = r - kb * nblk;
        conv_set(d, W, D, F, nb * 32 + nl, 0, (bf16*)(wl + (f ? WL_DN2 : WL_DN1)), F, kb * 64, nb * 32, lane, nullptr);
        return;
    }
    r -= 2 * IT_DN;
    if (r < IT_IN) {
        const float* W = Ap->in[I_WIN] + (size_t)l * D * N_IN;
        const int nblk = NWIN / 32, kb = r / nblk, nb = r - kb * nblk, n = nb * 32 + nl;
        int sc = -1;
        if (n < 416) sc = n; else if (n < 422) sc = 1824 + (n - 416); else if (n < 512) sc = -1; else if (n < 768) sc = 416 + (n - 512); else if (n < 1920) sc = 672 + (n - 768);
        conv_set(d, W, N_IN, D, sc, 0, (bf16*)(wl + WL_IN), D, kb * 64, nb * 32, lane, Ap->in[I_MIXN] + l * D);
        return;
    }
    r -= IT_IN;
    if (r < IT_QKV) {
        const int nblk = NQKV / 32, kb = r / nblk, nb = r - kb * nblk, n = nb * 32 + nl;
        if (n < 576) {
            const int head = n / 96, dd = n - head * 96; int sd = dd;
            if (dd >= 64) { const int j2 = dd - 64; sd = 64 + (j2 >> 1) + 16 * (j2 & 1); }
            conv_set(d, Ap->in[I_WQB] + (size_t)l * 256 * 576, 576, 256, head * 96 + sd, 0, (bf16*)(wl + WL_QKV), KQKV, kb * 64, nb * 32, lane, nullptr);
        } else {
            const int sc = (n < 1344) ? n - 576 : -1;
            conv_set(d, Ap->in[I_WKVB] + (size_t)l * 128 * 768, 768, 128, sc, 256, (bf16*)(wl + WL_QKV), KQKV, kb * 64, nb * 32, lane, nullptr);
        }
        return;
    }
    r -= IT_QKV;
    {
        const float* W = Ap->in[I_WOUT] + (size_t)l * D * D;
        const int nblk = D / 32, kb = r / nblk, nb = r - kb * nblk;
        conv_set(d, W, D, D, nb * 32 + nl, 0, (bf16*)(wl + WL_OUT), D, kb * 64, nb * 32, lane, nullptr);
    }
}

constexpr int IT_P0 = 2 * IT_GU, IT_P1 = IT_LAYER - IT_P0 - IT_DN, IT_P3 = IT_DN;
__device__ __forceinline__ int conv_remap(int pass, int x) {
    if (pass == 2 || pass == 0) return x;
    if (pass == 3) return 2 * IT_GU + IT_DN + x;
    return (x < IT_DN) ? 2 * IT_GU + x : 2 * IT_GU + IT_DN + x;
}
__device__ __forceinline__ void convert_items(CArgsP Ap, int l, LAS unsigned char* lds, int pass, int gw, int NGW, int wave, int lane) {
    LAS float* scr = (LAS float*)(lds + wave * 16384);
    unsigned char* wl = Ap->ws + WS_W;
    const int NIT = (pass == 2) ? IT_LAYER : (pass == 0 ? IT_P0 : (pass == 1 ? IT_P1 : IT_P3));
    ConvDesc dA, dB; float va[32], vb[32];
    int it = gw;
    if (it < NIT) { conv_decode(dA, Ap, l, wl, conv_remap(pass, it), lane); conv_load(dA, va, lane); }
    while (it < NIT) {
        const int it2 = it + NGW; const bool has2 = it2 < NIT;
        if (has2) { conv_decode(dB, Ap, l, wl, conv_remap(pass, it2), lane); conv_load(dB, vb, lane); }
        conv_store(dA, va, scr, lane);
        if (!has2) break;
        const int it3 = it2 + NGW; const bool has3 = it3 < NIT;
        if (has3) { conv_decode(dA, Ap, l, wl, conv_remap(pass, it3), lane); conv_load(dA, va, lane); }
        conv_store(dB, vb, scr, lane);
        if (!has3) break;
        it = it3;
    }
}
__device__ __forceinline__ void prologue(CArgsP Ap, int l, LAS unsigned char* lds, int gw, int NGW, int wave, int lane) {
    unsigned char* ws = Ap->ws;
    convert_items(Ap, l, lds, (NGW == 2048) ? 0 : 2, gw, NGW, wave, lane);
    if (l != 0) return;
    {
        const float* x = Ap->in[I_X]; bf16* xb = (bf16*)(ws + WS_XB); float* ssq = (float*)(ws + WS_SSQ);
        f32x4 cur[4], nxtv[4];
        if (gw < M) { const f32x4* xr = (const f32x4*)(x + (size_t)gw * D) + lane;
#pragma unroll
            for (int j = 0; j < 4; ++j) cur[j] = __builtin_nontemporal_load(xr + 64 * j); }
        for (int row = gw; row < M; row += NGW) {
            const int rn = row + NGW;
            if (rn < M) { const f32x4* xr = (const f32x4*)(x + (size_t)rn * D) + lane;
#pragma unroll
                for (int j = 0; j < 4; ++j) nxtv[j] = __builtin_nontemporal_load(xr + 64 * j); }
            u32x2* o = (u32x2*)(xb + (size_t)row * D) + lane; float s = 0.f;
#pragma unroll
            for (int j = 0; j < 4; ++j) { const f32x4 v = cur[j]; s += (v[0] * v[0] + v[1] * v[1]) + (v[2] * v[2] + v[3] * v[3]); o[64 * j] = (u32x2){cvtpk(v[0], v[1]), cvtpk(v[2], v[3])}; }
            s = wave_sum(s, lane);
            if (lane == 0) ssq[row] = s;
#pragma unroll
            for (int j = 0; j < 4; ++j) cur[j] = nxtv[j];
        }
    }
    float* T = (float*)(ws + WS_ROPE);
    for (int e = gw * 64 + lane; e < SEQ * 16; e += NGW * 64) {
        const int pos = e >> 4, j = e & 15;
        const float inv = exp2f(-(float)j * 0.8304820237218405f);
        const float ang = (float)pos * inv;
        const double a = (double)ang, k = __builtin_rint(a * 0.15915494309189535), x = a - k * 6.283185307179586, x2 = x * x;
        double s = x, c = 1.0, ts = x, tc = 1.0;
#pragma unroll 1
        for (int i = 1; i <= 12; ++i) {
            tc = -tc * x2 / (double)((2 * i - 1) * (2 * i)); c += tc;
            ts = -ts * x2 / (double)((2 * i) * (2 * i + 1)); s += ts;
        }
        *(f32x2*)(T + (size_t)e * 2) = (f32x2){(float)c, (float)s};
    }
}

__device__ __forceinline__ void norm_phase(const float* x, const float* g, bf16* xn, float* fout, int gw, int NGW, int lane) {
    f32x4 gv[4];
#pragma unroll
    for (int j = 0; j < 4; ++j) gv[j] = *((const f32x4*)g + lane + 64 * j);
    for (int row = gw; row < M; row += NGW) {
        const f32x4* xr = (const f32x4*)(x + (size_t)row * D) + lane;
        f32x4 v[4]; float s = 0.f;
#pragma unroll
        for (int j = 0; j < 4; ++j) { v[j] = xr[64 * j]; s += (v[j][0] * v[j][0] + v[j][1] * v[j][1]) + (v[j][2] * v[j][2] + v[j][3] * v[j][3]); }
        const float rstd = 1.0f / sqrtf(wave_sum(s, lane) * (1.0f / D) + EPS);
        if (fout) {
            f32x4* o = (f32x4*)(fout + (size_t)row * D) + lane;
#pragma unroll
            for (int j = 0; j < 4; ++j) o[64 * j] = (v[j] * rstd) * gv[j];
        } else {
            u32x2* o = (u32x2*)(xn + (size_t)row * D) + lane;
#pragma unroll
            for (int j = 0; j < 4; ++j) { const f32x4 y = (v[j] * rstd) * gv[j]; o[64 * j] = (u32x2){cvtpk(y[0], y[1]), cvtpk(y[2], y[3])}; }
        }
    }
}

__device__ __forceinline__ void prep_phase(CArgsP Ap, int l, LAS unsigned char* lds, int tid, int wave, int lane, int bid, int G) {
    unsigned char* ws = Ap->ws;
    const bf16* Zs = (const bf16*)(ws + WS_ZS); const bf16* U = (const bf16*)(ws + WS_U);
    bf16* QKn = (bf16*)(ws + WS_QKN); bf16* Qp = (bf16*)(ws + WS_QP); bf16* Kp = (bf16*)(ws + WS_KP); bf16* Y = (bf16*)(ws + WS_XN);
    const float* T = (const float*)(ws + WS_ROPE); const float* Fl = (const float*)(ws + WS_FL);
    const float* qg = Ap->in[I_QAN] + l * 256; const float* kg = Ap->in[I_KVAN] + l * 128;
    const float* pw = Ap->in[I_POOLW] + (size_t)l * 4 * 4096; const float* ps = Ap->in[I_POOLS] + l * 256;
    const float* fb = Ap->in[I_FOXB] + l * 6;
    LAS unsigned char* Uw = lds;
    LAS unsigned char* Wt = lds + 40960;
    LAS unsigned char* Pb = lds + 40960 + 36864;
    LAS double* Sd = (LAS double*)(lds + 114688);
    for (int idx = tid; idx < 4096; idx += 512) {
        const int g = idx >> 10, c = (idx >> 4) & 63, d4 = (idx & 15) * 4;
        const f32x4 w = *(const f32x4*)(pw + g * 4096 + c * 64 + d4);
#pragma unroll
        for (int i = 0; i < 4; ++i) *(LAS unsigned short*)(Wt + ((g * 64 + d4 + i) * 72 + c) * 2) = (unsigned short)f2bf(w[i]);
    }
    for (int tile = bid; tile < M / 64; tile += G) {
        const int r0 = tile * 64, tloc0 = r0 & (SEQ - 1);
        __syncthreads();
        for (int idx = tid; idx < 79 * 32; idx += 512) {
            const int i = idx >> 5, c8 = (idx & 31) * 8; u32x4 v = {0u, 0u, 0u, 0u};
            if (tloc0 - 15 + i >= 0) v = *(const u32x4*)(U + (size_t)(r0 - 15 + i) * 256 + c8);
            *(LAS u32x4*)(Uw + i * 512 + c8 * 2) = v;
        }
        {
            u32x2 qa[8]; unsigned ka[8]; unsigned short r1[8], r2[8];
#pragma unroll
            for (int i = 0; i < 8; ++i) {
                const bf16* z = Zs + (size_t)(r0 + wave * 8 + i) * 512;
                qa[i] = *(const u32x2*)(z + 4 * lane); ka[i] = *(const unsigned*)(z + 256 + 2 * lane);
                r1[i] = z[384 + (lane & 15)]; r2[i] = z[400 + (lane & 15)];
            }
            const f32x4 g4 = *(const f32x4*)(qg + 4 * lane); const f32x2 g2 = *(const f32x2*)(kg + 2 * lane);
#pragma unroll
            for (int i = 0; i < 8; ++i) {
                const int row = r0 + wave * 8 + i, pos = row & (SEQ - 1);
                const float q0 = bf2f(qa[i].x & 0xffffu), q1 = bf2f(qa[i].x >> 16), q2 = bf2f(qa[i].y & 0xffffu), q3 = bf2f(qa[i].y >> 16);
                const float k0 = bf2f(ka[i] & 0xffffu), k1 = bf2f(ka[i] >> 16);
                const float sq = wave_sum((q0 * q0 + q1 * q1) + (q2 * q2 + q3 * q3), lane), sk = wave_sum(k0 * k0 + k1 * k1, lane);
                const float rq = 1.0f / sqrtf(sq * (1.0f / 256.0f) + EPS), rk = 1.0f / sqrtf(sk * (1.0f / 128.0f) + EPS);
                bf16* o = QKn + (size_t)row * KQKV;
                *(u32x2*)(o + 4 * lane) = (u32x2){cvtpk(q0 * rq * g4[0], q1 * rq * g4[1]), cvtpk(q2 * rq * g4[2], q3 * rq * g4[3])};
                *(unsigned*)(o + 256 + 2 * lane) = cvtpk(k0 * rk * g2[0], k1 * rk * g2[1]);
                if (lane < 16) {
                    const float x1 = bf2f(r1[i]), x2 = bf2f(r2[i]);
                    const f32x2 cs = *(const f32x2*)(T + (size_t)(pos * 16 + lane) * 2);
                    const unsigned pk = cvtpk(x1 * cs[0] - x2 * cs[1], x2 * cs[0] + x1 * cs[1]);
                    bf16* kp = Kp + (size_t)row * QP + 64 + 2 * lane;
#pragma unroll
                    for (int hh = 0; hh < 6; ++hh) *(unsigned*)(kp + hh * 96) = pk;
                }
            }
        }
        asm volatile("s_waitcnt lgkmcnt(0)\n\ts_barrier" ::: "memory");
        {
            const int g = wave >> 1, sub = (wave & 1) * 64 + lane;
#define WSUM(W) do { _Pragma("unroll 4") for (int it_ = 0; it_ < 16; ++it_) { const int id_ = sub + 128 * it_, tt = id_ >> 5, cp = g * 32 + (id_ & 31); \
                unsigned v_[W]; _Pragma("unroll") for (int i = 0; i < W; ++i) v_[i] = *(const LAS unsigned*)(Uw + (15 + tt - i) * 512 + cp * 4); \
                float s0 = 0.f, s1 = 0.f; _Pragma("unroll") for (int i = 0; i < W; ++i) { s0 += bf2f(v_[i] & 0xffffu); s1 += bf2f(v_[i] >> 16); } \
                const float inv = 1.0f / (float)min(tloc0 + tt + 1, W); \
                *(LAS unsigned*)(Pb + tt * 528 + cp * 4) = cvtpk(s0 * inv - bf2f(v_[0] & 0xffffu), s1 * inv - bf2f(v_[0] >> 16)); } } while (0)
            if (g == 0) WSUM(2); else if (g == 1) WSUM(4); else if (g == 2) WSUM(8); else WSUM(16);
#undef WSUM
        }
        asm volatile("s_waitcnt lgkmcnt(0)\n\ts_barrier" ::: "memory");
        {
            const int g = wave >> 1, tb = wave & 1, r = lane & 31, h = lane >> 5;
#pragma unroll
            for (int db = 0; db < 2; ++db) {
                f32x16 acc;
#pragma unroll
                for (int i = 0; i < 16; ++i) acc[i] = 0.f;
#pragma unroll
                for (int ks = 0; ks < 4; ++ks) {
                    const bf16x8 a = *(const LAS bf16x8*)(Wt + ((g * 64 + 32 * db + r) * 72 + 16 * ks + 8 * h) * 2);
                    const bf16x8 b = *(const LAS bf16x8*)(Pb + (32 * tb + r) * 528 + (g * 64 + 16 * ks + 8 * h) * 2);
                    acc = __builtin_amdgcn_mfma_f32_32x32x16_bf16(a, b, acc, 0, 0, 0);
                }
                bf16* yp = Y + (size_t)(r0 + 32 * tb + r) * D + 384 + g * 64 + 32 * db + 4 * h;
                const float* sp = ps + g * 64 + 32 * db + 4 * h;
#pragma unroll
                for (int q = 0; q < 4; ++q) {
                    const f32x4 s4 = *(const f32x4*)(sp + 8 * q);
                    *(u32x2*)(yp + 8 * q) = (u32x2){cvtpk(acc[4 * q] * s4[0], acc[4 * q + 1] * s4[1]), cvtpk(acc[4 * q + 2] * s4[2], acc[4 * q + 3] * s4[3])};
                }
            }
        }
    }
    __syncthreads();
}

__device__ __forceinline__ void scan_phase(CArgsP Ap, int l, LAS unsigned char* lds, int tid, int wave, int lane, int sbid, int SG) {
    unsigned char* ws = Ap->ws;
    bf16* Qp = (bf16*)(ws + WS_QP); bf16* Kp = (bf16*)(ws + WS_KP);
    const float* Fl = (const float*)(ws + WS_FL); const float* fb = Ap->in[I_FOXB] + l * 6;
    LAS double* Sd = (LAS double*)(lds + 114688);
    const int bid = sbid, G = SG;
    for (int sb = bid; sb < NB * 6 * 4; sb += G) {
        const int s = sb >> 2, quarter = sb & 3;
        const int b = s / 6, h = s - b * 6;
        const float bias = fb[h];
        double pre[8]; double run = 0.0;
#pragma unroll
        for (int j = 0; j < 8; ++j) {
            const float x = Fl[(size_t)(b * SEQ + tid * 8 + j) * 8 + h] + bias;
            const float ls = fminf(x, 0.f) - log1pf(expf(-fabsf(x)));
            run += (double)ls; pre[j] = run;
        }
        double inc = run;
#pragma unroll
        for (int o = 1; o < 64; o <<= 1) { const long long iv = __builtin_bit_cast(long long, inc); const int src = ((lane - o) & 63) << 2; const unsigned lo = (unsigned)__builtin_amdgcn_ds_bpermute(src, (int)(unsigned)iv), hi = (unsigned)__builtin_amdgcn_ds_bpermute(src, (int)(unsigned)(iv >> 32)); const double t = __builtin_bit_cast(double, ((unsigned long long)hi << 32) | lo); if (lane >= o) inc += t; }
        __syncthreads();
        if (lane == 63) Sd[wave] = inc;
        __syncthreads();
        double off = inc - run;
        for (int w2 = 0; w2 < wave; ++w2) off += Sd[w2];
        float* C2 = (float*)(ws + WS_C2) + (size_t)s * SEQ;
        if ((tid >> 7) == quarter)
#pragma unroll
        for (int j = 0; j < 8; ++j) {
            const double C = (off + pre[j]) * 1.4426950408889634;
            C2[tid * 8 + j] = (float)C;
            const unsigned c1 = f2bf((float)C); const double r1 = C - (double)bf2f(c1);
            const unsigned c2 = f2bf((float)r1); const double r2 = r1 - (double)bf2f(c2);
            const unsigned c3 = f2bf((float)r2);
            const size_t row = (size_t)b * SEQ + tid * 8 + j;
            u32x4* q = (u32x4*)(Qp + row * QP + (6 + h) * 96 + 64); u32x4* k = (u32x4*)(Kp + row * QP + (6 + h) * 96 + 64);
            const u32x4 z4 = {0u, 0u, 0u, 0u};
            q[0] = (u32x4){c1 | (c2 << 16), c3 | (0x3F80u << 16), 0x3F803F80u, 0u}; q[1] = z4; q[2] = z4; q[3] = z4;
            k[0] = (u32x4){0x3F803F80u, 0x3F80u | ((c1 ^ 0x8000u) << 16), (c2 ^ 0x8000u) | ((c3 ^ 0x8000u) << 16), 0u}; k[1] = z4; k[2] = z4; k[3] = z4;
        }
        __syncthreads();
    }
}

namespace att {
constexpr int KSTR = 208, KBUF = 64 * KSTR, VBUF = 8192, VB0 = 2 * KBUF;
__device__ __forceinline__ int crow(int i, int h) { return (i & 3) + 8 * (i >> 2) + 4 * h; }
typedef short v4i16_t __attribute__((ext_vector_type(4)));
__device__ __forceinline__ s16x4 vtr(const LAS unsigned char* p) { return __builtin_bit_cast(s16x4, __builtin_amdgcn_ds_read_tr16_b64_v4i16((LAS v4i16_t*)p)); }
#define MFMA32(a, b, c) __builtin_amdgcn_mfma_f32_32x32x16_bf16((a), (b), (c), 0, 0, 0)

__device__ __forceinline__ void glds16(const void* gsrc, unsigned lds_dst) { unsigned keep;
    asm volatile("s_mov_b32 %0, m0\n\ts_mov_b32 m0, %2\n\ts_nop 0\n\tglobal_load_lds_dwordx4 %1, off\n\ts_mov_b32 m0, %0" : "=&s"(keep) : "v"(gsrc), "s"(lds_dst) : "memory"); }
constexpr int NSLOT = 4, SLOT = 20480, VOFF = 12288;

__device__ __forceinline__ void attn_unit(LAS unsigned char* lds, const bf16* Qp, const bf16* Kp, const bf16* V, bf16* Y, int b, int head, int qb, int tbase, int tid, int w, int lane) {
    const int r = lane & 31, h = lane >> 5;
    const size_t rowbase = (size_t)b * SEQ; const int q0 = qb * 256;
    const bf16* qptr = Qp + (rowbase + q0 + 32 * w + r) * QP + head * 96 + 8 * h;
    bf16x8 qf[6];
#pragma unroll
    for (int s = 0; s < 6; ++s) qf[s] = *(const bf16x8*)(qptr + 16 * s);
    f32x16 o0, o1, s0, s1;
#pragma unroll
    for (int i = 0; i < 16; ++i) { o0[i] = 0.f; o1[i] = 0.f; s0[i] = 0.f; s1[i] = 0.f; }
    float mref = 0.f, lrun = 0.f;
    f32x16 negm;
#pragma unroll
    for (int i = 0; i < 16; ++i) negm[i] = 0.f;
    const int NT = 4 * (qb + 1) - tbase;
    const size_t rowk = rowbase + (size_t)tbase * 64;
    const bool low = w < 4;
    const unsigned lbase = (unsigned)(uintptr_t)lds;
    const bf16* gA = Kp + (rowk + lane) * QP + head * 96 + w * 8; const unsigned lA = w * 1024;
    const bf16* gB; unsigned lB; size_t stB;
    if (low) { gB = Kp + (rowk + lane) * QP + head * 96 + (w + 8) * 8; lB = (w + 8) * 1024; stB = (size_t)64 * QP; }
    else { gB = V + (rowk + 16 * (w - 4) + (lane >> 2)) * VP + head * 64 + (lane & 3) * 8; lB = VOFF + (w - 4) * 1024; stB = (size_t)64 * VP; }
    const bf16* gC = V + (rowk + 16 * (w & 3) + (lane >> 2)) * VP + head * 64 + 32 + (lane & 3) * 8; const unsigned lC = VOFF + 4096 + (w & 3) * 1024;
#define ISSUE(tt) do { const unsigned sl_ = lbase + ((tt) & 3) * SLOT; \
        glds16(gA, (unsigned)__builtin_amdgcn_readfirstlane(sl_ + lA)); gA += (size_t)64 * QP; \
        glds16(gB, (unsigned)__builtin_amdgcn_readfirstlane(sl_ + lB)); gB += stB; \
        if (low) { glds16(gC, (unsigned)__builtin_amdgcn_readfirstlane(sl_ + lC)); gC += (size_t)64 * VP; } } while (0)
#define WAIT_BAR_DMA(pending) do { if (pending) { if (low) asm volatile("s_waitcnt vmcnt(3) lgkmcnt(0)\n\ts_barrier" ::: "memory"); else asm volatile("s_waitcnt vmcnt(2) lgkmcnt(0)\n\ts_barrier" ::: "memory"); } \
        else asm volatile("s_waitcnt vmcnt(0) lgkmcnt(0)\n\ts_barrier" ::: "memory"); } while (0)
    ISSUE(0); ISSUE(1); ISSUE(2);
    WAIT_BAR_DMA(true);
    const int i16 = lane & 15, q4 = i16 >> 2, p4 = i16 & 3, blk = (lane >> 4) & 1;
    const int voff = VOFF + (4 * h + q4) * 64 + blk * 32 + p4 * 8;
    const int qmin = q0 + 32 * w, qme = qmin + r;
    const LAS unsigned char* kb0 = lds + h * 1024 + r * 16;
    {
#pragma unroll
        for (int st = 0; st < 6; ++st) {
            const bf16x8 a0 = *(const LAS bf16x8*)(kb0 + st * 2048), a1 = *(const LAS bf16x8*)(kb0 + st * 2048 + 512);
            s0 = MFMA32(a0, qf[st], s0); s1 = MFMA32(a1, qf[st], s1);
        }
    }
    asm volatile("s_nop 15\n\ts_nop 15" : "+v"(s0), "+v"(s1));
#define MAX3(a, b, c) __builtin_fmaxf(__builtin_fmaxf((a), (b)), (c))
#define ROWMAX(S0, S1, MX) do { float mxa_ = MAX3(S0[0], S0[1], S1[0]), mxb_ = MAX3(S0[2], S0[3], S1[1]); mxa_ = MAX3(mxa_, S1[2], S1[3]); \
        _Pragma("unroll") for (int i = 4; i < 16; i += 4) { mxa_ = MAX3(mxa_, S0[i], S0[i + 1]); mxb_ = MAX3(mxb_, S0[i + 2], S0[i + 3]); mxa_ = MAX3(mxa_, S1[i], S1[i + 1]); mxb_ = MAX3(mxb_, S1[i + 2], S1[i + 3]); } \
        MX = MAX3(mxa_, mxb_, mxb_); { const float ot_ = lane_xor(MX, lane, 32); MX = MAX3(MX, ot_, ot_); } } while (0)
#define MASK(S0, S1, TT) do { const int kmin_ = 64 * ((TT) + tbase); if (kmin_ + 63 > qmin) { \
        _Pragma("unroll") for (int i = 0; i < 16; ++i) { const int key = kmin_ + crow(i, h); if (key > qme) S0[i] = -INFINITY; if (key + 32 > qme) S1[i] = -INFINITY; } } } while (0)
    { if (NT == 4) MASK(s0, s1, 0); float mx; ROWMAX(s0, s1, mx); mref = mx;
#pragma unroll
      for (int i = 0; i < 16; ++i) { s0[i] -= mx; s1[i] -= mx; negm[i] = -mx; } }
    bool cur_act = true;
#define ATT_ITER(BAND) do { \
        const int kslot = ((t + 1) & 3) * SLOT, vslot = (t & 3) * SLOT; \
        const bool more1 = (t + 1 < NT), more3 = (t + 3 < NT); \
        if (more3) ISSUE(t + 3); \
        const bool next_act = (BAND) ? (more1 && (64 * (t + 1 + tbase) <= qmin + 31)) : true; \
        f32x16 n0, n1; n0 = negm; n1 = negm; \
        const LAS unsigned char* kb = kb0 + kslot; \
        float mx = -INFINITY; \
        if (!(BAND) || cur_act) { \
            bf16x8 pf[2][2]; \
            { \
                if (next_act) { bf16x8 kf[12]; _Pragma("unroll") for (int st = 0; st < 6; ++st) { kf[2 * st] = *(const LAS bf16x8*)(kb + st * 2048); kf[2 * st + 1] = *(const LAS bf16x8*)(kb + st * 2048 + 512); } \
                    _Pragma("unroll") for (int st = 0; st < 6; ++st) { n0 = MFMA32(kf[2 * st], qf[st], n0); n1 = MFMA32(kf[2 * st + 1], qf[st], n1); } } \
                f32x2 sum2 = {0.f, 0.f}; \
                _Pragma("unroll") for (int i = 0; i < 16; i += 2) { \
                    f32x2 a, c; \
                    a[0] = __builtin_amdgcn_exp2f(s0[i]); a[1] = __builtin_amdgcn_exp2f(s0[i + 1]); c[0] = __builtin_amdgcn_exp2f(s1[i]); c[1] = __builtin_amdgcn_exp2f(s1[i + 1]); \
                    s0[i] = a[0]; s0[i + 1] = a[1]; s1[i] = c[0]; s1[i + 1] = c[1]; sum2 += a; sum2 += c; } \
                lrun += sum2[0] + sum2[1]; \
                _Pragma("unroll") for (int s = 0; s < 2; ++s) { \
                    u32x4 a = {cvtpk(s0[8 * s], s0[8 * s + 1]), cvtpk(s0[8 * s + 2], s0[8 * s + 3]), cvtpk(s0[8 * s + 4], s0[8 * s + 5]), cvtpk(s0[8 * s + 6], s0[8 * s + 7])}; \
                    u32x4 c = {cvtpk(s1[8 * s], s1[8 * s + 1]), cvtpk(s1[8 * s + 2], s1[8 * s + 3]), cvtpk(s1[8 * s + 4], s1[8 * s + 5]), cvtpk(s1[8 * s + 6], s1[8 * s + 7])}; \
                    pf[0][s] = __builtin_bit_cast(bf16x8, a); pf[1][s] = __builtin_bit_cast(bf16x8, c); } \
                if (!(BAND)) {   \
                    __builtin_amdgcn_sched_group_barrier(0x100, 4, 0); \
                    _Pragma("unroll") for (int g_ = 0; g_ < 8; ++g_) { __builtin_amdgcn_sched_group_barrier(0x008, 1, 0); __builtin_amdgcn_sched_group_barrier(0x100, 1, 0); __builtin_amdgcn_sched_group_barrier(0x400, 3, 0); __builtin_amdgcn_sched_group_barrier(0x002, 4, 0); } \
                    _Pragma("unroll") for (int g_ = 0; g_ < 4; ++g_) { __builtin_amdgcn_sched_group_barrier(0x008, 1, 0); __builtin_amdgcn_sched_group_barrier(0x400, 3, 0); __builtin_amdgcn_sched_group_barrier(0x002, 4, 0); } } \
            } \
            __builtin_amdgcn_sched_barrier(0); \
            { \
                const LAS unsigned char* vb = lds + vslot + voff; \
                _Pragma("unroll") for (int kb2 = 0; kb2 < 2; ++kb2) \
                    _Pragma("unroll") for (int s = 0; s < 2; ++s) { \
                        const LAS unsigned char* vp = vb + (32 * kb2 + 16 * s) * 64; \
                        const s16x4 l0 = vtr(vp), h0 = vtr(vp + 8 * 64), l1 = vtr(vp + 4096), h1 = vtr(vp + 4096 + 8 * 64); \
                        const bf16x8 v0 = __builtin_shufflevector(l0, h0, 0, 1, 2, 3, 4, 5, 6, 7), v1 = __builtin_shufflevector(l1, h1, 0, 1, 2, 3, 4, 5, 6, 7); \
                        o0 = MFMA32(v0, pf[kb2][s], o0); o1 = MFMA32(v1, pf[kb2][s], o1); } \
                if (next_act) { if (BAND) MASK(n0, n1, t + 1); ROWMAX(n0, n1, mx); } \
            } \
        } else if (next_act) { \
            _Pragma("unroll") for (int st = 0; st < 6; ++st) { const bf16x8 a0 = *(const LAS bf16x8*)(kb + st * 2048), a1 = *(const LAS bf16x8*)(kb + st * 2048 + 512); n0 = MFMA32(a0, qf[st], n0); n1 = MFMA32(a1, qf[st], n1); } \
            MASK(n0, n1, t + 1); ROWMAX(n0, n1, mx); \
        } \
        WAIT_BAR_DMA(more3);                             \
        s0 = n0; s1 = n1; cur_act = next_act; \
        if (__builtin_amdgcn_ballot_w64(mx > 8.0f) != 0ull) { \
            const float dl = fmaxf(mx, 0.f), f = __builtin_amdgcn_exp2f(-dl); \
            mref += dl; lrun *= f; \
            _Pragma("unroll") for (int i = 0; i < 16; ++i) { s0[i] -= dl; s1[i] -= dl; o0[i] *= f; o1[i] *= f; } \
            _Pragma("unroll") for (int i = 0; i < 16; ++i) negm[i] = -mref; \
        } \
    } while (0)
    int t = 0;
    for (; t + 5 < NT; ++t) ATT_ITER(false);
    for (; t < NT; ++t) ATT_ITER(true);
#undef ROWMAX
#undef MASK
#undef ATT_ITER
#undef MAX3
#undef ISSUE
#undef WAIT_BAR_DMA
    const float lt = lrun + lane_xor(lrun, lane, 32);
    const float inv = 1.0f / lt;
    const int ycol = (head < 6) ? head * 64 : 640 + (head - 6) * 64;
    bf16* yp = Y + (rowbase + qme) * D + ycol + 4 * h;
#pragma unroll
    for (int g = 0; g < 4; ++g) {
        *(u32x2*)(yp + 8 * g) = (u32x2){cvtpk(o0[4 * g] * inv, o0[4 * g + 1] * inv), cvtpk(o0[4 * g + 2] * inv, o0[4 * g + 3] * inv)};
        *(u32x2*)(yp + 32 + 8 * g) = (u32x2){cvtpk(o1[4 * g] * inv, o1[4 * g + 1] * inv), cvtpk(o1[4 * g + 2] * inv, o1[4 * g + 3] * inv)};
    }
}
}

#define XB_TMO      128
#define XB_XCNT(j)  (256  + 64 * (j))
#define XB_XSUB(j)  (1280 + 64 * (j))
#define XB_XGEN(j)  (2304 + 64 * (j))
#define XB_TOP      3328
#define XB_TOPGEN   3392
#define XCD_BAR_WORDS 3456
#define XB_SPIN_CAP (1u << 18)

__device__ __forceinline__ unsigned xb_ld(unsigned* p)              { return __hip_atomic_load(p, __ATOMIC_RELAXED, __HIP_MEMORY_SCOPE_AGENT); }
__device__ __forceinline__ unsigned xb_add(unsigned* p, unsigned v) { return __hip_atomic_fetch_add(p, v, __ATOMIC_RELAXED, __HIP_MEMORY_SCOPE_AGENT); }
__device__ __forceinline__ unsigned xb_xcc_id() { return (unsigned)__builtin_amdgcn_s_getreg((3 << 11) | 20) & 0xFu; }
#define XB_SPIN(cond, bar) do { unsigned _sp = 0; while (cond) { __builtin_amdgcn_s_sleep(1); \
    if ((++_sp & 255u) == 0u) { if (xb_ld(&(bar)[XB_TMO])) break; if (_sp > XB_SPIN_CAP) { atomicAdd(&(bar)[XB_TMO], 1u); break; } } } } while (0)

struct XcdBarrier {
    unsigned* bar; unsigned x;
    volatile LAS unsigned* st;
};

__device__ __forceinline__ XcdBarrier xcd_barrier_post(unsigned* bar, volatile LAS unsigned* st) {
    XcdBarrier b; b.bar = bar; b.x = xb_xcc_id(); b.st = st;
    if (threadIdx.x == 0) (void)xb_add(&bar[XB_XCNT(b.x)], 1u);
    return b;
}
__device__ __forceinline__ void xcd_barrier_complete(unsigned* bar, unsigned x, unsigned& nloc, unsigned& nx) {
    const unsigned G = gridDim.x * gridDim.y * gridDim.z;
    unsigned sum, cnt, mine, sp = 0u;
    for (;;) {
        sum = 0u; cnt = 0u; mine = 0u;
#pragma unroll
        for (unsigned j = 0; j < 16; ++j) { const unsigned c = xb_ld(&bar[XB_XCNT(j)]); sum += c; cnt += (c > 0u) ? 1u : 0u; mine = (j == x) ? c : mine; }
        if (sum == G) break;
        __builtin_amdgcn_s_sleep(1);
        if ((++sp & 255u) == 0u) { if (xb_ld(&bar[XB_TMO])) break; if (sp > XB_SPIN_CAP) { atomicAdd(&bar[XB_TMO], 1u); break; } }
    }
    nloc = mine > 0u ? mine : 1u; nx = cnt > 0u ? cnt : 1u;
}

__device__ __forceinline__ void xcd_barrier(const XcdBarrier& b) {
    asm volatile("s_waitcnt vmcnt(0)" ::: "memory");
    __syncthreads();
    if (threadIdx.x == 0) {
        unsigned* bar = b.bar;
        __builtin_amdgcn_s_waitcnt(0);
        unsigned nloc = b.st[0], nx = b.st[1];
        if (nloc == 0u) { xcd_barrier_complete(bar, b.x, nloc, nx); b.st[0] = nloc; b.st[1] = nx; }
        const unsigned old = xb_add(&bar[XB_XSUB(b.x)], 1u);
        const unsigned gen = old / nloc;
        if (old + 1u == (gen + 1u) * nloc) {
            __builtin_amdgcn_fence(__ATOMIC_RELEASE, "agent");
            asm volatile("s_waitcnt vmcnt(0)" ::: "memory");
            const unsigned og = xb_add(&bar[XB_TOP], 1u);
            const unsigned tg = og / nx;
            if (og + 1u == (tg + 1u) * nx) xb_add(&bar[XB_TOPGEN], 1u);
            else XB_SPIN(xb_ld(&bar[XB_TOPGEN]) == tg, bar);
            __builtin_amdgcn_fence(__ATOMIC_ACQUIRE, "agent");
            xb_add(&bar[XB_XGEN(b.x)], 1u);
            asm volatile("s_waitcnt vmcnt(0)" ::: "memory");
        } else {
            XB_SPIN(xb_ld(&bar[XB_XGEN(b.x)]) == gen, bar);
            __builtin_amdgcn_fence(__ATOMIC_ACQUIRE, "agent");
            asm volatile("s_waitcnt vmcnt(0)" ::: "memory");
        }
    }
    __syncthreads();
}

constexpr int LDS_RSTD = LDS_MISC + 256;
__device__ __forceinline__ void fill_rstd(LAS unsigned char* lds, const pg8::StaticOrder& S, const float* ssq, int tid) {
    LAS float* tbl = (LAS float*)(lds + LDS_RSTD);
    pg8::Unit u;
    if (tid < 256) for (int i = 0; i < 8 && S.next(i, u); ++i) tbl[i * 256 + tid] = 1.0f / sqrtf(ssq[u.pm * 256 + tid] * (1.0f / D) + EPS);
    __syncthreads();
}

constexpr int NPH = 1 + 10 * DEPTH;
#ifndef PH_EN
#define PH_EN 0xffff
#endif
#define EN(b) ((PH_EN >> (b)) & 1)
__global__ void __launch_bounds__(512, 2) mk_fwd(Args A_unused) {
    extern __shared__ __attribute__((aligned(16))) unsigned char lds_raw[];
    LAS unsigned char* lds = (LAS unsigned char*)lds_raw;
    cg::grid_group grid = cg::this_grid();
    const int ph_lo = A_unused.ph_lo, ph_hi = A_unused.ph_hi;
    if (threadIdx.x < 64) ((LAS unsigned*)(lds + LDS_MISC))[threadIdx.x] = 0u;
    __syncthreads();
    XcdBarrier bar = xcd_barrier_post((unsigned*)(A_unused.ws + WS_CTL) + CW_BAR, (volatile LAS unsigned*)(lds + LDS_MISC) + 8);
#define PHASE_ENTER() \
    CArgsP Ap = (CArgsP)__builtin_amdgcn_kernarg_segment_ptr(); asm volatile("" : "+s"(Ap)); \
    int tid = threadIdx.x; asm volatile("" : "+v"(tid)); \
    const int lane = tid & 63, wave = __builtin_amdgcn_readfirstlane(tid >> 6); \
    int bid = blockIdx.x, G = gridDim.x; asm volatile("" : "+s"(bid), "+s"(G)); \
    const int gw = bid * 8 + wave, NGW = G * 8; \
    unsigned char* ws = Ap->ws; asm volatile("" : "+s"(ws)); \
    unsigned char* wl = ws + WS_W; \
    int KD = D, KF = F, KQ = KQKV; asm volatile("" : "+s"(KD), "+s"(KF), "+s"(KQ)); \
    (void)lane; (void)gw; (void)NGW; (void)wl; (void)tid; (void)KD; (void)KF; (void)KQ;
#ifdef PROBE_MASK
    unsigned long long tacc = 0;
#endif
    for (int ph = ph_lo; ph < ph_hi; ++ph) {
#ifdef PROBE_MASK
        const unsigned long long tph0 = __builtin_amdgcn_s_memrealtime();
#endif
        int l = 0, k = -1;
        if (ph == NPH - 1) k = 13; else { l = ph / 10; k = ph % 10; }
        asm volatile("" : "+s"(k), "+s"(l));
        if (k == 0) {
            PHASE_ENTER();
            if (EN(12)) prologue(Ap, l, lds, gw, NGW, wave, lane);
        } else if (k == 13) {
            PHASE_ENTER();
            if (EN(0)) norm_phase(Ap->out, Ap->in[I_FINN], nullptr, Ap->out, gw, NGW, lane);
        } else if (EN(1) && (k == 1 || k == 8)) {
            PHASE_ENTER();
            pg8::Gemm g{(const bf16*)(ws + WS_XB), (const bf16*)(wl + (k == 1 ? WL_GU1 : WL_GU2)), M, NGU, KD}; pg8::StaticOrder S; S.init(M, NGU, G, bid);
            const float* ssqp = (const float*)(ws + WS_SSQ) + (size_t)(l * 3 + (k == 1 ? 0 : 2)) * M;
            fill_rstd(lds, S, ssqp, tid);
            EpiSwiglu E{(bf16*)(ws + WS_BIG), ssqp, (const LAS float*)(lds + LDS_RSTD), 0};
            pg8::gemm_phase<EpiSwiglu, pg8::StaticOrder, true, true>(lds, g, S, E);
            if (G == 256 && bid >= 128) convert_items(Ap, l, lds, (k == 1) ? 1 : 3, (bid - 128) * 8 + wave, 1024, wave, lane);
        } else if (EN(2) && (k == 2 || k == 9)) {
            PHASE_ENTER();
            pg8::Gemm g{(const bf16*)(ws + WS_BIG), (const bf16*)(wl + (k == 2 ? WL_DN1 : WL_DN2)), M, D, KF}; pg8::StaticOrder S; S.init(M, D, G, bid);
            EpiResid E{(l == 0 && k == 2) ? Ap->in[I_X] : Ap->out, Ap->out, (bf16*)(ws + WS_XB), (float*)(ws + WS_SSQ) + (size_t)(k == 2 ? l * 3 + 1 : l * 3 + 3) * M, 0.5f};
            pg8::gemm_phase<EpiResid, pg8::StaticOrder, true, true>(lds, g, S, E);
        } else if (EN(4) && k == 3) {
            PHASE_ENTER();
            pg8::Gemm g{(const bf16*)(ws + WS_XB), (const bf16*)(wl + WL_IN), M, NWIN, KD}; pg8::StaticOrder S; S.init(M, NWIN, G, bid);
            fill_rstd(lds, S, (const float*)(ws + WS_SSQ) + (size_t)(l * 3 + 1) * M, tid);
            EpiWin E{(bf16*)(ws + WS_ZS), (bf16*)(ws + WS_U), (bf16*)(ws + WS_QP), (bf16*)(ws + WS_KP), (bf16*)(ws + WS_V), (float*)(ws + WS_FL), (const float*)(ws + WS_SSQ) + (size_t)(l * 3 + 1) * M, (unsigned*)(ws + WS_CTL) + 2048 + l * 96, (const LAS float*)(lds + LDS_RSTD), 0};
            pg8::gemm_phase<EpiWin, pg8::StaticOrder, true, true>(lds, g, S, E);
        } else if (EN(5) && k == 4) {
            PHASE_ENTER();
            prep_phase(Ap, l, lds, tid, wave, lane, bid, G);
        } else if (EN(6) && k == 5) {
            PHASE_ENTER();
            pg8::Gemm g{(const bf16*)(ws + WS_QKN), (const bf16*)(wl + WL_QKV), M, NQKV, KQ}; pg8::StaticOrder S; S.init(M, NQKV, G, bid);
            EpiQKV E{(bf16*)(ws + WS_QP), (bf16*)(ws + WS_KP), (bf16*)(ws + WS_V), (const float*)(ws + WS_ROPE)};
            pg8::gemm_phase<EpiQKV, pg8::StaticOrder, true, true>(lds, g, S, E);
            if (G >= 160) { if (bid >= 128) scan_phase(Ap, l, lds, tid, wave, lane, bid - 128, G - 128); }
            else scan_phase(Ap, l, lds, tid, wave, lane, bid, G);
        } else if (EN(7) && k == 6) {
            PHASE_ENTER();
            LAS unsigned* uw = (LAS unsigned*)(lds + LDS_MISC);
            unsigned* ctl = (unsigned*)(ws + WS_CTL);
            __syncthreads();
            for (int par = 0;; par ^= 1) {
                if (tid == 0) uw[par] = atomicAdd(ctl + 64 * l, 1u);
                asm volatile("s_waitcnt lgkmcnt(0)\n\ts_barrier" ::: "memory");
                const unsigned u = uw[par];
                if (u >= 768u) break;
                const unsigned v = (u < 384u) ? u : u - 384u;
                const int qb = 15 - (int)(v / 24u), bi = (int)(v % 24u), bb = bi / 6, hd = bi % 6 + ((u < 384u) ? 0 : 6);
                int tbase = 0;
                if (hd >= 6) {
                    const float* C2 = (const float*)(ws + WS_C2) + (size_t)(bb * 6 + hd - 6) * SEQ;
                    const float* nr = (const float*)(ws + WS_CTL) + 2048 + l * 96 + (bb * 6 + hd - 6) * 4;
                    const float B2 = 2.0f * (sqrtf((nr[0] + nr[1]) * (nr[2] + nr[3])) * 1.02f + 1.0f);
                    const float cq = C2[qb * 256];
                    const bool skip = (lane < 4 * (qb + 1) - 4) && (B2 + cq - C2[64 * lane + 63] < -160.0f);
                    const unsigned long long mk = __builtin_amdgcn_ballot_w64(skip);
                    tbase = (~mk == 0ull) ? 0 : __builtin_ctzll(~mk);
                    tbase = __builtin_amdgcn_readfirstlane(tbase);
                }
                att::attn_unit(lds, (const bf16*)(ws + WS_QP), (const bf16*)(ws + WS_KP), (const bf16*)(ws + WS_V), (bf16*)(ws + WS_XN), bb, hd, qb, tbase, tid, wave, lane);
            }
        } else if (EN(8) && k == 7) {
            PHASE_ENTER();
            pg8::Gemm g{(const bf16*)(ws + WS_XN), (const bf16*)(wl + WL_OUT), M, D, KD}; pg8::StaticOrder S; S.init(M, D, G, bid);
            EpiResid E{Ap->out, Ap->out, (bf16*)(ws + WS_XB), (float*)(ws + WS_SSQ) + (size_t)(l * 3 + 2) * M, 1.0f};
            pg8::gemm_phase<EpiResid, pg8::StaticOrder, true, true>(lds, g, S, E);
        }
        if (ph + 1 < ph_hi) { if (ph_hi > 1000) grid.sync(); xcd_barrier(bar); }
#ifdef PROBE_MASK
        if ((PROBE_MASK >> k) & 1) tacc += __builtin_amdgcn_s_memrealtime() - tph0;
#endif
    }
#ifdef PROBE_MASK
    if (blockIdx.x == 0) { const unsigned long long tend = __builtin_amdgcn_s_memrealtime() + 4ull * tacc; while (__builtin_amdgcn_s_memrealtime() < tend) __builtin_amdgcn_s_sleep(32); }
#endif
}

extern "C" void kernel_launch(void* const* d_in, const int* in_sizes, int n_in, void* d_out, int out_size, void* d_ws, size_t ws_size, hipStream_t stream) {
    static int grid = 0;
    if (grid == 0) {
        if (n_in != 18 || out_size != M * D || ws_size < WS_END) { fprintf(stderr, "kernel_launch: unexpected problem (n_in %d out %d ws %zu need %zu)\n", n_in, out_size, ws_size, (size_t)WS_END); grid = -1; return; }
        int dev = 0, cus = 0, per_cu = 0;
        hipGetDevice(&dev); hipDeviceGetAttribute(&cus, hipDeviceAttributeMultiprocessorCount, dev);
        if (hipFuncSetAttribute((const void*)mk_fwd, hipFuncAttributeMaxDynamicSharedMemorySize, LDS_BYTES) != hipSuccess) { fprintf(stderr, "kernel_launch: hipFuncSetAttribute failed\n"); grid = -1; return; }
        if (hipOccupancyMaxActiveBlocksPerMultiprocessor(&per_cu, (const void*)mk_fwd, 512, LDS_BYTES) != hipSuccess || per_cu < 1) { fprintf(stderr, "kernel_launch: occupancy query says %d\n", per_cu); per_cu = 1; }
        (void)hipGetLastError();
        grid = cus * per_cu;
        fprintf(stderr, "kernel_launch: grid %d (cus %d x %d)\n", grid, cus, per_cu);
        if (grid < 192) fprintf(stderr, "kernel_launch: this build keeps per-unit row scales for at most 8 GEMM units per workgroup (needs >= 176 workgroups); grid %d is too small\n", grid);
    }
    if (grid < 0) return;
    (void)hipMemsetAsync((char*)d_ws + WS_CTL, 0, CTL_BYTES, stream);
    Args a{};
    for (int i = 0; i < 18; ++i) a.in[i] = (const float*)d_in[i];
    a.out = (float*)d_out; a.ws = (unsigned char*)d_ws;
#if MK_MULTI
    for (int ph = 0; ph < NPH; ++ph) { a.ph_lo = ph; a.ph_hi = ph + 1; hipLaunchKernelGGL(mk_fwd, dim3(grid), dim3(512), LDS_BYTES, stream, a); }
#else
    a.ph_lo = 0; a.ph_hi = NPH;
    void* args[] = {&a};
    hipError_t e = hipLaunchCooperativeKernel((const void*)mk_fwd, dim3(grid), dim3(512), args, LDS_BYTES, stream);
    if (e != hipSuccess) fprintf(stderr, "kernel_launch: cooperative launch failed: %s (grid %d)\n", hipGetErrorString(e), grid);
#endif
}
```

```cpp
#include <hip/hip_runtime.h>
#include <hip/hip_cooperative_groups.h>
#include <cstdio>
#include <cstdint>
namespace cg = cooperative_groups;
#ifndef MK_MULTI
#define MK_MULTI 0
#endif
namespace pg8 {
#define PG8_LAS __attribute__((address_space(3)))
typedef unsigned short bf16_t;
typedef short bf16x8 __attribute__((ext_vector_type(8)));
typedef float f32x4 __attribute__((ext_vector_type(4)));
typedef unsigned u32x4 __attribute__((ext_vector_type(4)));
constexpr int BM = 256, BK = 64, HALF = 128, HTB = HALF * BK * 2  , STAGE_BYTES = 8 * HTB, NXCD = 8, WGM = 8;

__host__ __device__ __forceinline__ int lds_byte(int r, int c) { const int st = (r >> 4) * 2 + (c >> 5), rr = r & 15, cc = c & 31, ob = rr * 64 + cc * 2; return st * 1024 + (ob ^ (((ob >> 9) & 1) << 5)); }
__host__ __device__ __forceinline__ void stage_rc(int b, int& R, int& C) { const int st = b / 1024, sb = b % 1024, swz = sb ^ (((sb >> 9) & 1) << 5); R = (st >> 1) * 16 + swz / 64; C = (st & 1) * 32 + (swz % 64) / 2; }
__host__ __device__ __forceinline__ int perm32(int rho) { const int n = rho >> 4, i = rho & 15; return 8 * (i >> 2) + 4 * n + (i & 3); }

struct Unit { int pm, pn; };
struct Gemm { const bf16_t* A; const bf16_t* Bt; int M, N, K; };

struct StaticOrder {
    int nM, nN, nwg, G, c;
    __host__ __device__ void init(int M, int N, int G_, int c_) { nM = M / BM; nN = N / BM; nwg = nM * nN; G = G_; c = c_; }
    __host__ __device__ bool next(int i, Unit& u) const {
        const long L = (long)i * G + c; if (L >= nwg) return false;
        int wgid = (int)L; { const int q = nwg / NXCD, r = nwg % NXCD, xcd = wgid % NXCD, off = wgid / NXCD; wgid = (xcd < r ? xcd * (q + 1) : r * (q + 1) + (xcd - r) * q) + off; }
        const int nig = WGM * nN, gid = wgid / nig, fm = gid * WGM, gsz = (nM - fm) < WGM ? (nM - fm) : WGM;
        u.pm = fm + ((wgid % nig) % gsz); u.pn = (wgid % nig) / gsz; return true;
    }
    __device__ __forceinline__ void a_ready(const Unit&) const {}
    __device__ __forceinline__ void done(const Unit&) const {}
};
typedef float f32x2 __attribute__((ext_vector_type(2)));
template <class Epi, class Sched, bool ALIGN_EPI = false, bool SP2 = false>
__device__ __forceinline__ void gemm_phase(PG8_LAS unsigned char* lds, const Gemm g, const Sched& S, const Epi& E) {
    int tid = threadIdx.x; asm volatile("" : "+v"(tid)); const int wid = __builtin_amdgcn_readfirstlane(tid >> 6), lane = tid & 63, wr = wid >> 2, wc = wid & 3, fr = lane & 15, fq = lane >> 4;
    const int K = g.K, nt = K / BK;
    unsigned voffA[2], voffB[2];
#pragma unroll
    for (int i = 0; i < 2; ++i) { int R, C; stage_rc(tid * 16 + i * 8192, R, C); const int Rb = Epi::PERM ? ((R & ~31) + perm32(R & 31)) : R;
        voffA[i] = (unsigned)(R * K + C) * 2u; voffB[i] = (unsigned)(Rb * K + C) * 2u; }
    const size_t kstep = (size_t)(BK * 2);
    const size_t hstep = (size_t)HALF * K * 2;
    const size_t tstep = 2 * hstep;
    const unsigned ldsw = (unsigned)wid * 1024u;
    const int aoff = lds_byte(wr * 64 + fr, fq * 8), boff = lds_byte(wc * 32 + fr, fq * 8);
#define PG8_SA(b, h) (((b) * 2 + (h)) * HTB)
#define PG8_SB(b, h) ((4 + (b) * 2 + (h)) * HTB)
#define PG8_STAGE(bufoff, gbase, voff) do { _Pragma("unroll") for (int _i = 0; _i < 2; ++_i) \
        __builtin_amdgcn_global_load_lds((const unsigned*)((const char*)(gbase) + (voff)[_i]), (PG8_LAS unsigned*)(lds + (bufoff) + ldsw + _i * 8192), 16, 0, 0); } while (0)
#define PG8_LDA(dst, b, h) do { _Pragma("unroll") for (int m = 0; m < 4; ++m) _Pragma("unroll") for (int k = 0; k < 2; ++k) dst[m][k] = *(const PG8_LAS bf16x8*)(lds + PG8_SA(b, h) + aoff + m * 2048 + k * 1024); } while (0)
#define PG8_LDB(dst, b, h) do { _Pragma("unroll") for (int n = 0; n < 2; ++n) _Pragma("unroll") for (int k = 0; k < 2; ++k) dst[n][k] = *(const PG8_LAS bf16x8*)(lds + PG8_SB(b, h) + boff + n * 2048 + k * 1024); } while (0)
#define PG8_MMA(ai, bj, At, Bt) do { __builtin_amdgcn_s_setprio(1); _Pragma("unroll") for (int m = 0; m < 4; ++m) _Pragma("unroll") for (int n = 0; n < 2; ++n) _Pragma("unroll") for (int k = 0; k < 2; ++k) \
        acc[ai][bj][m][n] = __builtin_amdgcn_mfma_f32_16x16x32_bf16(Bt[n][k], At[m][k], acc[ai][bj][m][n], 0, 0, 0); __builtin_amdgcn_s_setprio(0); } while (0)
#define PG8_WAIT_V(n) asm volatile("s_waitcnt vmcnt(" #n ")" ::: "memory")
#define PG8_WAIT_L(n) asm volatile("s_waitcnt lgkmcnt(" #n ")" ::: "memory")
#define PG8_BAR __builtin_amdgcn_s_barrier()
#define PG8_SCHED __builtin_amdgcn_sched_barrier(0)
    Unit cur, nxt; int ui = 0;
    if (!S.next(0, cur)) return;
    f32x4 acc[2][2][4][2];
#pragma unroll
    for (int a = 0; a < 2; ++a)
#pragma unroll
        for (int b = 0; b < 2; ++b)
#pragma unroll
            for (int m = 0; m < 4; ++m)
#pragma unroll
                for (int n = 0; n < 2; ++n) acc[a][b][m][n] = (f32x4){0.f, 0.f, 0.f, 0.f};
    bf16x8 At[4][2], B0[2][2], B1[2][2];
    const char* cA = (const char*)g.A + (size_t)cur.pm * tstep; const char* cB = (const char*)g.Bt + (size_t)cur.pn * tstep;
    S.a_ready(cur);
    if constexpr (SP2) {
        PG8_STAGE(PG8_SB(0, 0), cB, voffB); PG8_STAGE(PG8_SB(0, 1), cB + hstep, voffB); PG8_STAGE(PG8_SA(0, 0), cA, voffA); PG8_STAGE(PG8_SA(0, 1), cA + hstep, voffA);
        if (wr == 1) PG8_BAR;
        PG8_WAIT_V(2); PG8_BAR;
        PG8_STAGE(PG8_SB(1, 0), cB + kstep, voffB); PG8_STAGE(PG8_SA(1, 0), cA + kstep, voffA); PG8_STAGE(PG8_SB(1, 1), cB + hstep + kstep, voffB);
        PG8_WAIT_V(6); PG8_BAR;
    } else {
        PG8_STAGE(PG8_SB(0, 0), cB, voffB); PG8_STAGE(PG8_SA(0, 0), cA, voffA); PG8_STAGE(PG8_SB(0, 1), cB + hstep, voffB); PG8_STAGE(PG8_SA(0, 1), cA + hstep, voffA);
        if (wr == 1) PG8_BAR;
        PG8_WAIT_V(4); PG8_BAR;
        PG8_STAGE(PG8_SB(1, 0), cB + kstep, voffB); PG8_STAGE(PG8_SA(1, 0), cA + kstep, voffA); PG8_STAGE(PG8_SB(1, 1), cB + hstep + kstep, voffB);
        PG8_WAIT_V(6); PG8_BAR;
    }
    for (;;) {
        const bool has_next = S.next(ui + 1, nxt);
        const char* nA = has_next ? (const char*)g.A + (size_t)nxt.pm * tstep : cA; const char* nB = has_next ? (const char*)g.Bt + (size_t)nxt.pn * tstep : cB;
        for (int t = 0; t < nt; t += 2) {
            const bool last = (t == nt - 2);
            const char* a1 = cA + (size_t)(t + 1) * kstep;
            const char* a2 = last ? nA : cA + (size_t)(t + 2) * kstep; const char* b2 = last ? nB : cB + (size_t)(t + 2) * kstep;
            const char* a3 = a2 + kstep; const char* b3 = b2 + kstep;
            if (last && has_next) S.a_ready(nxt);
            if constexpr (SP2) {
            PG8_LDB(B0, 0, 0); PG8_LDB(B1, 0, 1); PG8_SCHED; PG8_LDA(At, 0, 0); PG8_STAGE(PG8_SA(1, 1), a1 + hstep, voffA);
            PG8_WAIT_V(8); PG8_WAIT_L(0); PG8_BAR; PG8_MMA(0, 0, At, B0); PG8_MMA(0, 1, At, B1); PG8_BAR; PG8_SCHED;
            PG8_LDA(At, 0, 1); PG8_STAGE(PG8_SB(0, 0), b2, voffB); PG8_STAGE(PG8_SB(0, 1), b2 + hstep, voffB); PG8_STAGE(PG8_SA(0, 0), a2, voffA);
            PG8_WAIT_V(8); PG8_WAIT_L(0); PG8_BAR; PG8_MMA(1, 0, At, B0); PG8_MMA(1, 1, At, B1); PG8_BAR; PG8_SCHED;
            PG8_LDB(B0, 1, 0); PG8_LDB(B1, 1, 1); PG8_SCHED; PG8_LDA(At, 1, 0); PG8_STAGE(PG8_SA(0, 1), a2 + hstep, voffA);
            PG8_WAIT_V(8); PG8_WAIT_L(0); PG8_BAR; PG8_MMA(0, 0, At, B0); PG8_MMA(0, 1, At, B1); PG8_BAR; PG8_SCHED;
            PG8_LDA(At, 1, 1); PG8_STAGE(PG8_SB(1, 0), b3, voffB); PG8_STAGE(PG8_SB(1, 1), b3 + hstep, voffB); PG8_STAGE(PG8_SA(1, 0), a3, voffA);
            PG8_WAIT_V(8); PG8_WAIT_L(0); PG8_BAR; PG8_MMA(1, 0, At, B0); PG8_MMA(1, 1, At, B1); PG8_BAR; PG8_SCHED;
            } else {
            PG8_LDB(B0, 0, 0); PG8_SCHED; PG8_LDA(At, 0, 0); PG8_STAGE(PG8_SA(1, 1), a1 + hstep, voffA);
            PG8_WAIT_L(8); PG8_BAR; PG8_WAIT_L(0); PG8_MMA(0, 0, At, B0); PG8_BAR; PG8_SCHED;
            PG8_LDB(B1, 0, 1); PG8_STAGE(PG8_SB(0, 0), b2, voffB);
            PG8_BAR; PG8_WAIT_L(0); PG8_MMA(0, 1, At, B1); PG8_BAR;
            PG8_LDA(At, 0, 1); PG8_STAGE(PG8_SA(0, 0), a2, voffA);
            PG8_BAR; PG8_WAIT_L(0); PG8_MMA(1, 0, At, B0); PG8_BAR; PG8_SCHED;
            PG8_STAGE(PG8_SB(0, 1), b2 + hstep, voffB);
            PG8_WAIT_V(6); PG8_BAR; PG8_MMA(1, 1, At, B1); PG8_BAR;
            PG8_LDB(B0, 1, 0); PG8_SCHED; PG8_LDA(At, 1, 0); PG8_STAGE(PG8_SA(0, 1), a2 + hstep, voffA);
            PG8_WAIT_L(8); PG8_BAR; PG8_WAIT_L(0); PG8_MMA(0, 0, At, B0); PG8_BAR; PG8_SCHED;
            PG8_LDB(B1, 1, 1); PG8_STAGE(PG8_SB(1, 0), b3, voffB);
            PG8_BAR; PG8_WAIT_L(0); PG8_MMA(0, 1, At, B1); PG8_BAR;
            PG8_LDA(At, 1, 1); PG8_STAGE(PG8_SA(1, 0), a3, voffA);
            PG8_BAR; PG8_WAIT_L(0); PG8_MMA(1, 0, At, B0); PG8_BAR; PG8_SCHED;
            PG8_STAGE(PG8_SB(1, 1), b3 + hstep, voffB);
            PG8_WAIT_V(6); PG8_BAR; PG8_MMA(1, 1, At, B1); PG8_BAR;
            }
        }
        if constexpr (ALIGN_EPI) { if (wr == 0) PG8_BAR; }
        if constexpr (!Epi::AFTER_DRAIN) { E(acc, cur, wr, wc, fr, fq); S.done(cur); }
        if (!has_next) break;
#pragma unroll
        for (int a = 0; a < 2; ++a)
#pragma unroll
            for (int b = 0; b < 2; ++b)
#pragma unroll
                for (int m = 0; m < 4; ++m)
#pragma unroll
                    for (int n = 0; n < 2; ++n) acc[a][b][m][n] = (f32x4){0.f, 0.f, 0.f, 0.f};
        cur = nxt; cA = nA; cB = nB; ++ui;
        if constexpr (ALIGN_EPI) { if (wr == 1) PG8_BAR; }
    }
    PG8_WAIT_V(0);
    if constexpr (!ALIGN_EPI) { if (wr == 0) PG8_BAR; }
    PG8_BAR;
    if constexpr (Epi::AFTER_DRAIN) { E.fused(acc, cur, wr, wc, fr, fq, lds, wid, lane); S.done(cur); }
#undef PG8_SA
#undef PG8_SB
#undef PG8_STAGE
#undef PG8_LDA
#undef PG8_LDB
#undef PG8_MMA
#undef PG8_WAIT_V
#undef PG8_WAIT_L
#undef PG8_BAR
#undef PG8_SCHED
}
}

constexpr int M = 16384, SEQ = 4096, NB = 4, D = 1024, F = 2816, DEPTH = 2;
constexpr int N_IN = 1830;
constexpr int NGU = 2 * F;
constexpr int NWIN = 2048;
constexpr int NQKV = 1536, KQKV = 384;
constexpr int QP = 1152, VP = 768;
constexpr float EPS = 1e-6f;
constexpr float LOG2E = 1.4426950408889634f;
constexpr float QS_MLA = 0.14724444f;
constexpr float QS_FOX = 0.18033688f;

constexpr size_t MiB = 1u << 20;
constexpr size_t WS_CTL = 0;
constexpr int CW_BAR = 4096;
constexpr size_t WS_SSQ = 65536;
constexpr size_t CTL_BYTES = 65536 + 7 * 65536;
constexpr size_t WS_ROPE = 1 * MiB;
constexpr size_t WS_C2 = 512 * 1024;
constexpr size_t WS_BND = 960 * 1024;
constexpr size_t WS_FL = 1 * MiB + 512 * 1024;
constexpr size_t WS_W = 2 * MiB;
constexpr size_t WL_GU1 = 0, WL_GU2 = 11 * MiB, WL_DN1 = 22 * MiB, WL_DN2 = 22 * MiB + 5632 * 1024, WL_IN = 33 * MiB, WL_OUT = 37 * MiB, WL_QKV = 39 * MiB;
constexpr size_t WL_STRIDE = 41 * MiB;
constexpr size_t WS_XB = 43 * MiB;
constexpr size_t WS_XN = 75 * MiB;
constexpr size_t WS_BIG = 107 * MiB;
constexpr size_t WS_ZS = WS_BIG, WS_U = WS_BIG + 16 * MiB, WS_QKN = WS_BIG + 24 * MiB, WS_QP = WS_BIG + 36 * MiB, WS_KP = WS_BIG + 72 * MiB, WS_V = WS_BIG + 108 * MiB;
constexpr size_t WS_END = WS_BIG + 132 * MiB;
static_assert(WL_QKV + (size_t)NQKV * KQKV * 2 <= WL_STRIDE && WS_W + WL_STRIDE <= WS_XB, "weights map");
static_assert(WS_QKN + (size_t)M * KQKV * 2 <= WS_QP && WS_V + (size_t)M * VP * 2 <= WS_END && WS_BIG + (size_t)M * F * 2 <= WS_END, "act map");

constexpr int LDS_BYTES = 147456;
constexpr int LDS_MISC = 131072 + 4096;

#define LAS __attribute__((address_space(3)))
typedef unsigned short bf16;
typedef float f32x4 __attribute__((ext_vector_type(4)));
typedef float f32x2 __attribute__((ext_vector_type(2)));
typedef float f32x16 __attribute__((ext_vector_type(16)));
typedef unsigned u32x4 __attribute__((ext_vector_type(4)));
typedef unsigned u32x2 __attribute__((ext_vector_type(2)));
typedef short bf16x8 __attribute__((ext_vector_type(8)));
typedef short s16x4 __attribute__((ext_vector_type(4)));
typedef __bf16 bf16x2_t __attribute__((ext_vector_type(2)));

__device__ __forceinline__ unsigned cvtpk(float lo, float hi) { f32x2 v = {lo, hi}; bf16x2_t b = __builtin_convertvector(v, bf16x2_t); return __builtin_bit_cast(unsigned, b); }
__device__ __forceinline__ unsigned f2bf(float f) { unsigned u = __builtin_bit_cast(unsigned, f); return (u + 0x7fffu + ((u >> 16) & 1u)) >> 16; }
__device__ __forceinline__ float bf2f(unsigned b) { return __builtin_bit_cast(float, b << 16); }
__device__ __forceinline__ float lane_xor(float v, int lane, int o) { return __builtin_bit_cast(float, __builtin_amdgcn_ds_bpermute((lane ^ o) << 2, __builtin_bit_cast(int, v))); }
__device__ __forceinline__ float wave_sum(float v, int lane) {
#pragma unroll
    for (int o = 1; o < 64; o <<= 1) v += lane_xor(v, lane, o);
    return v;
}
__device__ __forceinline__ void store8nt(bf16* p, f32x4 a, f32x4 b) { u32x4 w; w.x = cvtpk(a[0], a[1]); w.y = cvtpk(a[2], a[3]); w.z = cvtpk(b[0], b[1]); w.w = cvtpk(b[2], b[3]); __builtin_nontemporal_store(w, (u32x4*)p); }
__device__ __forceinline__ void store8(bf16* p, f32x4 a, f32x4 b) { u32x4 w; w.x = cvtpk(a[0], a[1]); w.y = cvtpk(a[2], a[3]); w.z = cvtpk(b[0], b[1]); w.w = cvtpk(b[2], b[3]); *(u32x4*)p = w; }

struct EpiSwiglu {
    static constexpr bool PERM = true, AFTER_DRAIN = false;
    bf16* O; const float* ssq; const LAS float* tbl; mutable int ucount;
    __device__ __forceinline__ void operator()(const pg8::f32x4 (&acc)[2][2][4][2], const pg8::Unit& u, int wr, int wc, int fr, int fq) const {
        asm volatile("" : "+v"(fr), "+v"(fq));
        const int row0 = u.pm * 256 + wr * 64 + fr, col0 = u.pn * 128 + wc * 32 + 8 * fq;
#pragma unroll
        for (int ai = 0; ai < 2; ++ai)
#pragma unroll
            for (int m = 0; m < 4; ++m) {
                bf16* rowp = O + (size_t)(row0 + ai * 128 + m * 16) * F + col0;
                const float rs = tbl[(ucount & 7) * 256 + wr * 64 + fr + ai * 128 + m * 16], nrs = -rs * LOG2E;
                f32x4 r[2];
#pragma unroll
                for (int n = 0; n < 2; ++n) {
                    const f32x4 g = acc[ai][0][m][n], uu = acc[ai][1][m][n];
#pragma unroll
                    for (int j = 0; j < 4; ++j) { const float e = __builtin_amdgcn_exp2f(g[j] * nrs); r[n][j] = (g[j] * rs) * __builtin_amdgcn_rcpf(1.0f + e) * (uu[j] * rs); }
                }
                store8nt(rowp, r[0], r[1]);
            }
        ++ucount;
    }
};
struct EpiResid {
    static constexpr bool PERM = true, AFTER_DRAIN = false;
    const float* base; float* out; bf16* xb; float* ssq; float scale;
    __device__ __forceinline__ void operator()(const pg8::f32x4 (&acc)[2][2][4][2], const pg8::Unit& u, int wr, int wc, int fr, int fq) const {
        asm volatile("" : "+v"(fr), "+v"(fq));
        const int row0 = u.pm * 256 + wr * 64 + fr, col0 = u.pn * 256 + wc * 32 + 8 * fq;
#pragma unroll
        for (int ai = 0; ai < 2; ++ai)
#pragma unroll
            for (int m = 0; m < 4; ++m) {
                const size_t off = (size_t)(row0 + ai * 128 + m * 16) * D + col0;
                float sq = 0.f;
#pragma unroll
                for (int bj = 0; bj < 2; ++bj) {
                    const size_t p = off + bj * 128;
                    const f32x4 b0 = __builtin_nontemporal_load((const f32x4*)(base + p)), b1 = __builtin_nontemporal_load((const f32x4*)(base + p + 4));
                    const f32x4 o0 = b0 + acc[ai][bj][m][0] * scale, o1 = b1 + acc[ai][bj][m][1] * scale;
                    __builtin_nontemporal_store(o0, (f32x4*)(out + p)); __builtin_nontemporal_store(o1, (f32x4*)(out + p + 4));
                    store8(xb + p, o0, o1);
                    sq += ((o0[0] * o0[0] + o0[1] * o0[1]) + (o0[2] * o0[2] + o0[3] * o0[3])) + ((o1[0] * o1[0] + o1[1] * o1[1]) + (o1[2] * o1[2] + o1[3] * o1[3]));
                }
                { const int ln = fq * 16 + fr; sq += lane_xor(sq, ln, 16); sq += lane_xor(sq, ln, 32); if (fq == 0) atomicAdd(ssq + row0 + ai * 128 + m * 16, sq); }
                asm volatile("" ::: "memory");
            }
    }
};
struct EpiWin {
    static constexpr bool PERM = true, AFTER_DRAIN = false;
    bf16 *Zs, *U, *Qp, *Kp, *V; float* Fl; const float* ssq; unsigned* nrm; const LAS float* tbl; mutable int ucount;
    __device__ __forceinline__ void operator()(const pg8::f32x4 (&acc)[2][2][4][2], const pg8::Unit& u, int wr, int wc, int fr, int fq) const {
        asm volatile("" : "+v"(fr), "+v"(fq));
        const int row0 = u.pm * 256 + wr * 64 + fr;
#pragma unroll
        for (int bj = 0; bj < 2; ++bj) {
            const int c0 = u.pn * 256 + bj * 128 + wc * 32 + 8 * fq;
            bf16* dst; int pitch; float sc = 1.0f; bool f32too = false; int nslot = -1;
            if (c0 < 512) { dst = Zs + c0; pitch = 512; f32too = (c0 == 416); }
            else if (c0 < 768) { dst = U + (c0 - 512); pitch = 256; }
            else if (c0 < 1920) {
                const int e = c0 - 768, seg = e / 384, w = e - seg * 384, hh = w >> 6, d = w & 63;
                if (seg == 0) { dst = Qp + (6 + hh) * 96 + d; pitch = QP; sc = QS_FOX; nslot = hh * 4 + (d >> 5); }
                else if (seg == 1) { dst = Kp + (6 + hh) * 96 + d; pitch = QP; nslot = hh * 4 + 2 + (d >> 5); }
                else { dst = V + (6 + hh) * 64 + d; pitch = VP; }
            } else continue;
            float nmax = 0.f;
#pragma unroll
            for (int ai = 0; ai < 2; ++ai)
#pragma unroll
                for (int m = 0; m < 4; ++m) {
                    const int row = row0 + ai * 128 + m * 16;
                    const float rs = tbl[(ucount & 7) * 256 + wr * 64 + fr + ai * 128 + m * 16], scr = sc * rs;
                    const f32x4 v0 = acc[ai][bj][m][0] * scr, v1 = acc[ai][bj][m][1] * scr;
                    store8(dst + (size_t)row * pitch, v0, v1);
                    if (nslot >= 0) { float s2 = ((v0[0] * v0[0] + v0[1] * v0[1]) + (v0[2] * v0[2] + v0[3] * v0[3])) + ((v1[0] * v1[0] + v1[1] * v1[1]) + (v1[2] * v1[2] + v1[3] * v1[3]));
                        const int ln = fq * 16 + fr; s2 += lane_xor(s2, ln, 16); s2 += lane_xor(s2, ln, 32); nmax = fmaxf(nmax, s2); }
                    if (f32too) { *(f32x4*)(Fl + (size_t)row * 8) = acc[ai][bj][m][0] * rs; *(f32x4*)(Fl + (size_t)row * 8 + 4) = acc[ai][bj][m][1] * rs; }
                }
            if (nslot >= 0) { const int ln = fq * 16 + fr;
#pragma unroll
                for (int o = 1; o < 16; o <<= 1) nmax = fmaxf(nmax, lane_xor(nmax, ln, o));
                if (fr == 0 && fq == 0) atomicMax(nrm + ((u.pm >> 4) * 6) * 4 + nslot, __builtin_bit_cast(unsigned, nmax)); }
        }
        ++ucount;
    }
};
struct EpiQKV {
    static constexpr bool PERM = true, AFTER_DRAIN = false;
    bf16 *Qp, *Kp, *V; const float* rope;
    __device__ __forceinline__ void operator()(const pg8::f32x4 (&acc)[2][2][4][2], const pg8::Unit& u, int wr, int wc, int fr, int fq) const {
        asm volatile("" : "+v"(fr), "+v"(fq));
        const int row0 = u.pm * 256 + wr * 64 + fr;
#pragma unroll
        for (int bj = 0; bj < 2; ++bj) {
            const int c0 = u.pn * 256 + bj * 128 + wc * 32 + 8 * fq;
            if (c0 < 576) {
                const int head = c0 / 96, d = c0 - head * 96;
                bf16* dst = Qp + head * 96 + d;
                if (d < 64) {
#pragma unroll
                    for (int ai = 0; ai < 2; ++ai)
#pragma unroll
                        for (int m = 0; m < 4; ++m) { const int row = row0 + ai * 128 + m * 16; store8(dst + (size_t)row * QP, acc[ai][bj][m][0] * QS_MLA, acc[ai][bj][m][1] * QS_MLA); }
                } else {
                    const int a = (d - 64) >> 3;
                    f32x4 t0[2][4], t1[2][4];
#pragma unroll
                    for (int ai = 0; ai < 2; ++ai)
#pragma unroll
                        for (int m = 0; m < 4; ++m) { const int pos = (row0 + ai * 128 + m * 16) & (SEQ - 1);
                            t0[ai][m] = *(const f32x4*)(rope + (size_t)(pos * 16 + 4 * a) * 2); t1[ai][m] = *(const f32x4*)(rope + (size_t)(pos * 16 + 4 * a) * 2 + 4); }
                    asm volatile("" ::: "memory");
#pragma unroll
                    for (int ai = 0; ai < 2; ++ai)
#pragma unroll
                        for (int m = 0; m < 4; ++m) {
                            const int row = row0 + ai * 128 + m * 16;
                            const f32x4 x = acc[ai][bj][m][0], y = acc[ai][bj][m][1], c0v = t0[ai][m], c1v = t1[ai][m];
                            f32x4 ox, oy;
                            ox[0] = x[0] * c0v[0] - x[1] * c0v[1]; ox[1] = x[1] * c0v[0] + x[0] * c0v[1]; ox[2] = x[2] * c0v[2] - x[3] * c0v[3]; ox[3] = x[3] * c0v[2] + x[2] * c0v[3];
                            oy[0] = y[0] * c1v[0] - y[1] * c1v[1]; oy[1] = y[1] * c1v[0] + y[0] * c1v[1]; oy[2] = y[2] * c1v[2] - y[3] * c1v[3]; oy[3] = y[3] * c1v[2] + y[2] * c1v[3];
                            store8(dst + (size_t)row * QP, ox * QS_MLA, oy * QS_MLA);
                        }
                }
            } else if (c0 < 1344) {
                const int e = c0 - 576, head = e >> 7, d = e & 127;
                bf16* dst; int pitch;
                if (d < 64) { dst = Kp + head * 96 + d; pitch = QP; } else { dst = V + head * 64 + (d - 64); pitch = VP; }
#pragma unroll
                for (int ai = 0; ai < 2; ++ai)
#pragma unroll
                    for (int m = 0; m < 4; ++m) { const int row = row0 + ai * 128 + m * 16; store8(dst + (size_t)row * pitch, acc[ai][bj][m][0], acc[ai][bj][m][1]); }
            }
        }
    }
};

struct Args {
    const float* in[18];
    float* out; unsigned char* ws;
    int ph_lo, ph_hi;
};
typedef const __attribute__((address_space(4))) Args* CArgsP;
enum { I_X = 0, I_F1N, I_F1GU, I_F1DN, I_MIXN, I_WIN, I_QAN, I_WQB, I_KVAN, I_WKVB, I_POOLW, I_POOLS, I_FOXB, I_WOUT, I_F2N, I_F2GU, I_F2DN, I_FINN };

struct ConvDesc { const float* wp; const float* gain; bf16* wt; int Nsrc, Ksrc, koff, Kdst, k0; bool okc; };
__device__ __forceinline__ void conv_set(ConvDesc& d, const float* W, int Nsrc, int Ksrc, int sc, int koff, bf16* WT, int Kdst, int k0, int n0, int lane, const float* gain) {
    d.okc = sc >= 0; d.Nsrc = Nsrc; d.Ksrc = Ksrc; d.koff = koff; d.Kdst = Kdst; d.k0 = k0;
    d.wp = W + (size_t)(k0 - koff + (lane >> 5)) * Nsrc + (d.okc ? sc : 0);
    d.wt = WT + (size_t)n0 * Kdst + k0; d.gain = gain ? gain + k0 : nullptr;
}
__device__ __forceinline__ void conv_load(const ConvDesc& d, float (&v)[32], int lane) {
#pragma unroll
    for (int i = 0; i < 32; ++i) {
        const int ks = d.k0 + 2 * i + (lane >> 5) - d.koff;
        const bool ok = d.okc && ks >= 0 && ks < d.Ksrc;
        v[i] = ok ? __builtin_nontemporal_load(d.wp + (size_t)(2 * i) * d.Nsrc) : 0.f;
    }
}
__device__ __forceinline__ void conv_store(const ConvDesc& d, const float (&v)[32], LAS float* scr, int lane) {
    const int c = lane & 7;
    f32x4 g0 = {1.f, 1.f, 1.f, 1.f}, g1 = {1.f, 1.f, 1.f, 1.f};
    if (d.gain) { g0 = *(const f32x4*)(d.gain + 8 * c); g1 = *(const f32x4*)(d.gain + 8 * c + 4); }
#pragma unroll
    for (int i = 0; i < 32; ++i) scr[(2 * i + (lane >> 5)) * 33 + (lane & 31)] = v[i];
    asm volatile("s_waitcnt lgkmcnt(0)" ::: "memory");
#pragma unroll
    for (int j = 0; j < 4; ++j) {
        const int n = (lane >> 3) + 8 * j; const LAS float* s = scr + (8 * c) * 33 + n;
        u32x4 o; o.x = cvtpk(s[0 * 33] * g0[0], s[1 * 33] * g0[1]); o.y = cvtpk(s[2 * 33] * g0[2], s[3 * 33] * g0[3]); o.z = cvtpk(s[4 * 33] * g1[0], s[5 * 33] * g1[1]); o.w = cvtpk(s[6 * 33] * g1[2], s[7 * 33] * g1[3]);
        *(u32x4*)(d.wt + (size_t)n * d.Kdst + 8 * c) = o;
    }
    asm volatile("s_waitcnt lgkmcnt(0)" ::: "memory");
}
constexpr int IT_GU = 16 * (NGU / 32), IT_DN = (F / 64) * (D / 32), IT_IN = 16 * (NWIN / 32), IT_QKV = (KQKV / 64) * (NQKV / 32), IT_OUT = 16 * (D / 32);
constexpr int IT_LAYER = 2 * IT_GU + 2 * IT_DN + IT_IN + IT_QKV + IT_OUT;
__device__ __forceinline__ void conv_decode(ConvDesc& d, CArgsP Ap, int l, unsigned char* wl, int it, int lane) {
    int r = it; const int nl = lane & 31;
    if (r < 2 * IT_GU) {
        const int f = r / IT_GU; r -= f * IT_GU;
        const float* W = Ap->in[f ? I_F2GU : I_F1GU] + (size_t)l * D * NGU;
        const int nblk = NGU / 32, kb = r / nblk, nb = r - kb * nblk, n = nb * 32 + nl, tile = n >> 8, w = n & 255;
        const int sc = (w < 128) ? tile * 128 + w : F + tile * 128 + (w - 128);
        conv_set(d, W, NGU, D, sc, 0, (bf16*)(wl + (f ? WL_GU2 : WL_GU1)), D, kb * 64, nb * 32, lane, Ap->in[f ? I_F2N : I_F1N] + l * D);
        return;
    }
    r -= 2 * IT_GU;
    if (r < 2 * IT_DN) {
        const int f = r / IT_DN; r -= f * IT_DN;
        const float* W = Ap->in[f ? I_F2DN : I_F1DN] + (size_t)l * F * D;
        const int nblk = D / 32, kb = r / nblk, nb = r - kb * nblk;
        conv_set(d, W, D, F, nb * 32 + nl, 0, (bf16*)(wl + (f ? WL_DN2 : WL_DN1)), F, kb * 64, nb * 32, lane, nullptr);
        return;
    }
    r -= 2 * IT_DN;
    if (r < IT_IN) {
        const float* W = Ap->in[I_WIN] + (size_t)l * D * N_IN;
        const int nblk = NWIN / 32, kb = r / nblk, nb = r - kb * nblk, n = nb * 32 + nl;
        int sc = -1;
        if (n < 416) sc = n; else if (n < 422) sc = 1824 + (n - 416); else if (n < 512) sc = -1; else if (n < 768) sc = 416 + (n - 512); else if (n < 1920) sc = 672 + (n - 768);
        conv_set(d, W, N_IN, D, sc, 0, (bf16*)(wl + WL_IN), D, kb * 64, nb * 32, lane, Ap->in[I_MIXN] + l * D);
        return;
    }
    r -= IT_IN;
    if (r < IT_QKV) {
        const int nblk = NQKV / 32, kb = r / nblk, nb = r - kb * nblk, n = nb * 32 + nl;
        if (n < 576) {
            const int head = n / 96, dd = n - head * 96; int sd = dd;
            if (dd >= 64) { const int j2 = dd - 64; sd = 64 + (j2 >> 1) + 16 * (j2 & 1); }
            conv_set(d, Ap->in[I_WQB] + (size_t)l * 256 * 576, 576, 256, head * 96 + sd, 0, (bf16*)(wl + WL_QKV), KQKV, kb * 64, nb * 32, lane, nullptr);
        } else {
            const int sc = (n < 1344) ? n - 576 : -1;
            conv_set(d, Ap->in[I_WKVB] + (size_t)l * 128 * 768, 768, 128, sc, 256, (bf16*)(wl + WL_QKV), KQKV, kb * 64, nb * 32, lane, nullptr);
        }
        return;
    }
    r -= IT_QKV;
    {
        const float* W = Ap->in[I_WOUT] + (size_t)l * D * D;
        const int nblk = D / 32, kb = r / nblk, nb = r - kb * nblk;
        conv_set(d, W, D, D, nb * 32 + nl, 0, (bf16*)(wl + WL_OUT), D, kb * 64, nb * 32, lane, nullptr);
    }
}

constexpr int IT_P0 = 2 * IT_GU, IT_P1 = IT_LAYER - IT_P0 - IT_DN, IT_P3 = IT_DN;
__device__ __forceinline__ int conv_remap(int pass, int x) {
    if (pass == 2 || pass == 0) return x;
    if (pass == 3) return 2 * IT_GU + IT_DN + x;
    return (x < IT_DN) ? 2 * IT_GU + x : 2 * IT_GU + IT_DN + x;
}
__device__ __forceinline__ void convert_items(CArgsP Ap, int l, LAS unsigned char* lds, int pass, int gw, int NGW, int wave, int lane) {
    LAS float* scr = (LAS float*)(lds + wave * 16384);
    unsigned char* wl = Ap->ws + WS_W;
    const int NIT = (pass == 2) ? IT_LAYER : (pass == 0 ? IT_P0 : (pass == 1 ? IT_P1 : IT_P3));
    ConvDesc dA, dB; float va[32], vb[32];
    int it = gw;
    if (it < NIT) { conv_decode(dA, Ap, l, wl, conv_remap(pass, it), lane); conv_load(dA, va, lane); }
    while (it < NIT) {
        const int it2 = it + NGW; const bool has2 = it2 < NIT;
        if (has2) { conv_decode(dB, Ap, l, wl, conv_remap(pass, it2), lane); conv_load(dB, vb, lane); }
        conv_store(dA, va, scr, lane);
        if (!has2) break;
        const int it3 = it2 + NGW; const bool has3 = it3 < NIT;
        if (has3) { conv_decode(dA, Ap, l, wl, conv_remap(pass, it3), lane); conv_load(dA, va, lane); }
        conv_store(dB, vb, scr, lane);
        if (!has3) break;
        it = it3;
    }
}
__device__ __forceinline__ void prologue(CArgsP Ap, int l, LAS unsigned char* lds, int gw, int NGW, int wave, int lane) {
    unsigned char* ws = Ap->ws;
    convert_items(Ap, l, lds, (NGW == 2048) ? 0 : 2, gw, NGW, wave, lane);
    if (l != 0) return;
    {
        const float* x = Ap->in[I_X]; bf16* xb = (bf16*)(ws + WS_XB); float* ssq = (float*)(ws + WS_SSQ);
        f32x4 cur[4], nxtv[4];
        if (gw < M) { const f32x4* xr = (const f32x4*)(x + (size_t)gw * D) + lane;
#pragma unroll
            for (int j = 0; j < 4; ++j) cur[j] = __builtin_nontemporal_load(xr + 64 * j); }
        for (int row = gw; row < M; row += NGW) {
            const int rn = row + NGW;
            if (rn < M) { const f32x4* xr = (const f32x4*)(x + (size_t)rn * D) + lane;
#pragma unroll
                for (int j = 0; j < 4; ++j) nxtv[j] = __builtin_nontemporal_load(xr + 64 * j); }
            u32x2* o = (u32x2*)(xb + (size_t)row * D) + lane; float s = 0.f;
#pragma unroll
            for (int j = 0; j < 4; ++j) { const f32x4 v = cur[j]; s += (v[0] * v[0] + v[1] * v[1]) + (v[2] * v[2] + v[3] * v[3]); o[64 * j] = (u32x2){cvtpk(v[0], v[1]), cvtpk(v[2], v[3])}; }
            s = wave_sum(s, lane);
            if (lane == 0) ssq[row] = s;
#pragma unroll
            for (int j = 0; j < 4; ++j) cur[j] = nxtv[j];
        }
    }
    float* T = (float*)(ws + WS_ROPE);
    for (int e = gw * 64 + lane; e < SEQ * 16; e += NGW * 64) {
        const int pos = e >> 4, j = e & 15;
        const float inv = exp2f(-(float)j * 0.8304820237218405f);
        const float ang = (float)pos * inv;
        const double a = (double)ang, k = __builtin_rint(a * 0.15915494309189535), x = a - k * 6.283185307179586, x2 = x * x;
        double s = x, c = 1.0, ts = x, tc = 1.0;
#pragma unroll 1
        for (int i = 1; i <= 12; ++i) {
            tc = -tc * x2 / (double)((2 * i - 1) * (2 * i)); c += tc;
            ts = -ts * x2 / (double)((2 * i) * (2 * i + 1)); s += ts;
        }
        *(f32x2*)(T + (size_t)e * 2) = (f32x2){(float)c, (float)s};
    }
}

__device__ __forceinline__ void norm_phase(const float* x, const float* g, bf16* xn, float* fout, int gw, int NGW, int lane) {
    f32x4 gv[4];
#pragma unroll
    for (int j = 0; j < 4; ++j) gv[j] = *((const f32x4*)g + lane + 64 * j);
    for (int row = gw; row < M; row += NGW) {
        const f32x4* xr = (const f32x4*)(x + (size_t)row * D) + lane;
        f32x4 v[4]; float s = 0.f;
#pragma unroll
        for (int j = 0; j < 4; ++j) { v[j] = xr[64 * j]; s += (v[j][0] * v[j][0] + v[j][1] * v[j][1]) + (v[j][2] * v[j][2] + v[j][3] * v[j][3]); }
        const float rstd = 1.0f / sqrtf(wave_sum(s, lane) * (1.0f / D) + EPS);
        if (fout) {
            f32x4* o = (f32x4*)(fout + (size_t)row * D) + lane;
#pragma unroll
            for (int j = 0; j < 4; ++j) o[64 * j] = (v[j] * rstd) * gv[j];
        } else {
            u32x2* o = (u32x2*)(xn + (size_t)row * D) + lane;
#pragma unroll
            for (int j = 0; j < 4; ++j) { const f32x4 y = (v[j] * rstd) * gv[j]; o[64 * j] = (u32x2){cvtpk(y[0], y[1]), cvtpk(y[2], y[3])}; }
        }
    }
}

__device__ __forceinline__ void prep_phase(CArgsP Ap, int l, LAS unsigned char* lds, int tid, int wave, int lane, int bid, int G) {
    unsigned char* ws = Ap->ws;
    const bf16* Zs = (const bf16*)(ws + WS_ZS); const bf16* U = (const bf16*)(ws + WS_U);
    bf16* QKn = (bf16*)(ws + WS_QKN); bf16* Qp = (bf16*)(ws + WS_QP); bf16* Kp = (bf16*)(ws + WS_KP); bf16* Y = (bf16*)(ws + WS_XN);
    const float* T = (const float*)(ws + WS_ROPE); const float* Fl = (const float*)(ws + WS_FL);
    const float* qg = Ap->in[I_QAN] + l * 256; const float* kg = Ap->in[I_KVAN] + l * 128;
    const float* pw = Ap->in[I_POOLW] + (size_t)l * 4 * 4096; const float* ps = Ap->in[I_POOLS] + l * 256;
    const float* fb = Ap->in[I_FOXB] + l * 6;
    LAS unsigned char* Uw = lds;
    LAS unsigned char* Wt = lds + 40960;
    LAS unsigned char* Pb = lds + 40960 + 36864;
    LAS double* Sd = (LAS double*)(lds + 114688);
    for (int idx = tid; idx < 4096; idx += 512) {
        const int g = idx >> 10, c = (idx >> 4) & 63, d4 = (idx & 15) * 4;
        const f32x4 w = *(const f32x4*)(pw + g * 4096 + c * 64 + d4);
#pragma unroll
        for (int i = 0; i < 4; ++i) *(LAS unsigned short*)(Wt + ((g * 64 + d4 + i) * 72 + c) * 2) = (unsigned short)f2bf(w[i]);
    }
    for (int tile = bid; tile < M / 64; tile += G) {
        const int r0 = tile * 64, tloc0 = r0 & (SEQ - 1);
        __syncthreads();
        for (int idx = tid; idx < 79 * 32; idx += 512) {
            const int i = idx >> 5, c8 = (idx & 31) * 8; u32x4 v = {0u, 0u, 0u, 0u};
            if (tloc0 - 15 + i >= 0) v = *(const u32x4*)(U + (size_t)(r0 - 15 + i) * 256 + c8);
            *(LAS u32x4*)(Uw + i * 512 + c8 * 2) = v;
        }
        {
            u32x2 qa[8]; unsigned ka[8]; unsigned short r1[8], r2[8];
#pragma unroll
            for (int i = 0; i < 8; ++i) {
                const bf16* z = Zs + (size_t)(r0 + wave * 8 + i) * 512;
                qa[i] = *(const u32x2*)(z + 4 * lane); ka[i] = *(const unsigned*)(z + 256 + 2 * lane);
                r1[i] = z[384 + (lane & 15)]; r2[i] = z[400 + (lane & 15)];
            }
            const f32x4 g4 = *(const f32x4*)(qg + 4 * lane); const f32x2 g2 = *(const f32x2*)(kg + 2 * lane);
#pragma unroll
            for (int i = 0; i < 8; ++i) {
                const int row = r0 + wave * 8 + i, pos = row & (SEQ - 1);
                const float q0 = bf2f(qa[i].x & 0xffffu), q1 = bf2f(qa[i].x >> 16), q2 = bf2f(qa[i].y & 0xffffu), q3 = bf2f(qa[i].y >> 16);
                const float k0 = bf2f(ka[i] & 0xffffu), k1 = bf2f(ka[i] >> 16);
                const float sq = wave_sum((q0 * q0 + q1 * q1) + (q2 * q2 + q3 * q3), lane), sk = wave_sum(k0 * k0 + k1 * k1, lane);
                const float rq = 1.0f / sqrtf(sq * (1.0f / 256.0f) + EPS), rk = 1.0f / sqrtf(sk * (1.0f / 128.0f) + EPS);
                bf16* o = QKn + (size_t)row * KQKV;
                *(u32x2*)(o + 4 * lane) = (u32x2){cvtpk(q0 * rq * g4[0], q1 * rq * g4[1]), cvtpk(q2 * rq * g4[2], q3 * rq * g4[3])};
                *(unsigned*)(o + 256 + 2 * lane) = cvtpk(k0 * rk * g2[0], k1 * rk * g2[1]);
                if (lane < 16) {
                    const float x1 = bf2f(r1[i]), x2 = bf2f(r2[i]);
                    const f32x2 cs = *(const f32x2*)(T + (size_t)(pos * 16 + lane) * 2);
                    const unsigned pk = cvtpk(x1 * cs[0] - x2 * cs[1], x2 * cs[0] + x1 * cs[1]);
                    bf16* kp = Kp + (size_t)row * QP + 64 + 2 * lane;
#pragma unroll
                    for (int hh = 0; hh < 6; ++hh) *(unsigned*)(kp + hh * 96) = pk;
                }
            }
        }
        asm volatile("s_waitcnt lgkmcnt(0)\n\ts_barrier" ::: "memory");
        {
            const int g = wave >> 1, sub = (wave & 1) * 64 + lane;
#define WSUM(W) do { _Pragma("unroll 4") for (int it_ = 0; it_ < 16; ++it_) { const int id_ = sub + 128 * it_, tt = id_ >> 5, cp = g * 32 + (id_ & 31); \
                unsigned v_[W]; _Pragma("unroll") for (int i = 0; i < W; ++i) v_[i] = *(const LAS unsigned*)(Uw + (15 + tt - i) * 512 + cp * 4); \
                float s0 = 0.f, s1 = 0.f; _Pragma("unroll") for (int i = 0; i < W; ++i) { s0 += bf2f(v_[i] & 0xffffu); s1 += bf2f(v_[i] >> 16); } \
                const float inv = 1.0f / (float)min(tloc0 + tt + 1, W); \
                *(LAS unsigned*)(Pb + tt * 528 + cp * 4) = cvtpk(s0 * inv - bf2f(v_[0] & 0xffffu), s1 * inv - bf2f(v_[0] >> 16)); } } while (0)
            if (g == 0) WSUM(2); else if (g == 1) WSUM(4); else if (g == 2) WSUM(8); else WSUM(16);
#undef WSUM
        }
        asm volatile("s_waitcnt lgkmcnt(0)\n\ts_barrier" ::: "memory");
        {
            const int g = wave >> 1, tb = wave & 1, r = lane & 31, h = lane >> 5;
#pragma unroll
            for (int db = 0; db < 2; ++db) {
                f32x16 acc;
#pragma unroll
                for (int i = 0; i < 16; ++i) acc[i] = 0.f;
#pragma unroll
                for (int ks = 0; ks < 4; ++ks) {
                    const bf16x8 a = *(const LAS bf16x8*)(Wt + ((g * 64 + 32 * db + r) * 72 + 16 * ks + 8 * h) * 2);
                    const bf16x8 b = *(const LAS bf16x8*)(Pb + (32 * tb + r) * 528 + (g * 64 + 16 * ks + 8 * h) * 2);
                    acc = __builtin_amdgcn_mfma_f32_32x32x16_bf16(a, b, acc, 0, 0, 0);
                }
                bf16* yp = Y + (size_t)(r0 + 32 * tb + r) * D + 384 + g * 64 + 32 * db + 4 * h;
                const float* sp = ps + g * 64 + 32 * db + 4 * h;
#pragma unroll
                for (int q = 0; q < 4; ++q) {
                    const f32x4 s4 = *(const f32x4*)(sp + 8 * q);
                    *(u32x2*)(yp + 8 * q) = (u32x2){cvtpk(acc[4 * q] * s4[0], acc[4 * q + 1] * s4[1]), cvtpk(acc[4 * q + 2] * s4[2], acc[4 * q + 3] * s4[3])};
                }
            }
        }
    }
    __syncthreads();
}

__device__ __forceinline__ void scan_phase(CArgsP Ap, int l, LAS unsigned char* lds, int tid, int wave, int lane, int sbid, int SG) {
    unsigned char* ws = Ap->ws;
    bf16* Qp = (bf16*)(ws + WS_QP); bf16* Kp = (bf16*)(ws + WS_KP);
    const float* Fl = (const float*)(ws + WS_FL); const float* fb = Ap->in[I_FOXB] + l * 6;
    LAS double* Sd = (LAS double*)(lds + 114688);
    const int bid = sbid, G = SG;
    for (int sb = bid; sb < NB * 6 * 4; sb += G) {
        const int s = sb >> 2, quarter = sb & 3;
        const int b = s / 6, h = s - b * 6;
        const float bias = fb[h];
        double pre[8]; double run = 0.0;
#pragma unroll
        for (int j = 0; j < 8; ++j) {
            const float x = Fl[(size_t)(b * SEQ + tid * 8 + j) * 8 + h] + bias;
            const float ls = fminf(x, 0.f) - log1pf(expf(-fabsf(x)));
            run += (double)ls; pre[j] = run;
        }
        double inc = run;
#pragma unroll
        for (int o = 1; o < 64; o <<= 1) { const long long iv = __builtin_bit_cast(long long, inc); const int src = ((lane - o) & 63) << 2; const unsigned lo = (unsigned)__builtin_amdgcn_ds_bpermute(src, (int)(unsigned)iv), hi = (unsigned)__builtin_amdgcn_ds_bpermute(src, (int)(unsigned)(iv >> 32)); const double t = __builtin_bit_cast(double, ((unsigned long long)hi << 32) | lo); if (lane >= o) inc += t; }
        __syncthreads();
        if (lane == 63) Sd[wave] = inc;
        __syncthreads();
        double off = inc - run;
        for (int w2 = 0; w2 < wave; ++w2) off += Sd[w2];
        float* C2 = (float*)(ws + WS_C2) + (size_t)s * SEQ;
        if ((tid >> 7) == quarter)
#pragma unroll
        for (int j = 0; j < 8; ++j) {
            const double C = (off + pre[j]) * 1.4426950408889634;
            C2[tid * 8 + j] = (float)C;
            const unsigned c1 = f2bf((float)C); const double r1 = C - (double)bf2f(c1);
            const unsigned c2 = f2bf((float)r1); const double r2 = r1 - (double)bf2f(c2);
            const unsigned c3 = f2bf((float)r2);
            const size_t row = (size_t)b * SEQ + tid * 8 + j;
            u32x4* q = (u32x4*)(Qp + row * QP + (6 + h) * 96 + 64); u32x4* k = (u32x4*)(Kp + row * QP + (6 + h) * 96 + 64);
            const u32x4 z4 = {0u, 0u, 0u, 0u};
            q[0] = (u32x4){c1 | (c2 << 16), c3 | (0x3F80u << 16), 0x3F803F80u, 0u}; q[1] = z4; q[2] = z4; q[3] = z4;
            k[0] = (u32x4){0x3F803F80u, 0x3F80u | ((c1 ^ 0x8000u) << 16), (c2 ^ 0x8000u) | ((c3 ^ 0x8000u) << 16), 0u}; k[1] = z4; k[2] = z4; k[3] = z4;
        }
        __syncthreads();
    }
}

namespace att {
constexpr int KSTR = 208, KBUF = 64 * KSTR, VBUF = 8192, VB0 = 2 * KBUF;
__device__ __forceinline__ int crow(int i, int h) { return (i & 3) + 8 * (i >> 2) + 4 * h; }
typedef short v4i16_t __attribute__((ext_vector_type(4)));
__device__ __forceinline__ s16x4 vtr(const LAS unsigned char* p) { return __builtin_bit_cast(s16x4, __builtin_amdgcn_ds_read_tr16_b64_v4i16((LAS v4i16_t*)p)); }
#define MFMA32(a, b, c) __builtin_amdgcn_mfma_f32_32x32x16_bf16((a), (b), (c), 0, 0, 0)

__device__ __forceinline__ void glds16(const void* gsrc, unsigned lds_dst) { unsigned keep;
    asm volatile("s_mov_b32 %0, m0\n\ts_mov_b32 m0, %2\n\ts_nop 0\n\tglobal_load_lds_dwordx4 %1, off\n\ts_mov_b32 m0, %0" : "=&s"(keep) : "v"(gsrc), "s"(lds_dst) : "memory"); }
constexpr int NSLOT = 4, SLOT = 20480, VOFF = 12288;

__device__ __forceinline__ void attn_unit(LAS unsigned char* lds, const bf16* Qp, const bf16* Kp, const bf16* V, bf16* Y, int b, int head, int qb, int tbase, int tid, int w, int lane) {
    const int r = lane & 31, h = lane >> 5;
    const size_t rowbase = (size_t)b * SEQ; const int q0 = qb * 256;
    const bf16* qptr = Qp + (rowbase + q0 + 32 * w + r) * QP + head * 96 + 8 * h;
    bf16x8 qf[6];
#pragma unroll
    for (int s = 0; s < 6; ++s) qf[s] = *(const bf16x8*)(qptr + 16 * s);
    f32x16 o0, o1, s0, s1;
#pragma unroll
    for (int i = 0; i < 16; ++i) { o0[i] = 0.f; o1[i] = 0.f; s0[i] = 0.f; s1[i] = 0.f; }
    float mref = 0.f, lrun = 0.f;
    f32x16 negm;
#pragma unroll
    for (int i = 0; i < 16; ++i) negm[i] = 0.f;
    const int NT = 4 * (qb + 1) - tbase;
    const size_t rowk = rowbase + (size_t)tbase * 64;
    const bool low = w < 4;
    const unsigned lbase = (unsigned)(uintptr_t)lds;
    const bf16* gA = Kp + (rowk + lane) * QP + head * 96 + w * 8; const unsigned lA = w * 1024;
    const bf16* gB; unsigned lB; size_t stB;
    if (low) { gB = Kp + (rowk + lane) * QP + head * 96 + (w + 8) * 8; lB = (w + 8) * 1024; stB = (size_t)64 * QP; }
    else { gB = V + (rowk + 16 * (w - 4) + (lane >> 2)) * VP + head * 64 + (lane & 3) * 8; lB = VOFF + (w - 4) * 1024; stB = (size_t)64 * VP; }
    const bf16* gC = V + (rowk + 16 * (w & 3) + (lane >> 2)) * VP + head * 64 + 32 + (lane & 3) * 8; const unsigned lC = VOFF + 4096 + (w & 3) * 1024;
#define ISSUE(tt) do { const unsigned sl_ = lbase + ((tt) & 3) * SLOT; \
        glds16(gA, (unsigned)__builtin_amdgcn_readfirstlane(sl_ + lA)); gA += (size_t)64 * QP; \
        glds16(gB, (unsigned)__builtin_amdgcn_readfirstlane(sl_ + lB)); gB += stB; \
        if (low) { glds16(gC, (unsigned)__builtin_amdgcn_readfirstlane(sl_ + lC)); gC += (size_t)64 * VP; } } while (0)
#define WAIT_BAR_DMA(pending) do { if (pending) { if (low) asm volatile("s_waitcnt vmcnt(3) lgkmcnt(0)\n\ts_barrier" ::: "memory"); else asm volatile("s_waitcnt vmcnt(2) lgkmcnt(0)\n\ts_barrier" ::: "memory"); } \
        else asm volatile("s_waitcnt vmcnt(0) lgkmcnt(0)\n\ts_barrier" ::: "memory"); } while (0)
    ISSUE(0); ISSUE(1); ISSUE(2);
    WAIT_BAR_DMA(true);
    const int i16 = lane & 15, q4 = i16 >> 2, p4 = i16 & 3, blk = (lane >> 4) & 1;
    const int voff = VOFF + (4 * h + q4) * 64 + blk * 32 + p4 * 8;
    const int qmin = q0 + 32 * w, qme = qmin + r;
    const LAS unsigned char* kb0 = lds + h * 1024 + r * 16;
    {
#pragma unroll
        for (int st = 0; st < 6; ++st) {
            const bf16x8 a0 = *(const LAS bf16x8*)(kb0 + st * 2048), a1 = *(const LAS bf16x8*)(kb0 + st * 2048 + 512);
            s0 = MFMA32(a0, qf[st], s0); s1 = MFMA32(a1, qf[st], s1);
        }
    }
    asm volatile("s_nop 15\n\ts_nop 15" : "+v"(s0), "+v"(s1));
#define MAX3(a, b, c) __builtin_fmaxf(__builtin_fmaxf((a), (b)), (c))
#define ROWMAX(S0, S1, MX) do { float mxa_ = MAX3(S0[0], S0[1], S1[0]), mxb_ = MAX3(S0[2], S0[3], S1[1]); mxa_ = MAX3(mxa_, S1[2], S1[3]); \
        _Pragma("unroll") for (int i = 4; i < 16; i += 4) { mxa_ = MAX3(mxa_, S0[i], S0[i + 1]); mxb_ = MAX3(mxb_, S0[i + 2], S0[i + 3]); mxa_ = MAX3(mxa_, S1[i], S1[i + 1]); mxb_ = MAX3(mxb_, S1[i + 2], S1[i + 3]); } \
        MX = MAX3(mxa_, mxb_, mxb_); { const float ot_ = lane_xor(MX, lane, 32); MX = MAX3(MX, ot_, ot_); } } while (0)
#define MASK(S0, S1, TT) do { const int kmin_ = 64 * ((TT) + tbase); if (kmin_ + 63 > qmin) { \
        _Pragma("unroll") for (int i = 0; i < 16; ++i) { const int key = kmin_ + crow(i, h); if (key > qme) S0[i] = -INFINITY; if (key + 32 > qme) S1[i] = -INFINITY; } } } while (0)
    { if (NT == 4) MASK(s0, s1, 0); float mx; ROWMAX(s0, s1, mx); mref = mx;
#pragma unroll
      for (int i = 0; i < 16; ++i) { s0[i] -= mx; s1[i] -= mx; negm[i] = -mx; } }
    bool cur_act = true;
#define ATT_ITER(BAND) do { \
        const int kslot = ((t + 1) & 3) * SLOT, vslot = (t & 3) * SLOT; \
        const bool more1 = (t + 1 < NT), more3 = (t + 3 < NT); \
        if (more3) ISSUE(t + 3); \
        const bool next_act = (BAND) ? (more1 && (64 * (t + 1 + tbase) <= qmin + 31)) : true; \
        f32x16 n0, n1; n0 = negm; n1 = negm; \
        const LAS unsigned char* kb = kb0 + kslot; \
        float mx = -INFINITY; \
        if (!(BAND) || cur_act) { \
            bf16x8 pf[2][2]; \
            { \
                if (next_act) { bf16x8 kf[12]; _Pragma("unroll") for (int st = 0; st < 6; ++st) { kf[2 * st] = *(const LAS bf16x8*)(kb + st * 2048); kf[2 * st + 1] = *(const LAS bf16x8*)(kb + st * 2048 + 512); } \
                    _Pragma("unroll") for (int st = 0; st < 6; ++st) { n0 = MFMA32(kf[2 * st], qf[st], n0); n1 = MFMA32(kf[2 * st + 1], qf[st], n1); } } \
                f32x2 sum2 = {0.f, 0.f}; \
                _Pragma("unroll") for (int i = 0; i < 16; i += 2) { \
                    f32x2 a, c; \
                    a[0] = __builtin_amdgcn_exp2f(s0[i]); a[1] = __builtin_amdgcn_exp2f(s0[i + 1]); c[0] = __builtin_amdgcn_exp2f(s1[i]); c[1] = __builtin_amdgcn_exp2f(s1[i + 1]); \
                    s0[i] = a[0]; s0[i + 1] = a[1]; s1[i] = c[0]; s1[i + 1] = c[1]; sum2 += a; sum2 += c; } \
                lrun += sum2[0] + sum2[1]; \
                _Pragma("unroll") for (int s = 0; s < 2; ++s) { \
                    u32x4 a = {cvtpk(s0[8 * s], s0[8 * s + 1]), cvtpk(s0[8 * s + 2], s0[8 * s + 3]), cvtpk(s0[8 * s + 4], s0[8 * s + 5]), cvtpk(s0[8 * s + 6], s0[8 * s + 7])}; \
                    u32x4 c = {cvtpk(s1[8 * s], s1[8 * s + 1]), cvtpk(s1[8 * s + 2], s1[8 * s + 3]), cvtpk(s1[8 * s + 4], s1[8 * s + 5]), cvtpk(s1[8 * s + 6], s1[8 * s + 7])}; \
                    pf[0][s] = __builtin_bit_cast(bf16x8, a); pf[1][s] = __builtin_bit_cast(bf16x8, c); } \
                if (!(BAND)) {   \
                    __builtin_amdgcn_sched_group_barrier(0x100, 4, 0); \
                    _Pragma("unroll") for (int g_ = 0; g_ < 8; ++g_) { __builtin_amdgcn_sched_group_barrier(0x008, 1, 0); __builtin_amdgcn_sched_group_barrier(0x100, 1, 0); __builtin_amdgcn_sched_group_barrier(0x400, 3, 0); __builtin_amdgcn_sched_group_barrier(0x002, 4, 0); } \
                    _Pragma("unroll") for (int g_ = 0; g_ < 4; ++g_) { __builtin_amdgcn_sched_group_barrier(0x008, 1, 0); __builtin_amdgcn_sched_group_barrier(0x400, 3, 0); __builtin_amdgcn_sched_group_barrier(0x002, 4, 0); } } \
            } \
            __builtin_amdgcn_sched_barrier(0); \
            { \
                const LAS unsigned char* vb = lds + vslot + voff; \
                _Pragma("unroll") for (int kb2 = 0; kb2 < 2; ++kb2) \
                    _Pragma("unroll") for (int s = 0; s < 2; ++s) { \
                        const LAS unsigned char* vp = vb + (32 * kb2 + 16 * s) * 64; \
                        const s16x4 l0 = vtr(vp), h0 = vtr(vp + 8 * 64), l1 = vtr(vp + 4096), h1 = vtr(vp + 4096 + 8 * 64); \
                        const bf16x8 v0 = __builtin_shufflevector(l0, h0, 0, 1, 2, 3, 4, 5, 6, 7), v1 = __builtin_shufflevector(l1, h1, 0, 1, 2, 3, 4, 5, 6, 7); \
                        o0 = MFMA32(v0, pf[kb2][s], o0); o1 = MFMA32(v1, pf[kb2][s], o1); } \
                if (next_act) { if (BAND) MASK(n0, n1, t + 1); ROWMAX(n0, n1, mx); } \
            } \
        } else if (next_act) { \
            _Pragma("unroll") for (int st = 0; st < 6; ++st) { const bf16x8 a0 = *(const LAS bf16x8*)(kb + st * 2048), a1 = *(const LAS bf16x8*)(kb + st * 2048 + 512); n0 = MFMA32(a0, qf[st], n0); n1 = MFMA32(a1, qf[st], n1); } \
            MASK(n0, n1, t + 1); ROWMAX(n0, n1, mx); \
        } \
        WAIT_BAR_DMA(more3);                             \
        s0 = n0; s1 = n1; cur_act = next_act; \
        if (__builtin_amdgcn_ballot_w64(mx > 8.0f) != 0ull) { \
            const float dl = fmaxf(mx, 0.f), f = __builtin_amdgcn_exp2f(-dl); \
            mref += dl; lrun *= f; \
            _Pragma("unroll") for (int i = 0; i < 16; ++i) { s0[i] -= dl; s1[i] -= dl; o0[i] *= f; o1[i] *= f; } \
            _Pragma("unroll") for (int i = 0; i < 16; ++i) negm[i] = -mref; \
        } \
    } while (0)
    int t = 0;
    for (; t + 5 < NT; ++t) ATT_ITER(false);
    for (; t < NT; ++t) ATT_ITER(true);
#undef ROWMAX
#undef MASK
#undef ATT_ITER
#undef MAX3
#undef ISSUE
#undef WAIT_BAR_DMA
    const float lt = lrun + lane_xor(lrun, lane, 32);
    const float inv = 1.0f / lt;
    const int ycol = (head < 6) ? head * 64 : 640 + (head - 6) * 64;
    bf16* yp = Y + (rowbase + qme) * D + ycol + 4 * h;
#pragma unroll
    for (int g = 0; g < 4; ++g) {
        *(u32x2*)(yp + 8 * g) = (u32x2){cvtpk(o0[4 * g] * inv, o0[4 * g + 1] * inv), cvtpk(o0[4 * g + 2] * inv, o0[4 * g + 3] * inv)};
        *(u32x2*)(yp + 32 + 8 * g) = (u32x2){cvtpk(o1[4 * g] * inv, o1[4 * g + 1] * inv), cvtpk(o1[4 * g + 2] * inv, o1[4 * g + 3] * inv)};
    }
}
}

#define XB_TMO      128
#define XB_XCNT(j)  (256  + 64 * (j))
#define XB_XSUB(j)  (1280 + 64 * (j))
#define XB_XGEN(j)  (2304 + 64 * (j))
#define XB_TOP      3328
#define XB_TOPGEN   3392
#define XCD_BAR_WORDS 3456
#define XB_SPIN_CAP (1u << 18)

__device__ __forceinline__ unsigned xb_ld(unsigned* p)              { return __hip_atomic_load(p, __ATOMIC_RELAXED, __HIP_MEMORY_SCOPE_AGENT); }
__device__ __forceinline__ unsigned xb_add(unsigned* p, unsigned v) { return __hip_atomic_fetch_add(p, v, __ATOMIC_RELAXED, __HIP_MEMORY_SCOPE_AGENT); }
__device__ __forceinline__ unsigned xb_xcc_id() { return (unsigned)__builtin_amdgcn_s_getreg((3 << 11) | 20) & 0xFu; }
#define XB_SPIN(cond, bar) do { unsigned _sp = 0; while (cond) { __builtin_amdgcn_s_sleep(1); \
    if ((++_sp & 255u) == 0u) { if (xb_ld(&(bar)[XB_TMO])) break; if (_sp > XB_SPIN_CAP) { atomicAdd(&(bar)[XB_TMO], 1u); break; } } } } while (0)

struct XcdBarrier {
    unsigned* bar; unsigned x;
    volatile LAS unsigned* st;
};

__device__ __forceinline__ XcdBarrier xcd_barrier_post(unsigned* bar, volatile LAS unsigned* st) {
    XcdBarrier b; b.bar = bar; b.x = xb_xcc_id(); b.st = st;
    if (threadIdx.x == 0) (void)xb_add(&bar[XB_XCNT(b.x)], 1u);
    return b;
}
__device__ __forceinline__ void xcd_barrier_complete(unsigned* bar, unsigned x, unsigned& nloc, unsigned& nx) {
    const unsigned G = gridDim.x * gridDim.y * gridDim.z;
    unsigned sum, cnt, mine, sp = 0u;
    for (;;) {
        sum = 0u; cnt = 0u; mine = 0u;
#pragma unroll
        for (unsigned j = 0; j < 16; ++j) { const unsigned c = xb_ld(&bar[XB_XCNT(j)]); sum += c; cnt += (c > 0u) ? 1u : 0u; mine = (j == x) ? c : mine; }
        if (sum == G) break;
        __builtin_amdgcn_s_sleep(1);
        if ((++sp & 255u) == 0u) { if (xb_ld(&bar[XB_TMO])) break; if (sp > XB_SPIN_CAP) { atomicAdd(&bar[XB_TMO], 1u); break; } }
    }
    nloc = mine > 0u ? mine : 1u; nx = cnt > 0u ? cnt : 1u;
}

__device__ __forceinline__ void xcd_barrier(const XcdBarrier& b) {
    asm volatile("s_waitcnt vmcnt(0)" ::: "memory");
    __syncthreads();
    if (threadIdx.x == 0) {
        unsigned* bar = b.bar;
        __builtin_amdgcn_s_waitcnt(0);
        unsigned nloc = b.st[0], nx = b.st[1];
        if (nloc == 0u) { xcd_barrier_complete(bar, b.x, nloc, nx); b.st[0] = nloc; b.st[1] = nx; }
        const unsigned old = xb_add(&bar[XB_XSUB(b.x)], 1u);
        const unsigned gen = old / nloc;
        if (old + 1u == (gen + 1u) * nloc) {
            __builtin_amdgcn_fence(__ATOMIC_RELEASE, "agent");
            asm volatile("s_waitcnt vmcnt(0)" ::: "memory");
            const unsigned og = xb_add(&bar[XB_TOP], 1u);
            const unsigned tg = og / nx;
            if (og + 1u == (tg + 1u) * nx) xb_add(&bar[XB_TOPGEN], 1u);
            else XB_SPIN(xb_ld(&bar[XB_TOPGEN]) == tg, bar);
            __builtin_amdgcn_fence(__ATOMIC_ACQUIRE, "agent");
            xb_add(&bar[XB_XGEN(b.x)], 1u);
            asm volatile("s_waitcnt vmcnt(0)" ::: "memory");
        } else {
            XB_SPIN(xb_ld(&bar[XB_XGEN(b.x)]) == gen, bar);
            __builtin_amdgcn_fence(__ATOMIC_ACQUIRE, "agent");
            asm volatile("s_waitcnt vmcnt(0)" ::: "memory");
        }
    }
    __syncthreads();
}

constexpr int LDS_RSTD = LDS_MISC + 256;
__device__ __forceinline__ void fill_rstd(LAS unsigned char* lds, const pg8::StaticOrder& S, const float* ssq, int tid) {
    LAS float* tbl = (LAS float*)(lds + LDS_RSTD);
    pg8::Unit u;
    if (tid < 256) for (int i = 0; i < 8 && S.next(i, u); ++i) tbl[i * 256 + tid] = 1.0f / sqrtf(ssq[u.pm * 256 + tid] * (1.0f / D) + EPS);
    __syncthreads();
}

constexpr int NPH = 1 + 10 * DEPTH;
#ifndef PH_EN
#define PH_EN 0xffff
#endif
#define EN(b) ((PH_EN >> (b)) & 1)
__global__ void __launch_bounds__(512, 2) mk_fwd(Args A_unused) {
    extern __shared__ __attribute__((aligned(16))) unsigned char lds_raw[];
    LAS unsigned char* lds = (LAS unsigned char*)lds_raw;
    cg::grid_group grid = cg::this_grid();
    const int ph_lo = A_unused.ph_lo, ph_hi = A_unused.ph_hi;
    if (threadIdx.x < 64) ((LAS unsigned*)(lds + LDS_MISC))[threadIdx.x] = 0u;
    __syncthreads();
    XcdBarrier bar = xcd_barrier_post((unsigned*)(A_unused.ws + WS_CTL) + CW_BAR, (volatile LAS unsigned*)(lds + LDS_MISC) + 8);
#define PHASE_ENTER() \
    CArgsP Ap = (CArgsP)__builtin_amdgcn_kernarg_segment_ptr(); asm volatile("" : "+s"(Ap)); \
    int tid = threadIdx.x; asm volatile("" : "+v"(tid)); \
    const int lane = tid & 63, wave = __builtin_amdgcn_readfirstlane(tid >> 6); \
    int bid = blockIdx.x, G = gridDim.x; asm volatile("" : "+s"(bid), "+s"(G)); \
    const int gw = bid * 8 + wave, NGW = G * 8; \
    unsigned char* ws = Ap->ws; asm volatile("" : "+s"(ws)); \
    unsigned char* wl = ws + WS_W; \
    int KD = D, KF = F, KQ = KQKV; asm volatile("" : "+s"(KD), "+s"(KF), "+s"(KQ)); \
    (void)lane; (void)gw; (void)NGW; (void)wl; (void)tid; (void)KD; (void)KF; (void)KQ;
#ifdef PROBE_MASK
    unsigned long long tacc = 0;
#endif
    for (int ph = ph_lo; ph < ph_hi; ++ph) {
#ifdef PROBE_MASK
        const unsigned long long tph0 = __builtin_amdgcn_s_memrealtime();
#endif
        int l = 0, k = -1;
        if (ph == NPH - 1) k = 13; else { l = ph / 10; k = ph % 10; }
        asm volatile("" : "+s"(k), "+s"(l));
        if (k == 0) {
            PHASE_ENTER();
            if (EN(12)) prologue(Ap, l, lds, gw, NGW, wave, lane);
        } else if (k == 13) {
            PHASE_ENTER();
            if (EN(0)) norm_phase(Ap->out, Ap->in[I_FINN], nullptr, Ap->out, gw, NGW, lane);
        } else if (EN(1) && (k == 1 || k == 8)) {
            PHASE_ENTER();
            pg8::Gemm g{(const bf16*)(ws + WS_XB), (const bf16*)(wl + (k == 1 ? WL_GU1 : WL_GU2)), M, NGU, KD}; pg8::StaticOrder S; S.init(M, NGU, G, bid);
            const float* ssqp = (const float*)(ws + WS_SSQ) + (size_t)(l * 3 + (k == 1 ? 0 : 2)) * M;
            fill_rstd(lds, S, ssqp, tid);
            EpiSwiglu E{(bf16*)(ws + WS_BIG), ssqp, (const LAS float*)(lds + LDS_RSTD), 0};
            pg8::gemm_phase<EpiSwiglu, pg8::StaticOrder, true, true>(lds, g, S, E);
            if (G == 256 && bid >= 128) convert_items(Ap, l, lds, (k == 1) ? 1 : 3, (bid - 128) * 8 + wave, 1024, wave, lane);
        } else if (EN(2) && (k == 2 || k == 9)) {
            PHASE_ENTER();
            pg8::Gemm g{(const bf16*)(ws + WS_BIG), (const bf16*)(wl + (k == 2 ? WL_DN1 : WL_DN2)), M, D, KF}; pg8::StaticOrder S; S.init(M, D, G, bid);
            EpiResid E{(l == 0 && k == 2) ? Ap->in[I_X] : Ap->out, Ap->out, (bf16*)(ws + WS_XB), (float*)(ws + WS_SSQ) + (size_t)(k == 2 ? l * 3 + 1 : l * 3 + 3) * M, 0.5f};
            pg8::gemm_phase<EpiResid, pg8::StaticOrder, true, true>(lds, g, S, E);
        } else if (EN(4) && k == 3) {
            PHASE_ENTER();
            pg8::Gemm g{(const bf16*)(ws + WS_XB), (const bf16*)(wl + WL_IN), M, NWIN, KD}; pg8::StaticOrder S; S.init(M, NWIN, G, bid);
            fill_rstd(lds, S, (const float*)(ws + WS_SSQ) + (size_t)(l * 3 + 1) * M, tid);
            EpiWin E{(bf16*)(ws + WS_ZS), (bf16*)(ws + WS_U), (bf16*)(ws + WS_QP), (bf16*)(ws + WS_KP), (bf16*)(ws + WS_V), (float*)(ws + WS_FL), (const float*)(ws + WS_SSQ) + (size_t)(l * 3 + 1) * M, (unsigned*)(ws + WS_CTL) + 2048 + l * 96, (const LAS float*)(lds + LDS_RSTD), 0};
            pg8::gemm_phase<EpiWin, pg8::StaticOrder, true, true>(lds, g, S, E);
        } else if (EN(5) && k == 4) {
            PHASE_ENTER();
            prep_phase(Ap, l, lds, tid, wave, lane, bid, G);
        } else if (EN(6) && k == 5) {
            PHASE_ENTER();
            pg8::Gemm g{(const bf16*)(ws + WS_QKN), (const bf16*)(wl + WL_QKV), M, NQKV, KQ}; pg8::StaticOrder S; S.init(M, NQKV, G, bid);
            EpiQKV E{(bf16*)(ws + WS_QP), (bf16*)(ws + WS_KP), (bf16*)(ws + WS_V), (const float*)(ws + WS_ROPE)};
            pg8::gemm_phase<EpiQKV, pg8::StaticOrder, true, true>(lds, g, S, E);
            if (G >= 160) { if (bid >= 128) scan_phase(Ap, l, lds, tid, wave, lane, bid - 128, G - 128); }
            else scan_phase(Ap, l, lds, tid, wave, lane, bid, G);
        } else if (EN(7) && k == 6) {
            PHASE_ENTER();
            LAS unsigned* uw = (LAS unsigned*)(lds + LDS_MISC);
            unsigned* ctl = (unsigned*)(ws + WS_CTL);
            __syncthreads();
            for (int par = 0;; par ^= 1) {
                if (tid == 0) uw[par] = atomicAdd(ctl + 64 * l, 1u);
                asm volatile("s_waitcnt lgkmcnt(0)\n\ts_barrier" ::: "memory");
                const unsigned u = uw[par];
                if (u >= 768u) break;
                const bool fox = (u >= 312u && u < 696u);
                const unsigned v = (u < 312u) ? u : (fox ? u - 312u : u - 696u);
                const int qb = (u < 696u ? 15 : 2) - (int)(v / 24u), bi = (int)(v % 24u), bb = bi / 6, hd = bi % 6 + (fox ? 6 : 0);
                int tbase = 0;
                if (hd >= 6) {
                    const float* C2 = (const float*)(ws + WS_C2) + (size_t)(bb * 6 + hd - 6) * SEQ;
                    const float* nr = (const float*)(ws + WS_CTL) + 2048 + l * 96 + (bb * 6 + hd - 6) * 4;
                    const float B2 = 2.0f * (sqrtf((nr[0] + nr[1]) * (nr[2] + nr[3])) * 1.02f + 1.0f);
                    const float cq = C2[qb * 256];
                    const bool skip = (lane < 4 * (qb + 1) - 4) && (B2 + cq - C2[64 * lane + 63] < -160.0f);
                    const unsigned long long mk = __builtin_amdgcn_ballot_w64(skip);
                    tbase = (~mk == 0ull) ? 0 : __builtin_ctzll(~mk);
                    tbase = __builtin_amdgcn_readfirstlane(tbase);
                }
                att::attn_unit(lds, (const bf16*)(ws + WS_QP), (const bf16*)(ws + WS_KP), (const bf16*)(ws + WS_V), (bf16*)(ws + WS_XN), bb, hd, qb, tbase, tid, wave, lane);
            }
        } else if (EN(8) && k == 7) {
            PHASE_ENTER();
            pg8::Gemm g{(const bf16*)(ws + WS_XN), (const bf16*)(wl + WL_OUT), M, D, KD}; pg8::StaticOrder S; S.init(M, D, G, bid);
            EpiResid E{Ap->out, Ap->out, (bf16*)(ws + WS_XB), (float*)(ws + WS_SSQ) + (size_t)(l * 3 + 2) * M, 1.0f};
            pg8::gemm_phase<EpiResid, pg8::StaticOrder, true, true>(lds, g, S, E);
        }
        if (ph + 1 < ph_hi) { if (ph_hi > 1000) grid.sync(); xcd_barrier(bar); }
#ifdef PROBE_MASK
        if ((PROBE_MASK >> k) & 1) tacc += __builtin_amdgcn_s_memrealtime() - tph0;
#endif
    }
#ifdef PROBE_MASK
    if (blockIdx.x == 0) { const unsigned long long tend = __builtin_amdgcn_s_memrealtime() + 4ull * tacc; while (__builtin_amdgcn_s_memrealtime() < tend) __builtin_amdgcn_s_sleep(32); }
#endif
}

extern "C" void kernel_launch(void* const* d_in, const int* in_sizes, int n_in, void* d_out, int out_size, void* d_ws, size_t ws_size, hipStream_t stream) {
    static int grid = 0;
    if (grid == 0) {
        if (n_in != 18 || out_size != M * D || ws_size < WS_END) { fprintf(stderr, "kernel_launch: unexpected problem (n_in %d out %d ws %zu need %zu)\n", n_in, out_size, ws_size, (size_t)WS_END); grid = -1; return; }
        int dev = 0, cus = 0, per_cu = 0;
        hipGetDevice(&dev); hipDeviceGetAttribute(&cus, hipDeviceAttributeMultiprocessorCount, dev);
        if (hipFuncSetAttribute((const void*)mk_fwd, hipFuncAttributeMaxDynamicSharedMemorySize, LDS_BYTES) != hipSuccess) { fprintf(stderr, "kernel_launch: hipFuncSetAttribute failed\n"); grid = -1; return; }
        if (hipOccupancyMaxActiveBlocksPerMultiprocessor(&per_cu, (const void*)mk_fwd, 512, LDS_BYTES) != hipSuccess || per_cu < 1) { fprintf(stderr, "kernel_launch: occupancy query says %d\n", per_cu); per_cu = 1; }
        (void)hipGetLastError();
        grid = cus * per_cu;
        fprintf(stderr, "kernel_launch: grid %d (cus %d x %d)\n", grid, cus, per_cu);
        if (grid < 192) fprintf(stderr, "kernel_launch: this build keeps per-unit row scales for at most 8 GEMM units per workgroup (needs >= 176 workgroups); grid %d is too small\n", grid);
    }
    if (grid < 0) return;
    (void)hipMemsetAsync((char*)d_ws + WS_CTL, 0, CTL_BYTES, stream);
    Args a{};
    for (int i = 0; i < 18; ++i) a.in[i] = (const float*)d_in[i];
    a.out = (float*)d_out; a.ws = (unsigned char*)d_ws;
#if MK_MULTI
    for (int ph = 0; ph < NPH; ++ph) { a.ph_lo = ph; a.ph_hi = ph + 1; hipLaunchKernelGGL(mk_fwd, dim3(grid), dim3(512), LDS_BYTES, stream, a); }
#else
    a.ph_lo = 0; a.ph_hi = NPH;
    void* args[] = {&a};
    hipError_t e = hipLaunchCooperativeKernel((const void*)mk_fwd, dim3(grid), dim3(512), args, LDS_BYTES, stream);
    if (e != hipSuccess) fprintf(stderr, "kernel_launch: cooperative launch failed: %s (grid %d)\n", hipGetErrorString(e), grid);
#endif
}
```

```cpp
#include <hip/hip_runtime.h>
#include <hip/hip_cooperative_groups.h>
#include <cstdio>
#include <cstdint>
namespace cg = cooperative_groups;
#ifndef MK_MULTI
#define MK_MULTI 0
#endif
namespace pg8 {
#define PG8_LAS __attribute__((address_space(3)))
typedef unsigned short bf16_t;
typedef short bf16x8 __attribute__((ext_vector_type(8)));
typedef float f32x4 __attribute__((ext_vector_type(4)));
typedef unsigned u32x4 __attribute__((ext_vector_type(4)));
constexpr int BM = 256, BK = 64, HALF = 128, HTB = HALF * BK * 2  , STAGE_BYTES = 8 * HTB, NXCD = 8, WGM = 8;

__host__ __device__ __forceinline__ int lds_byte(int r, int c) { const int st = (r >> 4) * 2 + (c >> 5), rr = r & 15, cc = c & 31, ob = rr * 64 + cc * 2; return st * 1024 + (ob ^ (((ob >> 9) & 1) << 5)); }
__host__ __device__ __forceinline__ void stage_rc(int b, int& R, int& C) { const int st = b / 1024, sb = b % 1024, swz = sb ^ (((sb >> 9) & 1) << 5); R = (st >> 1) * 16 + swz / 64; C = (st & 1) * 32 + (swz % 64) / 2; }
__host__ __device__ __forceinline__ int perm32(int rho) { const int n = rho >> 4, i = rho & 15; return 8 * (i >> 2) + 4 * n + (i & 3); }

struct Unit { int pm, pn; };
struct Gemm { const bf16_t* A; const bf16_t* Bt; int M, N, K; };

struct StaticOrder {
    int nM, nN, nwg, G, c;
    __host__ __device__ void init(int M, int N, int G_, int c_) { nM = M / BM; nN = N / BM; nwg = nM * nN; G = G_; c = c_; }
    __host__ __device__ bool next(int i, Unit& u) const {
        const long L = (long)i * G + c; if (L >= nwg) return false;
        int wgid = (int)L; { const int q = nwg / NXCD, r = nwg % NXCD, xcd = wgid % NXCD, off = wgid / NXCD; wgid = (xcd < r ? xcd * (q + 1) : r * (q + 1) + (xcd - r) * q) + off; }
        const int nig = WGM * nN, gid = wgid / nig, fm = gid * WGM, gsz = (nM - fm) < WGM ? (nM - fm) : WGM;
        u.pm = fm + ((wgid % nig) % gsz); u.pn = (wgid % nig) / gsz; return true;
    }
    __device__ __forceinline__ void a_ready(const Unit&) const {}
    __device__ __forceinline__ void done(const Unit&) const {}
};
typedef float f32x2 __attribute__((ext_vector_type(2)));
template <class Epi, class Sched, bool ALIGN_EPI = false, bool SP2 = false>
__device__ __forceinline__ void gemm_phase(PG8_LAS unsigned char* lds, const Gemm g, const Sched& S, const Epi& E) {
    int tid = threadIdx.x; asm volatile("" : "+v"(tid)); const int wid = __builtin_amdgcn_readfirstlane(tid >> 6), lane = tid & 63, wr = wid >> 2, wc = wid & 3, fr = lane & 15, fq = lane >> 4;
    const int K = g.K, nt = K / BK;
    unsigned voffA[2], voffB[2];
#pragma unroll
    for (int i = 0; i < 2; ++i) { int R, C; stage_rc(tid * 16 + i * 8192, R, C); const int Rb = Epi::PERM ? ((R & ~31) + perm32(R & 31)) : R;
        voffA[i] = (unsigned)(R * K + C) * 2u; voffB[i] = (unsigned)(Rb * K + C) * 2u; }
    const size_t kstep = (size_t)(BK * 2);
    const size_t hstep = (size_t)HALF * K * 2;
    const size_t tstep = 2 * hstep;
    const unsigned ldsw = (unsigned)wid * 1024u;
    const int aoff = lds_byte(wr * 64 + fr, fq * 8), boff = lds_byte(wc * 32 + fr, fq * 8);
#define PG8_SA(b, h) (((b) * 2 + (h)) * HTB)
#define PG8_SB(b, h) ((4 + (b) * 2 + (h)) * HTB)
#define PG8_STAGE(bufoff, gbase, voff) do { _Pragma("unroll") for (int _i = 0; _i < 2; ++_i) \
        __builtin_amdgcn_global_load_lds((const unsigned*)((const char*)(gbase) + (voff)[_i]), (PG8_LAS unsigned*)(lds + (bufoff) + ldsw + _i * 8192), 16, 0, 0); } while (0)
#define PG8_LDA(dst, b, h) do { _Pragma("unroll") for (int m = 0; m < 4; ++m) _Pragma("unroll") for (int k = 0; k < 2; ++k) dst[m][k] = *(const PG8_LAS bf16x8*)(lds + PG8_SA(b, h) + aoff + m * 2048 + k * 1024); } while (0)
#define PG8_LDB(dst, b, h) do { _Pragma("unroll") for (int n = 0; n < 2; ++n) _Pragma("unroll") for (int k = 0; k < 2; ++k) dst[n][k] = *(const PG8_LAS bf16x8*)(lds + PG8_SB(b, h) + boff + n * 2048 + k * 1024); } while (0)
#define PG8_MMA(ai, bj, At, Bt) do { __builtin_amdgcn_s_setprio(1); _Pragma("unroll") for (int m = 0; m < 4; ++m) _Pragma("unroll") for (int n = 0; n < 2; ++n) _Pragma("unroll") for (int k = 0; k < 2; ++k) \
        acc[ai][bj][m][n] = __builtin_amdgcn_mfma_f32_16x16x32_bf16(Bt[n][k], At[m][k], acc[ai][bj][m][n], 0, 0, 0); __builtin_amdgcn_s_setprio(0); } while (0)
#define PG8_WAIT_V(n) asm volatile("s_waitcnt vmcnt(" #n ")" ::: "memory")
#define PG8_WAIT_L(n) asm volatile("s_waitcnt lgkmcnt(" #n ")" ::: "memory")
#define PG8_BAR __builtin_amdgcn_s_barrier()
#define PG8_SCHED __builtin_amdgcn_sched_barrier(0)
    Unit cur, nxt; int ui = 0;
    if (!S.next(0, cur)) return;
    f32x4 acc[2][2][4][2];
#pragma unroll
    for (int a = 0; a < 2; ++a)
#pragma unroll
        for (int b = 0; b < 2; ++b)
#pragma unroll
            for (int m = 0; m < 4; ++m)
#pragma unroll
                for (int n = 0; n < 2; ++n) acc[a][b][m][n] = (f32x4){0.f, 0.f, 0.f, 0.f};
    bf16x8 At[4][2], B0[2][2], B1[2][2];
    const char* cA = (const char*)g.A + (size_t)cur.pm * tstep; const char* cB = (const char*)g.Bt + (size_t)cur.pn * tstep;
    S.a_ready(cur);
    if constexpr (SP2) {
        PG8_STAGE(PG8_SB(0, 0), cB, voffB); PG8_STAGE(PG8_SB(0, 1), cB + hstep, voffB); PG8_STAGE(PG8_SA(0, 0), cA, voffA); PG8_STAGE(PG8_SA(0, 1), cA + hstep, voffA);
        if (wr == 1) PG8_BAR;
        PG8_WAIT_V(2); PG8_BAR;
        PG8_STAGE(PG8_SB(1, 0), cB + kstep, voffB); PG8_STAGE(PG8_SA(1, 0), cA + kstep, voffA); PG8_STAGE(PG8_SB(1, 1), cB + hstep + kstep, voffB);
        PG8_WAIT_V(6); PG8_BAR;
    } else {
        PG8_STAGE(PG8_SB(0, 0), cB, voffB); PG8_STAGE(PG8_SA(0, 0), cA, voffA); PG8_STAGE(PG8_SB(0, 1), cB + hstep, voffB); PG8_STAGE(PG8_SA(0, 1), cA + hstep, voffA);
        if (wr == 1) PG8_BAR;
        PG8_WAIT_V(4); PG8_BAR;
        PG8_STAGE(PG8_SB(1, 0), cB + kstep, voffB); PG8_STAGE(PG8_SA(1, 0), cA + kstep, voffA); PG8_STAGE(PG8_SB(1, 1), cB + hstep + kstep, voffB);
        PG8_WAIT_V(6); PG8_BAR;
    }
    for (;;) {
        const bool has_next = S.next(ui + 1, nxt);
        const char* nA = has_next ? (const char*)g.A + (size_t)nxt.pm * tstep : cA; const char* nB = has_next ? (const char*)g.Bt + (size_t)nxt.pn * tstep : cB;
        for (int t = 0; t < nt; t += 2) {
            const bool last = (t == nt - 2);
            const char* a1 = cA + (size_t)(t + 1) * kstep;
            const char* a2 = last ? nA : cA + (size_t)(t + 2) * kstep; const char* b2 = last ? nB : cB + (size_t)(t + 2) * kstep;
            const char* a3 = a2 + kstep; const char* b3 = b2 + kstep;
            if (last && has_next) S.a_ready(nxt);
            if constexpr (SP2) {
            PG8_LDB(B0, 0, 0); PG8_LDB(B1, 0, 1); PG8_SCHED; PG8_LDA(At, 0, 0); PG8_STAGE(PG8_SA(1, 1), a1 + hstep, voffA);
            PG8_WAIT_V(8); PG8_WAIT_L(0); PG8_BAR; PG8_MMA(0, 0, At, B0); PG8_MMA(0, 1, At, B1); PG8_BAR; PG8_SCHED;
            PG8_LDA(At, 0, 1); PG8_STAGE(PG8_SB(0, 0), b2, voffB); PG8_STAGE(PG8_SB(0, 1), b2 + hstep, voffB); PG8_STAGE(PG8_SA(0, 0), a2, voffA);
            PG8_WAIT_V(8); PG8_WAIT_L(0); PG8_BAR; PG8_MMA(1, 0, At, B0); PG8_MMA(1, 1, At, B1); PG8_BAR; PG8_SCHED;
            PG8_LDB(B0, 1, 0); PG8_LDB(B1, 1, 1); PG8_SCHED; PG8_LDA(At, 1, 0); PG8_STAGE(PG8_SA(0, 1), a2 + hstep, voffA);
            PG8_WAIT_V(8); PG8_WAIT_L(0); PG8_BAR; PG8_MMA(0, 0, At, B0); PG8_MMA(0, 1, At, B1); PG8_BAR; PG8_SCHED;
            PG8_LDA(At, 1, 1); PG8_STAGE(PG8_SB(1, 0), b3, voffB); PG8_STAGE(PG8_SB(1, 1), b3 + hstep, voffB); PG8_STAGE(PG8_SA(1, 0), a3, voffA);
            PG8_WAIT_V(8); PG8_WAIT_L(0); PG8_BAR; PG8_MMA(1, 0, At, B0); PG8_MMA(1, 1, At, B1); PG8_BAR; PG8_SCHED;
            } else {
            PG8_LDB(B0, 0, 0); PG8_SCHED; PG8_LDA(At, 0, 0); PG8_STAGE(PG8_SA(1, 1), a1 + hstep, voffA);
            PG8_WAIT_L(8); PG8_BAR; PG8_WAIT_L(0); PG8_MMA(0, 0, At, B0); PG8_BAR; PG8_SCHED;
            PG8_LDB(B1, 0, 1); PG8_STAGE(PG8_SB(0, 0), b2, voffB);
            PG8_BAR; PG8_WAIT_L(0); PG8_MMA(0, 1, At, B1); PG8_BAR;
            PG8_LDA(At, 0, 1); PG8_STAGE(PG8_SA(0, 0), a2, voffA);
            PG8_BAR; PG8_WAIT_L(0); PG8_MMA(1, 0, At, B0); PG8_BAR; PG8_SCHED;
            PG8_STAGE(PG8_SB(0, 1), b2 + hstep, voffB);
            PG8_WAIT_V(6); PG8_BAR; PG8_MMA(1, 1, At, B1); PG8_BAR;
            PG8_LDB(B0, 1, 0); PG8_SCHED; PG8_LDA(At, 1, 0); PG8_STAGE(PG8_SA(0, 1), a2 + hstep, voffA);
            PG8_WAIT_L(8); PG8_BAR; PG8_WAIT_L(0); PG8_MMA(0, 0, At, B0); PG8_BAR; PG8_SCHED;
            PG8_LDB(B1, 1, 1); PG8_STAGE(PG8_SB(1, 0), b3, voffB);
            PG8_BAR; PG8_WAIT_L(0); PG8_MMA(0, 1, At, B1); PG8_BAR;
            PG8_LDA(At, 1, 1); PG8_STAGE(PG8_SA(1, 0), a3, voffA);
            PG8_BAR; PG8_WAIT_L(0); PG8_MMA(1, 0, At, B0); PG8_BAR; PG8_SCHED;
            PG8_STAGE(PG8_SB(1, 1), b3 + hstep, voffB);
            PG8_WAIT_V(6); PG8_BAR; PG8_MMA(1, 1, At, B1); PG8_BAR;
            }
        }
        if constexpr (ALIGN_EPI) { if (wr == 0) PG8_BAR; }
        if constexpr (!Epi::AFTER_DRAIN) { E(acc, cur, wr, wc, fr, fq); S.done(cur); }
        if (!has_next) break;
#pragma unroll
        for (int a = 0; a < 2; ++a)
#pragma unroll
            for (int b = 0; b < 2; ++b)
#pragma unroll
                for (int m = 0; m < 4; ++m)
#pragma unroll
                    for (int n = 0; n < 2; ++n) acc[a][b][m][n] = (f32x4){0.f, 0.f, 0.f, 0.f};
        cur = nxt; cA = nA; cB = nB; ++ui;
        if constexpr (ALIGN_EPI) { if (wr == 1) PG8_BAR; }
    }
    PG8_WAIT_V(0);
    if constexpr (!ALIGN_EPI) { if (wr == 0) PG8_BAR; }
    PG8_BAR;
    if constexpr (Epi::AFTER_DRAIN) { E.fused(acc, cur, wr, wc, fr, fq, lds, wid, lane); S.done(cur); }
#undef PG8_SA
#undef PG8_SB
#undef PG8_STAGE
#undef PG8_LDA
#undef PG8_LDB
#undef PG8_MMA
#undef PG8_WAIT_V
#undef PG8_WAIT_L
#undef PG8_BAR
#undef PG8_SCHED
}
}

constexpr int M = 16384, SEQ = 4096, NB = 4, D = 1024, F = 2816, DEPTH = 2;
constexpr int N_IN = 1830;
constexpr int NGU = 2 * F;
constexpr int NWIN = 2048;
constexpr int NQKV = 1536, KQKV = 384;
constexpr int QP = 1152, VP = 768;
constexpr float EPS = 1e-6f;
constexpr float LOG2E = 1.4426950408889634f;
constexpr float QS_MLA = 0.14724444f;
constexpr float QS_FOX = 0.18033688f;

constexpr size_t MiB = 1u << 20;
constexpr size_t WS_CTL = 0;
constexpr int CW_BAR = 4096;
constexpr size_t WS_SSQ = 65536;
constexpr size_t CTL_BYTES = 65536 + 7 * 65536;
constexpr size_t WS_ROPE = 1 * MiB;
constexpr size_t WS_C2 = 512 * 1024;
constexpr size_t WS_BND = 960 * 1024;
constexpr size_t WS_FL = 1 * MiB + 512 * 1024;
constexpr size_t WS_W = 2 * MiB;
constexpr size_t WL_GU1 = 0, WL_GU2 = 11 * MiB, WL_DN1 = 22 * MiB, WL_DN2 = 22 * MiB + 5632 * 1024, WL_IN = 33 * MiB, WL_OUT = 37 * MiB, WL_QKV = 39 * MiB;
constexpr size_t WL_STRIDE = 41 * MiB;
constexpr size_t WS_XB = 43 * MiB;
constexpr size_t WS_XN = 75 * MiB;
constexpr size_t WS_BIG = 107 * MiB;
constexpr size_t WS_ZS = WS_BIG, WS_U = WS_BIG + 16 * MiB, WS_QKN = WS_BIG + 24 * MiB, WS_QP = WS_BIG + 36 * MiB, WS_KP = WS_BIG + 72 * MiB, WS_V = WS_BIG + 108 * MiB;
constexpr size_t WS_END = WS_BIG + 132 * MiB;
static_assert(WL_QKV + (size_t)NQKV * KQKV * 2 <= WL_STRIDE && WS_W + WL_STRIDE <= WS_XB, "weights map");
static_assert(WS_QKN + (size_t)M * KQKV * 2 <= WS_QP && WS_V + (size_t)M * VP * 2 <= WS_END && WS_BIG + (size_t)M * F * 2 <= WS_END, "act map");

constexpr int LDS_BYTES = 147456;
constexpr int LDS_MISC = 131072 + 4096;

#define LAS __attribute__((address_space(3)))
typedef unsigned short bf16;
typedef float f32x4 __attribute__((ext_vector_type(4)));
typedef float f32x2 __attribute__((ext_vector_type(2)));
typedef float f32x16 __attribute__((ext_vector_type(16)));
typedef unsigned u32x4 __attribute__((ext_vector_type(4)));
typedef unsigned u32x2 __attribute__((ext_vector_type(2)));
typedef short bf16x8 __attribute__((ext_vector_type(8)));
typedef short s16x4 __attribute__((ext_vector_type(4)));
typedef __bf16 bf16x2_t __attribute__((ext_vector_type(2)));

__device__ __forceinline__ unsigned cvtpk(float lo, float hi) { f32x2 v = {lo, hi}; bf16x2_t b = __builtin_convertvector(v, bf16x2_t); return __builtin_bit_cast(unsigned, b); }
__device__ __forceinline__ unsigned f2bf(float f) { unsigned u = __builtin_bit_cast(unsigned, f); return (u + 0x7fffu + ((u >> 16) & 1u)) >> 16; }
__device__ __forceinline__ float bf2f(unsigned b) { return __builtin_bit_cast(float, b << 16); }
__device__ __forceinline__ float lane_xor(float v, int lane, int o) { return __builtin_bit_cast(float, __builtin_amdgcn_ds_bpermute((lane ^ o) << 2, __builtin_bit_cast(int, v))); }
__device__ __forceinline__ float wave_sum(float v, int lane) {
#pragma unroll
    for (int o = 1; o < 64; o <<= 1) v += lane_xor(v, lane, o);
    return v;
}
__device__ __forceinline__ void store8nt(bf16* p, f32x4 a, f32x4 b) { u32x4 w; w.x = cvtpk(a[0], a[1]); w.y = cvtpk(a[2], a[3]); w.z = cvtpk(b[0], b[1]); w.w = cvtpk(b[2], b[3]); __builtin_nontemporal_store(w, (u32x4*)p); }
__device__ __forceinline__ void store8(bf16* p, f32x4 a, f32x4 b) { u32x4 w; w.x = cvtpk(a[0], a[1]); w.y = cvtpk(a[2], a[3]); w.z = cvtpk(b[0], b[1]); w.w = cvtpk(b[2], b[3]); *(u32x4*)p = w; }

struct EpiSwiglu {
    static constexpr bool PERM = true, AFTER_DRAIN = false;
    bf16* O; const float* ssq; const LAS float* tbl; mutable int ucount;
    __device__ __forceinline__ void operator()(const pg8::f32x4 (&acc)[2][2][4][2], const pg8::Unit& u, int wr, int wc, int fr, int fq) const {
        asm volatile("" : "+v"(fr), "+v"(fq));
        const int row0 = u.pm * 256 + wr * 64 + fr, col0 = u.pn * 128 + wc * 32 + 8 * fq;
#pragma unroll
        for (int ai = 0; ai < 2; ++ai)
#pragma unroll
            for (int m = 0; m < 4; ++m) {
                bf16* rowp = O + (size_t)(row0 + ai * 128 + m * 16) * F + col0;
                const float rs = tbl[(ucount & 7) * 256 + wr * 64 + fr + ai * 128 + m * 16], nrs = -rs * LOG2E;
                f32x4 r[2];
#pragma unroll
                for (int n = 0; n < 2; ++n) {
                    const f32x4 g = acc[ai][0][m][n], uu = acc[ai][1][m][n];
#pragma unroll
                    for (int j = 0; j < 4; ++j) { const float e = __builtin_amdgcn_exp2f(g[j] * nrs); r[n][j] = (g[j] * rs) * __builtin_amdgcn_rcpf(1.0f + e) * (uu[j] * rs); }
                }
                store8nt(rowp, r[0], r[1]);
            }
        ++ucount;
    }
};
struct EpiResid {
    static constexpr bool PERM = true, AFTER_DRAIN = false;
    const float* base; float* out; bf16* xb; float* ssq; float scale;
    __device__ __forceinline__ void operator()(const pg8::f32x4 (&acc)[2][2][4][2], const pg8::Unit& u, int wr, int wc, int fr, int fq) const {
        asm volatile("" : "+v"(fr), "+v"(fq));
        const int row0 = u.pm * 256 + wr * 64 + fr, col0 = u.pn * 256 + wc * 32 + 8 * fq;
#pragma unroll
        for (int ai = 0; ai < 2; ++ai)
#pragma unroll
            for (int m = 0; m < 4; ++m) {
                const size_t off = (size_t)(row0 + ai * 128 + m * 16) * D + col0;
                float sq = 0.f;
#pragma unroll
                for (int bj = 0; bj < 2; ++bj) {
                    const size_t p = off + bj * 128;
                    const f32x4 b0 = __builtin_nontemporal_load((const f32x4*)(base + p)), b1 = __builtin_nontemporal_load((const f32x4*)(base + p + 4));
                    const f32x4 o0 = b0 + acc[ai][bj][m][0] * scale, o1 = b1 + acc[ai][bj][m][1] * scale;
                    __builtin_nontemporal_store(o0, (f32x4*)(out + p)); __builtin_nontemporal_store(o1, (f32x4*)(out + p + 4));
                    store8(xb + p, o0, o1);
                    sq += ((o0[0] * o0[0] + o0[1] * o0[1]) + (o0[2] * o0[2] + o0[3] * o0[3])) + ((o1[0] * o1[0] + o1[1] * o1[1]) + (o1[2] * o1[2] + o1[3] * o1[3]));
                }
                { const int ln = fq * 16 + fr; sq += lane_xor(sq, ln, 16); sq += lane_xor(sq, ln, 32); if (fq == 0) atomicAdd(ssq + row0 + ai * 128 + m * 16, sq); }
                asm volatile("" ::: "memory");
            }
    }
};
struct EpiWin {
    static constexpr bool PERM = true, AFTER_DRAIN = false;
    bf16 *Zs, *U, *Qp, *Kp, *V; float* Fl; const float* ssq; unsigned* nrm; const LAS float* tbl; mutable int ucount;
    __device__ __forceinline__ void operator()(const pg8::f32x4 (&acc)[2][2][4][2], const pg8::Unit& u, int wr, int wc, int fr, int fq) const {
        asm volatile("" : "+v"(fr), "+v"(fq));
        const int row0 = u.pm * 256 + wr * 64 + fr;
#pragma unroll
        for (int bj = 0; bj < 2; ++bj) {
            const int c0 = u.pn * 256 + bj * 128 + wc * 32 + 8 * fq;
            bf16* dst; int pitch; float sc = 1.0f; bool f32too = false; int nslot = -1;
            if (c0 < 512) { dst = Zs + c0; pitch = 512; f32too = (c0 == 416); }
            else if (c0 < 768) { dst = U + (c0 - 512); pitch = 256; }
            else if (c0 < 1920) {
                const int e = c0 - 768, seg = e / 384, w = e - seg * 384, hh = w >> 6, d = w & 63;
                if (seg == 0) { dst = Qp + (6 + hh) * 96 + d; pitch = QP; sc = QS_FOX; nslot = hh * 4 + (d >> 5); }
                else if (seg == 1) { dst = Kp + (6 + hh) * 96 + d; pitch = QP; nslot = hh * 4 + 2 + (d >> 5); }
                else { dst = V + (6 + hh) * 64 + d; pitch = VP; }
            } else continue;
            float nmax = 0.f;
#pragma unroll
            for (int ai = 0; ai < 2; ++ai)
#pragma unroll
                for (int m = 0; m < 4; ++m) {
                    const int row = row0 + ai * 128 + m * 16;
                    const float rs = tbl[(ucount & 7) * 256 + wr * 64 + fr + ai * 128 + m * 16], scr = sc * rs;
                    const f32x4 v0 = acc[ai][bj][m][0] * scr, v1 = acc[ai][bj][m][1] * scr;
                    store8(dst + (size_t)row * pitch, v0, v1);
                    if (nslot >= 0) { float s2 = ((v0[0] * v0[0] + v0[1] * v0[1]) + (v0[2] * v0[2] + v0[3] * v0[3])) + ((v1[0] * v1[0] + v1[1] * v1[1]) + (v1[2] * v1[2] + v1[3] * v1[3]));
                        const int ln = fq * 16 + fr; s2 += lane_xor(s2, ln, 16); s2 += lane_xor(s2, ln, 32); nmax = fmaxf(nmax, s2); }
                    if (f32too) { *(f32x4*)(Fl + (size_t)row * 8) = acc[ai][bj][m][0] * rs; *(f32x4*)(Fl + (size_t)row * 8 + 4) = acc[ai][bj][m][1] * rs; }
                }
            if (nslot >= 0) { const int ln = fq * 16 + fr;
#pragma unroll
                for (int o = 1; o < 16; o <<= 1) nmax = fmaxf(nmax, lane_xor(nmax, ln, o));
                if (fr == 0 && fq == 0) atomicMax(nrm + ((u.pm >> 4) * 6) * 4 + nslot, __builtin_bit_cast(unsigned, nmax)); }
        }
        ++ucount;
    }
};
struct EpiQKV {
    static constexpr bool PERM = true, AFTER_DRAIN = false;
    bf16 *Qp, *Kp, *V; const float* rope;
    __device__ __forceinline__ void operator()(const pg8::f32x4 (&acc)[2][2][4][2], const pg8::Unit& u, int wr, int wc, int fr, int fq) const {
        asm volatile("" : "+v"(fr), "+v"(fq));
        const int row0 = u.pm * 256 + wr * 64 + fr;
#pragma unroll
        for (int bj = 0; bj < 2; ++bj) {
            const int c0 = u.pn * 256 + bj * 128 + wc * 32 + 8 * fq;
            if (c0 < 576) {
                const int head = c0 / 96, d = c0 - head * 96;
                bf16* dst = Qp + head * 96 + d;
                if (d < 64) {
#pragma unroll
                    for (int ai = 0; ai < 2; ++ai)
#pragma unroll
                        for (int m = 0; m < 4; ++m) { const int row = row0 + ai * 128 + m * 16; store8(dst + (size_t)row * QP, acc[ai][bj][m][0] * QS_MLA, acc[ai][bj][m][1] * QS_MLA); }
                } else {
                    const int a = (d - 64) >> 3;
                    f32x4 t0[2][4], t1[2][4];
#pragma unroll
                    for (int ai = 0; ai < 2; ++ai)
#pragma unroll
                        for (int m = 0; m < 4; ++m) { const int pos = (row0 + ai * 128 + m * 16) & (SEQ - 1);
                            t0[ai][m] = *(const f32x4*)(rope + (size_t)(pos * 16 + 4 * a) * 2); t1[ai][m] = *(const f32x4*)(rope + (size_t)(pos * 16 + 4 * a) * 2 + 4); }
                    asm volatile("" ::: "memory");
#pragma unroll
                    for (int ai = 0; ai < 2; ++ai)
#pragma unroll
                        for (int m = 0; m < 4; ++m) {
                            const int row = row0 + ai * 128 + m * 16;
                            const f32x4 x = acc[ai][bj][m][0], y = acc[ai][bj][m][1], c0v = t0[ai][m], c1v = t1[ai][m];
                            f32x4 ox, oy;
                            ox[0] = x[0] * c0v[0] - x[1] * c0v[1]; ox[1] = x[1] * c0v[0] + x[0] * c0v[1]; ox[2] = x[2] * c0v[2] - x[3] * c0v[3]; ox[3] = x[3] * c0v[2] + x[2] * c0v[3];
                            oy[0] = y[0] * c1v[0] - y[1] * c1v[1]; oy[1] = y[1] * c1v[0] + y[0] * c1v[1]; oy[2] = y[2] * c1v[2] - y[3] * c1v[3]; oy[3] = y[3] * c1v[2] + y[2] * c1v[3];
                            store8(dst + (size_t)row * QP, ox * QS_MLA, oy * QS_MLA);
                        }
                }
            } else if (c0 < 1344) {
                const int e = c0 - 576, head = e >> 7, d = e & 127;
                bf16* dst; int pitch;
                if (d < 64) { dst = Kp + head * 96 + d; pitch = QP; } else { dst = V + head * 64 + (d - 64); pitch = VP; }
#pragma unroll
                for (int ai = 0; ai < 2; ++ai)
#pragma unroll
                    for (int m = 0; m < 4; ++m) { const int row = row0 + ai * 128 + m * 16; store8(dst + (size_t)row * pitch, acc[ai][bj][m][0], acc[ai][bj][m][1]); }
            }
        }
    }
};

struct Args {
    const float* in[18];
    float* out; unsigned char* ws;
    int ph_lo, ph_hi;
};
typedef const __attribute__((address_space(4))) Args* CArgsP;
enum { I_X = 0, I_F1N, I_F1GU, I_F1DN, I_MIXN, I_WIN, I_QAN, I_WQB, I_KVAN, I_WKVB, I_POOLW, I_POOLS, I_FOXB, I_WOUT, I_F2N, I_F2GU, I_F2DN, I_FINN };

struct ConvDesc { const float* wp; const float* gain; bf16* wt; int Nsrc, Ksrc, koff, Kdst, k0; bool okc; };
__device__ __forceinline__ void conv_set(ConvDesc& d, const float* W, int Nsrc, int Ksrc, int sc, int koff, bf16* WT, int Kdst, int k0, int n0, int lane, const float* gain) {
    d.okc = sc >= 0; d.Nsrc = Nsrc; d.Ksrc = Ksrc; d.koff = koff; d.Kdst = Kdst; d.k0 = k0;
    d.wp = W + (size_t)(k0 - koff + (lane >> 5)) * Nsrc + (d.okc ? sc : 0);
    d.wt = WT + (size_t)n0 * Kdst + k0; d.gain = gain ? gain + k0 : nullptr;
}
__device__ __forceinline__ void conv_load(const ConvDesc& d, float (&v)[32], int lane) {
#pragma unroll
    for (int i = 0; i < 32; ++i) {
        const int ks = d.k0 + 2 * i + (lane >> 5) - d.koff;
        const bool ok = d.okc && ks >= 0 && ks < d.Ksrc;
        v[i] = ok ? __builtin_nontemporal_load(d.wp + (size_t)(2 * i) * d.Nsrc) : 0.f;
    }
}
__device__ __forceinline__ void conv_store(const ConvDesc& d, const float (&v)[32], LAS float* scr, int lane) {
    const int c = lane & 7;
    f32x4 g0 = {1.f, 1.f, 1.f, 1.f}, g1 = {1.f, 1.f, 1.f, 1.f};
    if (d.gain) { g0 = *(const f32x4*)(d.gain + 8 * c); g1 = *(const f32x4*)(d.gain + 8 * c + 4); }
#pragma unroll
    for (int i = 0; i < 32; ++i) scr[(2 * i + (lane >> 5)) * 33 + (lane & 31)] = v[i];
    asm volatile("s_waitcnt lgkmcnt(0)" ::: "memory");
#pragma unroll
    for (int j = 0; j < 4; ++j) {
        const int n = (lane >> 3) + 8 * j; const LAS float* s = scr + (8 * c) * 33 + n;
        u32x4 o; o.x = cvtpk(s[0 * 33] * g0[0], s[1 * 33] * g0[1]); o.y = cvtpk(s[2 * 33] * g0[2], s[3 * 33] * g0[3]); o.z = cvtpk(s[4 * 33] * g1[0], s[5 * 33] * g1[1]); o.w = cvtpk(s[6 * 33] * g1[2], s[7 * 33] * g1[3]);
        *(u32x4*)(d.wt + (size_t)n * d.Kdst + 8 * c) = o;
    }
    asm volatile("s_waitcnt lgkmcnt(0)" ::: "memory");
}
constexpr int IT_GU = 16 * (NGU / 32), IT_DN = (F / 64) * (D / 32), IT_IN = 16 * (NWIN / 32), IT_QKV = (KQKV / 64) * (NQKV / 32), IT_OUT = 16 * (D / 32);
constexpr int IT_LAYER = 2 * IT_GU + 2 * IT_DN + IT_IN + IT_QKV + IT_OUT;
__device__ __forceinline__ void conv_decode(ConvDesc& d, CArgsP Ap, int l, unsigned char* wl, int it, int lane) {
    int r = it; const int nl = lane & 31;
    if (r < 2 * IT_GU) {
        const int f = r / IT_GU; r -= f * IT_GU;
        const float* W = Ap->in[f ? I_F2GU : I_F1GU] + (size_t)l * D * NGU;
        const int nblk = NGU / 32, kb = r / nblk, nb = r - kb * nblk, n = nb * 32 + nl, tile = n >> 8, w = n & 255;
        const int sc = (w < 128) ? tile * 128 + w : F + tile * 128 + (w - 128);
        conv_set(d, W, NGU, D, sc, 0, (bf16*)(wl + (f ? WL_GU2 : WL_GU1)), D, kb * 64, nb * 32, lane, Ap->in[f ? I_F2N : I_F1N] + l * D);
        return;
    }
    r -= 2 * IT_GU;
    if (r < 2 * IT_DN) {
        const int f = r / IT_DN; r -= f * IT_DN;
        const float* W = Ap->in[f ? I_F2DN : I_F1DN] + (size_t)l * F * D;
        const int nblk = D / 32, kb = r / nblk, nb = r - kb * nblk;
        conv_set(d, W, D, F, nb * 32 + nl, 0, (bf16*)(wl + (f ? WL_DN2 : WL_DN1)), F, kb * 64, nb * 32, lane, nullptr);
        return;
    }
    r -= 2 * IT_DN;
    if (r < IT_IN) {
        const float* W = Ap->in[I_WIN] + (size_t)l * D * N_IN;
        const int nblk = NWIN / 32, kb = r / nblk, nb = r - kb * nblk, n = nb * 32 + nl;
        int sc = -1;
        if (n < 416) sc = n; else if (n < 422) sc = 1824 + (n - 416); else if (n < 512) sc = -1; else if (n < 768) sc = 416 + (n - 512); else if (n < 1920) sc = 672 + (n - 768);
        conv_set(d, W, N_IN, D, sc, 0, (bf16*)(wl + WL_IN), D, kb * 64, nb * 32, lane, Ap->in[I_MIXN] + l * D);
        return;
    }
    r -= IT_IN;
    if (r < IT_QKV) {
        const int nblk = NQKV / 32, kb = r / nblk, nb = r - kb * nblk, n = nb * 32 + nl;
        if (n < 576) {
            const int head = n / 96, dd = n - head * 96; int sd = dd;
            if (dd >= 64) { const int j2 = dd - 64; sd = 64 + (j2 >> 1) + 16 * (j2 & 1); }
            conv_set(d, Ap->in[I_WQB] + (size_t)l * 256 * 576, 576, 256, head * 96 + sd, 0, (bf16*)(wl + WL_QKV), KQKV, kb * 64, nb * 32, lane, nullptr);
        } else {
            const int sc = (n < 1344) ? n - 576 : -1;
            conv_set(d, Ap->in[I_WKVB] + (size_t)l * 128 * 768, 768, 128, sc, 256, (bf16*)(wl + WL_QKV), KQKV, kb * 64, nb * 32, lane, nullptr);
        }
        return;
    }
    r -= IT_QKV;
    {
        const float* W = Ap->in[I_WOUT] + (size_t)l * D * D;
        const int nblk = D / 32, kb = r / nblk, nb = r - kb * nblk;
        conv_set(d, W, D, D, nb * 32 + nl, 0, (bf16*)(wl + WL_OUT), D, kb * 64, nb * 32, lane, nullptr);
    }
}

constexpr int IT_P0 = 2 * IT_GU, IT_P1 = IT_LAYER - IT_P0 - IT_DN, IT_P3 = IT_DN;
__device__ __forceinline__ int conv_remap(int pass, int x) {
    if (pass == 2 || pass == 0) return x;
    if (pass == 3) return 2 * IT_GU + IT_DN + x;
    return (x < IT_DN) ? 2 * IT_GU + x : 2 * IT_GU + IT_DN + x;
}
__device__ __forceinline__ void convert_items(CArgsP Ap, int l, LAS unsigned char* lds, int pass, int gw, int NGW, int wave, int lane) {
    LAS float* scr = (LAS float*)(lds + wave * 16384);
    unsigned char* wl = Ap->ws + WS_W;
    const int NIT = (pass == 2) ? IT_LAYER : (pass == 0 ? IT_P0 : (pass == 1 ? IT_P1 : IT_P3));
    ConvDesc dA, dB; float va[32], vb[32];
    int it = gw;
    if (it < NIT) { conv_decode(dA, Ap, l, wl, conv_remap(pass, it), lane); conv_load(dA, va, lane); }
    while (it < NIT) {
        const int it2 = it + NGW; const bool has2 = it2 < NIT;
        if (has2) { conv_decode(dB, Ap, l, wl, conv_remap(pass, it2), lane); conv_load(dB, vb, lane); }
        conv_store(dA, va, scr, lane);
        if (!has2) break;
        const int it3 = it2 + NGW; const bool has3 = it3 < NIT;
        if (has3) { conv_decode(dA, Ap, l, wl, conv_remap(pass, it3), lane); conv_load(dA, va, lane); }
        conv_store(dB, vb, scr, lane);
        if (!has3) break;
        it = it3;
    }
}
__device__ __forceinline__ void prologue(CArgsP Ap, int l, LAS unsigned char* lds, int gw, int NGW, int wave, int lane) {
    unsigned char* ws = Ap->ws;
    convert_items(Ap, l, lds, (NGW == 2048) ? 0 : 2, gw, NGW, wave, lane);
    if (l != 0) return;
    {
        const float* x = Ap->in[I_X]; bf16* xb = (bf16*)(ws + WS_XB); float* ssq = (float*)(ws + WS_SSQ);
        f32x4 cur[4], nxtv[4];
        if (gw < M) { const f32x4* xr = (const f32x4*)(x + (size_t)gw * D) + lane;
#pragma unroll
            for (int j = 0; j < 4; ++j) cur[j] = __builtin_nontemporal_load(xr + 64 * j); }
        for (int row = gw; row < M; row += NGW) {
            const int rn = row + NGW;
            if (rn < M) { const f32x4* xr = (const f32x4*)(x + (size_t)rn * D) + lane;
#pragma unroll
                for (int j = 0; j < 4; ++j) nxtv[j] = __builtin_nontemporal_load(xr + 64 * j); }
            u32x2* o = (u32x2*)(xb + (size_t)row * D) + lane; float s = 0.f;
#pragma unroll
            for (int j = 0; j < 4; ++j) { const f32x4 v = cur[j]; s += (v[0] * v[0] + v[1] * v[1]) + (v[2] * v[2] + v[3] * v[3]); o[64 * j] = (u32x2){cvtpk(v[0], v[1]), cvtpk(v[2], v[3])}; }
            s = wave_sum(s, lane);
            if (lane == 0) ssq[row] = s;
#pragma unroll
            for (int j = 0; j < 4; ++j) cur[j] = nxtv[j];
        }
    }
    float* T = (float*)(ws + WS_ROPE);
    for (int e = gw * 64 + lane; e < SEQ * 16; e += NGW * 64) {
        const int pos = e >> 4, j = e & 15;
        const float inv = exp2f(-(float)j * 0.8304820237218405f);
        const float ang = (float)pos * inv;
        const double a = (double)ang, k = __builtin_rint(a * 0.15915494309189535), x = a - k * 6.283185307179586, x2 = x * x;
        double s = x, c = 1.0, ts = x, tc = 1.0;
#pragma unroll 1
        for (int i = 1; i <= 12; ++i) {
            tc = -tc * x2 / (double)((2 * i - 1) * (2 * i)); c += tc;
            ts = -ts * x2 / (double)((2 * i) * (2 * i + 1)); s += ts;
        }
        *(f32x2*)(T + (size_t)e * 2) = (f32x2){(float)c, (float)s};
    }
}

__device__ __forceinline__ void norm_phase(const float* x, const float* g, bf16* xn, float* fout, int gw, int NGW, int lane) {
    f32x4 gv[4];
#pragma unroll
    for (int j = 0; j < 4; ++j) gv[j] = *((const f32x4*)g + lane + 64 * j);
    for (int row = gw; row < M; row += NGW) {
        const f32x4* xr = (const f32x4*)(x + (size_t)row * D) + lane;
        f32x4 v[4]; float s = 0.f;
#pragma unroll
        for (int j = 0; j < 4; ++j) { v[j] = xr[64 * j]; s += (v[j][0] * v[j][0] + v[j][1] * v[j][1]) + (v[j][2] * v[j][2] + v[j][3] * v[j][3]); }
        const float rstd = 1.0f / sqrtf(wave_sum(s, lane) * (1.0f / D) + EPS);
        if (fout) {
            f32x4* o = (f32x4*)(fout + (size_t)row * D) + lane;
#pragma unroll
            for (int j = 0; j < 4; ++j) o[64 * j] = (v[j] * rstd) * gv[j];
        } else {
            u32x2* o = (u32x2*)(xn + (size_t)row * D) + lane;
#pragma unroll
            for (int j = 0; j < 4; ++j) { const f32x4 y = (v[j] * rstd) * gv[j]; o[64 * j] = (u32x2){cvtpk(y[0], y[1]), cvtpk(y[2], y[3])}; }
        }
    }
}

__device__ __forceinline__ void prep_phase(CArgsP Ap, int l, LAS unsigned char* lds, int tid, int wave, int lane, int bid, int G) {
    unsigned char* ws = Ap->ws;
    const bf16* Zs = (const bf16*)(ws + WS_ZS); const bf16* U = (const bf16*)(ws + WS_U);
    bf16* QKn = (bf16*)(ws + WS_QKN); bf16* Qp = (bf16*)(ws + WS_QP); bf16* Kp = (bf16*)(ws + WS_KP); bf16* Y = (bf16*)(ws + WS_XN);
    const float* T = (const float*)(ws + WS_ROPE); const float* Fl = (const float*)(ws + WS_FL);
    const float* qg = Ap->in[I_QAN] + l * 256; const float* kg = Ap->in[I_KVAN] + l * 128;
    const float* pw = Ap->in[I_POOLW] + (size_t)l * 4 * 4096; const float* ps = Ap->in[I_POOLS] + l * 256;
    const float* fb = Ap->in[I_FOXB] + l * 6;
    LAS unsigned char* Uw = lds;
    LAS unsigned char* Wt = lds + 40960;
    LAS unsigned char* Pb = lds + 40960 + 36864;
    LAS double* Sd = (LAS double*)(lds + 114688);
    for (int idx = tid; idx < 4096; idx += 512) {
        const int g = idx >> 10, c = (idx >> 4) & 63, d4 = (idx & 15) * 4;
        const f32x4 w = *(const f32x4*)(pw + g * 4096 + c * 64 + d4);
#pragma unroll
        for (int i = 0; i < 4; ++i) *(LAS unsigned short*)(Wt + ((g * 64 + d4 + i) * 72 + c) * 2) = (unsigned short)f2bf(w[i]);
    }
    for (int tile = bid; tile < M / 64; tile += G) {
        const int r0 = tile * 64, tloc0 = r0 & (SEQ - 1);
        __syncthreads();
        for (int idx = tid; idx < 79 * 32; idx += 512) {
            const int i = idx >> 5, c8 = (idx & 31) * 8; u32x4 v = {0u, 0u, 0u, 0u};
            if (tloc0 - 15 + i >= 0) v = *(const u32x4*)(U + (size_t)(r0 - 15 + i) * 256 + c8);
            *(LAS u32x4*)(Uw + i * 512 + c8 * 2) = v;
        }
        {
            u32x2 qa[8]; unsigned ka[8]; unsigned short r1[8], r2[8];
#pragma unroll
            for (int i = 0; i < 8; ++i) {
                const bf16* z = Zs + (size_t)(r0 + wave * 8 + i) * 512;
                qa[i] = *(const u32x2*)(z + 4 * lane); ka[i] = *(const unsigned*)(z + 256 + 2 * lane);
                r1[i] = z[384 + (lane & 15)]; r2[i] = z[400 + (lane & 15)];
            }
            const f32x4 g4 = *(const f32x4*)(qg + 4 * lane); const f32x2 g2 = *(const f32x2*)(kg + 2 * lane);
#pragma unroll
            for (int i = 0; i < 8; ++i) {
                const int row = r0 + wave * 8 + i, pos = row & (SEQ - 1);
                const float q0 = bf2f(qa[i].x & 0xffffu), q1 = bf2f(qa[i].x >> 16), q2 = bf2f(qa[i].y & 0xffffu), q3 = bf2f(qa[i].y >> 16);
                const float k0 = bf2f(ka[i] & 0xffffu), k1 = bf2f(ka[i] >> 16);
                const float sq = wave_sum((q0 * q0 + q1 * q1) + (q2 * q2 + q3 * q3), lane), sk = wave_sum(k0 * k0 + k1 * k1, lane);
                const float rq = 1.0f / sqrtf(sq * (1.0f / 256.0f) + EPS), rk = 1.0f / sqrtf(sk * (1.0f / 128.0f) + EPS);
                bf16* o = QKn + (size_t)row * KQKV;
                *(u32x2*)(o + 4 * lane) = (u32x2){cvtpk(q0 * rq * g4[0], q1 * rq * g4[1]), cvtpk(q2 * rq * g4[2], q3 * rq * g4[3])};
                *(unsigned*)(o + 256 + 2 * lane) = cvtpk(k0 * rk * g2[0], k1 * rk * g2[1]);
                if (lane < 16) {
                    const float x1 = bf2f(r1[i]), x2 = bf2f(r2[i]);
                    const f32x2 cs = *(const f32x2*)(T + (size_t)(pos * 16 + lane) * 2);
                    const unsigned pk = cvtpk(x1 * cs[0] - x2 * cs[1], x2 * cs[0] + x1 * cs[1]);
                    bf16* kp = Kp + (size_t)row * QP + 64 + 2 * lane;
#pragma unroll
                    for (int hh = 0; hh < 6; ++hh) *(unsigned*)(kp + hh * 96) = pk;
                }
            }
        }
        asm volatile("s_waitcnt lgkmcnt(0)\n\ts_barrier" ::: "memory");
        {
            const int g = wave >> 1, sub = (wave & 1) * 64 + lane;
#define WSUM(W) do { _Pragma("unroll 4") for (int it_ = 0; it_ < 16; ++it_) { const int id_ = sub + 128 * it_, tt = id_ >> 5, cp = g * 32 + (id_ & 31); \
                unsigned v_[W]; _Pragma("unroll") for (int i = 0; i < W; ++i) v_[i] = *(const LAS unsigned*)(Uw + (15 + tt - i) * 512 + cp * 4); \
                float s0 = 0.f, s1 = 0.f; _Pragma("unroll") for (int i = 0; i < W; ++i) { s0 += bf2f(v_[i] & 0xffffu); s1 += bf2f(v_[i] >> 16); } \
                const float inv = 1.0f / (float)min(tloc0 + tt + 1, W); \
                *(LAS unsigned*)(Pb + tt * 528 + cp * 4) = cvtpk(s0 * inv - bf2f(v_[0] & 0xffffu), s1 * inv - bf2f(v_[0] >> 16)); } } while (0)
            if (g == 0) WSUM(2); else if (g == 1) WSUM(4); else if (g == 2) WSUM(8); else WSUM(16);
#undef WSUM
        }
        asm volatile("s_waitcnt lgkmcnt(0)\n\ts_barrier" ::: "memory");
        {
            const int g = wave >> 1, tb = wave & 1, r = lane & 31, h = lane >> 5;
#pragma unroll
            for (int db = 0; db < 2; ++db) {
                f32x16 acc;
#pragma unroll
                for (int i = 0; i < 16; ++i) acc[i] = 0.f;
#pragma unroll
                for (int ks = 0; ks < 4; ++ks) {
                    const bf16x8 a = *(const LAS bf16x8*)(Wt + ((g * 64 + 32 * db + r) * 72 + 16 * ks + 8 * h) * 2);
                    const bf16x8 b = *(const LAS bf16x8*)(Pb + (32 * tb + r) * 528 + (g * 64 + 16 * ks + 8 * h) * 2);
                    acc = __builtin_amdgcn_mfma_f32_32x32x16_bf16(a, b, acc, 0, 0, 0);
                }
                bf16* yp = Y + (size_t)(r0 + 32 * tb + r) * D + 384 + g * 64 + 32 * db + 4 * h;
                const float* sp = ps + g * 64 + 32 * db + 4 * h;
#pragma unroll
                for (int q = 0; q < 4; ++q) {
                    const f32x4 s4 = *(const f32x4*)(sp + 8 * q);
                    *(u32x2*)(yp + 8 * q) = (u32x2){cvtpk(acc[4 * q] * s4[0], acc[4 * q + 1] * s4[1]), cvtpk(acc[4 * q + 2] * s4[2], acc[4 * q + 3] * s4[3])};
                }
            }
        }
    }
    __syncthreads();
}

__device__ __forceinline__ void scan_phase(CArgsP Ap, int l, LAS unsigned char* lds, int tid, int wave, int lane, int sbid, int SG) {
    unsigned char* ws = Ap->ws;
    bf16* Qp = (bf16*)(ws + WS_QP); bf16* Kp = (bf16*)(ws + WS_KP);
    const float* Fl = (const float*)(ws + WS_FL); const float* fb = Ap->in[I_FOXB] + l * 6;
    LAS double* Sd = (LAS double*)(lds + 114688);
    const int bid = sbid, G = SG;
    for (int sb = bid; sb < NB * 6 * 4; sb += G) {
        const int s = sb >> 2, quarter = sb & 3;
        const int b = s / 6, h = s - b * 6;
        const float bias = fb[h];
        double pre[8]; double run = 0.0;
#pragma unroll
        for (int j = 0; j < 8; ++j) {
            const float x = Fl[(size_t)(b * SEQ + tid * 8 + j) * 8 + h] + bias;
            const float ls = fminf(x, 0.f) - log1pf(expf(-fabsf(x)));
            run += (double)ls; pre[j] = run;
        }
        double inc = run;
#pragma unroll
        for (int o = 1; o < 64; o <<= 1) { const long long iv = __builtin_bit_cast(long long, inc); const int src = ((lane - o) & 63) << 2; const unsigned lo = (unsigned)__builtin_amdgcn_ds_bpermute(src, (int)(unsigned)iv), hi = (unsigned)__builtin_amdgcn_ds_bpermute(src, (int)(unsigned)(iv >> 32)); const double t = __builtin_bit_cast(double, ((unsigned long long)hi << 32) | lo); if (lane >= o) inc += t; }
        __syncthreads();
        if (lane == 63) Sd[wave] = inc;
        __syncthreads();
        double off = inc - run;
        for (int w2 = 0; w2 < wave; ++w2) off += Sd[w2];
        float* C2 = (float*)(ws + WS_C2) + (size_t)s * SEQ;
        if ((tid >> 7) == quarter)
#pragma unroll
        for (int j = 0; j < 8; ++j) {
            const double C = (off + pre[j]) * 1.4426950408889634;
            C2[tid * 8 + j] = (float)C;
            const unsigned c1 = f2bf((float)C); const double r1 = C - (double)bf2f(c1);
            const unsigned c2 = f2bf((float)r1); const double r2 = r1 - (double)bf2f(c2);
            const unsigned c3 = f2bf((float)r2);
            const size_t row = (size_t)b * SEQ + tid * 8 + j;
            u32x4* q = (u32x4*)(Qp + row * QP + (6 + h) * 96 + 64); u32x4* k = (u32x4*)(Kp + row * QP + (6 + h) * 96 + 64);
            const u32x4 z4 = {0u, 0u, 0u, 0u};
            q[0] = (u32x4){c1 | (c2 << 16), c3 | (0x3F80u << 16), 0x3F803F80u, 0u}; q[1] = z4; q[2] = z4; q[3] = z4;
            k[0] = (u32x4){0x3F803F80u, 0x3F80u | ((c1 ^ 0x8000u) << 16), (c2 ^ 0x8000u) | ((c3 ^ 0x8000u) << 16), 0u}; k[1] = z4; k[2] = z4; k[3] = z4;
        }
        __syncthreads();
    }
}

namespace att {
constexpr int KSTR = 208, KBUF = 64 * KSTR, VBUF = 8192, VB0 = 2 * KBUF;
__device__ __forceinline__ int crow(int i, int h) { return (i & 3) + 8 * (i >> 2) + 4 * h; }
typedef short v4i16_t __attribute__((ext_vector_type(4)));
__device__ __forceinline__ s16x4 vtr(const LAS unsigned char* p) { return __builtin_bit_cast(s16x4, __builtin_amdgcn_ds_read_tr16_b64_v4i16((LAS v4i16_t*)p)); }
#define MFMA32(a, b, c) __builtin_amdgcn_mfma_f32_32x32x16_bf16((a), (b), (c), 0, 0, 0)

__device__ __forceinline__ void glds16(const void* gsrc, unsigned lds_dst) { unsigned keep;
    asm volatile("s_mov_b32 %0, m0\n\ts_mov_b32 m0, %2\n\ts_nop 0\n\tglobal_load_lds_dwordx4 %1, off\n\ts_mov_b32 m0, %0" : "=&s"(keep) : "v"(gsrc), "s"(lds_dst) : "memory"); }
constexpr int NSLOT = 4, SLOT = 20480, VOFF = 12288;

__device__ __forceinline__ void attn_unit(LAS unsigned char* lds, const bf16* Qp, const bf16* Kp, const bf16* V, bf16* Y, int b, int head, int qb, int tbase, int tid, int w, int lane) {
    const int r = lane & 31, h = lane >> 5;
    const size_t rowbase = (size_t)b * SEQ; const int q0 = qb * 256;
    const bf16* qptr = Qp + (rowbase + q0 + 32 * w + r) * QP + head * 96 + 8 * h;
    bf16x8 qf[6];
#pragma unroll
    for (int s = 0; s < 6; ++s) qf[s] = *(const bf16x8*)(qptr + 16 * s);
    f32x16 o0, o1, s0, s1;
#pragma unroll
    for (int i = 0; i < 16; ++i) { o0[i] = 0.f; o1[i] = 0.f; s0[i] = 0.f; s1[i] = 0.f; }
    float mref = 0.f, lrun = 0.f;
    f32x16 negm;
#pragma unroll
    for (int i = 0; i < 16; ++i) negm[i] = 0.f;
    const int NT = 4 * (qb + 1) - tbase;
    const size_t rowk = rowbase + (size_t)tbase * 64;
    const bool low = w < 4;
    const unsigned lbase = (unsigned)(uintptr_t)lds;
    const bf16* gA = Kp + (rowk + lane) * QP + head * 96 + w * 8; const unsigned lA = w * 1024;
    const bf16* gB; unsigned lB; size_t stB;
    if (low) { gB = Kp + (rowk + lane) * QP + head * 96 + (w + 8) * 8; lB = (w + 8) * 1024; stB = (size_t)64 * QP; }
    else { gB = V + (rowk + 16 * (w - 4) + (lane >> 2)) * VP + head * 64 + (lane & 3) * 8; lB = VOFF + (w - 4) * 1024; stB = (size_t)64 * VP; }
    const bf16* gC = V + (rowk + 16 * (w & 3) + (lane >> 2)) * VP + head * 64 + 32 + (lane & 3) * 8; const unsigned lC = VOFF + 4096 + (w & 3) * 1024;
#define ISSUE(tt) do { const unsigned sl_ = lbase + ((tt) & 3) * SLOT; \
        glds16(gA, (unsigned)__builtin_amdgcn_readfirstlane(sl_ + lA)); gA += (size_t)64 * QP; \
        glds16(gB, (unsigned)__builtin_amdgcn_readfirstlane(sl_ + lB)); gB += stB; \
        if (low) { glds16(gC, (unsigned)__builtin_amdgcn_readfirstlane(sl_ + lC)); gC += (size_t)64 * VP; } } while (0)
#define WAIT_BAR_DMA(pending) do { if (pending) { if (low) asm volatile("s_waitcnt vmcnt(3) lgkmcnt(0)\n\ts_barrier" ::: "memory"); else asm volatile("s_waitcnt vmcnt(2) lgkmcnt(0)\n\ts_barrier" ::: "memory"); } \
        else asm volatile("s_waitcnt vmcnt(0) lgkmcnt(0)\n\ts_barrier" ::: "memory"); } while (0)
    ISSUE(0); ISSUE(1); ISSUE(2);
    WAIT_BAR_DMA(true);
    const int i16 = lane & 15, q4 = i16 >> 2, p4 = i16 & 3, blk = (lane >> 4) & 1;
    const int voff = VOFF + (4 * h + q4) * 64 + blk * 32 + p4 * 8;
    const int qmin = q0 + 32 * w, qme = qmin + r;
    const LAS unsigned char* kb0 = lds + h * 1024 + r * 16;
    {
#pragma unroll
        for (int st = 0; st < 6; ++st) {
            const bf16x8 a0 = *(const LAS bf16x8*)(kb0 + st * 2048), a1 = *(const LAS bf16x8*)(kb0 + st * 2048 + 512);
            s0 = MFMA32(a0, qf[st], s0); s1 = MFMA32(a1, qf[st], s1);
        }
    }
    asm volatile("s_nop 15\n\ts_nop 15" : "+v"(s0), "+v"(s1));
#define MAX3(a, b, c) __builtin_fmaxf(__builtin_fmaxf((a), (b)), (c))
#define ROWMAX(S0, S1, MX) do { float mxa_ = MAX3(S0[0], S0[1], S1[0]), mxb_ = MAX3(S0[2], S0[3], S1[1]); mxa_ = MAX3(mxa_, S1[2], S1[3]); \
        _Pragma("unroll") for (int i = 4; i < 16; i += 4) { mxa_ = MAX3(mxa_, S0[i], S0[i + 1]); mxb_ = MAX3(mxb_, S0[i + 2], S0[i + 3]); mxa_ = MAX3(mxa_, S1[i], S1[i + 1]); mxb_ = MAX3(mxb_, S1[i + 2], S1[i + 3]); } \
        MX = MAX3(mxa_, mxb_, mxb_); { const float ot_ = lane_xor(MX, lane, 32); MX = MAX3(MX, ot_, ot_); } } while (0)
#define MASK(S0, S1, TT) do { const int kmin_ = 64 * ((TT) + tbase); if (kmin_ + 63 > qmin) { \
        _Pragma("unroll") for (int i = 0; i < 16; ++i) { const int key = kmin_ + crow(i, h); if (key > qme) S0[i] = -INFINITY; if (key + 32 > qme) S1[i] = -INFINITY; } } } while (0)
    { if (NT == 4) MASK(s0, s1, 0); float mx; ROWMAX(s0, s1, mx); mref = mx;
#pragma unroll
      for (int i = 0; i < 16; ++i) { s0[i] -= mx; s1[i] -= mx; negm[i] = -mx; } }
    bool cur_act = true;
#define ATT_ITER(BAND) do { \
        const int kslot = ((t + 1) & 3) * SLOT, vslot = (t & 3) * SLOT; \
        const bool more1 = (t + 1 < NT), more3 = (t + 3 < NT); \
        if (more3) ISSUE(t + 3); \
        const bool next_act = (BAND) ? (more1 && (64 * (t + 1 + tbase) <= qmin + 31)) : true; \
        f32x16 n0, n1; n0 = negm; n1 = negm; \
        const LAS unsigned char* kb = kb0 + kslot; \
        float mx = -INFINITY; \
        if (!(BAND) || cur_act) { \
            bf16x8 pf[2][2]; \
            { \
                if (next_act) { bf16x8 kf[12]; _Pragma("unroll") for (int st = 0; st < 6; ++st) { kf[2 * st] = *(const LAS bf16x8*)(kb + st * 2048); kf[2 * st + 1] = *(const LAS bf16x8*)(kb + st * 2048 + 512); } \
                    _Pragma("unroll") for (int st = 0; st < 6; ++st) { n0 = MFMA32(kf[2 * st], qf[st], n0); n1 = MFMA32(kf[2 * st + 1], qf[st], n1); } } \
                f32x2 sum2 = {0.f, 0.f}; \
                _Pragma("unroll") for (int i = 0; i < 16; i += 2) { \
                    f32x2 a, c; \
                    a[0] = __builtin_amdgcn_exp2f(s0[i]); a[1] = __builtin_amdgcn_exp2f(s0[i + 1]); c[0] = __builtin_amdgcn_exp2f(s1[i]); c[1] = __builtin_amdgcn_exp2f(s1[i + 1]); \
                    s0[i] = a[0]; s0[i + 1] = a[1]; s1[i] = c[0]; s1[i + 1] = c[1]; sum2 += a; sum2 += c; } \
                lrun += sum2[0] + sum2[1]; \
                _Pragma("unroll") for (int s = 0; s < 2; ++s) { \
                    u32x4 a = {cvtpk(s0[8 * s], s0[8 * s + 1]), cvtpk(s0[8 * s + 2], s0[8 * s + 3]), cvtpk(s0[8 * s + 4], s0[8 * s + 5]), cvtpk(s0[8 * s + 6], s0[8 * s + 7])}; \
                    u32x4 c = {cvtpk(s1[8 * s], s1[8 * s + 1]), cvtpk(s1[8 * s + 2], s1[8 * s + 3]), cvtpk(s1[8 * s + 4], s1[8 * s + 5]), cvtpk(s1[8 * s + 6], s1[8 * s + 7])}; \
                    pf[0][s] = __builtin_bit_cast(bf16x8, a); pf[1][s] = __builtin_bit_cast(bf16x8, c); } \
                if (!(BAND)) {   \
                    __builtin_amdgcn_sched_group_barrier(0x100, 4, 0); \
                    _Pragma("unroll") for (int g_ = 0; g_ < 8; ++g_) { __builtin_amdgcn_sched_group_barrier(0x008, 1, 0); __builtin_amdgcn_sched_group_barrier(0x100, 1, 0); __builtin_amdgcn_sched_group_barrier(0x400, 3, 0); __builtin_amdgcn_sched_group_barrier(0x002, 4, 0); } \
                    _Pragma("unroll") for (int g_ = 0; g_ < 4; ++g_) { __builtin_amdgcn_sched_group_barrier(0x008, 1, 0); __builtin_amdgcn_sched_group_barrier(0x400, 3, 0); __builtin_amdgcn_sched_group_barrier(0x002, 4, 0); } } \
            } \
            __builtin_amdgcn_sched_barrier(0); \
            { \
                const LAS unsigned char* vb = lds + vslot + voff; \
                _Pragma("unroll") for (int kb2 = 0; kb2 < 2; ++kb2) \
                    _Pragma("unroll") for (int s = 0; s < 2; ++s) { \
                        const LAS unsigned char* vp = vb + (32 * kb2 + 16 * s) * 64; \
                        const s16x4 l0 = vtr(vp), h0 = vtr(vp + 8 * 64), l1 = vtr(vp + 4096), h1 = vtr(vp + 4096 + 8 * 64); \
                        const bf16x8 v0 = __builtin_shufflevector(l0, h0, 0, 1, 2, 3, 4, 5, 6, 7), v1 = __builtin_shufflevector(l1, h1, 0, 1, 2, 3, 4, 5, 6, 7); \
                        o0 = MFMA32(v0, pf[kb2][s], o0); o1 = MFMA32(v1, pf[kb2][s], o1); } \
                if (next_act) { if (BAND) MASK(n0, n1, t + 1); ROWMAX(n0, n1, mx); } \
            } \
        } else if (next_act) { \
            _Pragma("unroll") for (int st = 0; st < 6; ++st) { const bf16x8 a0 = *(const LAS bf16x8*)(kb + st * 2048), a1 = *(const LAS bf16x8*)(kb + st * 2048 + 512); n0 = MFMA32(a0, qf[st], n0); n1 = MFMA32(a1, qf[st], n1); } \
            MASK(n0, n1, t + 1); ROWMAX(n0, n1, mx); \
        } \
        WAIT_BAR_DMA(more3);                             \
        s0 = n0; s1 = n1; cur_act = next_act; \
        if (__builtin_amdgcn_ballot_w64(mx > 8.0f) != 0ull) { \
            const float dl = fmaxf(mx, 0.f), f = __builtin_amdgcn_exp2f(-dl); \
            mref += dl; lrun *= f; \
            _Pragma("unroll") for (int i = 0; i < 16; ++i) { s0[i] -= dl; s1[i] -= dl; o0[i] *= f; o1[i] *= f; } \
            _Pragma("unroll") for (int i = 0; i < 16; ++i) negm[i] = -mref; \
        } \
    } while (0)
    int t = 0;
    for (; t + 5 < NT; ++t) ATT_ITER(false);
    for (; t < NT; ++t) ATT_ITER(true);
#undef ROWMAX
#undef MASK
#undef ATT_ITER
#undef MAX3
#undef ISSUE
#undef WAIT_BAR_DMA
    const float lt = lrun + lane_xor(lrun, lane, 32);
    const float inv = 1.0f / lt;
    const int ycol = (head < 6) ? head * 64 : 640 + (head - 6) * 64;
    bf16* yp = Y + (rowbase + qme) * D + ycol + 4 * h;
#pragma unroll
    for (int g = 0; g < 4; ++g) {
        *(u32x2*)(yp + 8 * g) = (u32x2){cvtpk(o0[4 * g] * inv, o0[4 * g + 1] * inv), cvtpk(o0[4 * g + 2] * inv, o0[4 * g + 3] * inv)};
        *(u32x2*)(yp + 32 + 8 * g) = (u32x2){cvtpk(o1[4 * g] * inv, o1[4 * g + 1] * inv), cvtpk(o1[4 * g + 2] * inv, o1[4 * g + 3] * inv)};
    }
}
}

#define XB_TMO      128
#define XB_XCNT(j)  (256  + 64 * (j))
#define XB_XSUB(j)  (1280 + 64 * (j))
#define XB_XGEN(j)  (2304 + 64 * (j))
#define XB_TOP      3328
#define XB_TOPGEN   3392
#define XCD_BAR_WORDS 3456
#define XB_SPIN_CAP (1u << 18)

__device__ __forceinline__ unsigned xb_ld(unsigned* p)              { return __hip_atomic_load(p, __ATOMIC_RELAXED, __HIP_MEMORY_SCOPE_AGENT); }
__device__ __forceinline__ unsigned xb_add(unsigned* p, unsigned v) { return __hip_atomic_fetch_add(p, v, __ATOMIC_RELAXED, __HIP_MEMORY_SCOPE_AGENT); }
__device__ __forceinline__ unsigned xb_xcc_id() { return (unsigned)__builtin_amdgcn_s_getreg((3 << 11) | 20) & 0xFu; }
#define XB_SPIN(cond, bar) do { unsigned _sp = 0; while (cond) { __builtin_amdgcn_s_sleep(1); \
    if ((++_sp & 255u) == 0u) { if (xb_ld(&(bar)[XB_TMO])) break; if (_sp > XB_SPIN_CAP) { atomicAdd(&(bar)[XB_TMO], 1u); break; } } } } while (0)

struct XcdBarrier {
    unsigned* bar; unsigned x;
    volatile LAS unsigned* st;
};

__device__ __forceinline__ XcdBarrier xcd_barrier_post(unsigned* bar, volatile LAS unsigned* st) {
    XcdBarrier b; b.bar = bar; b.x = xb_xcc_id(); b.st = st;
    if (threadIdx.x == 0) (void)xb_add(&bar[XB_XCNT(b.x)], 1u);
    return b;
}
__device__ __forceinline__ void xcd_barrier_complete(unsigned* bar, unsigned x, unsigned& nloc, unsigned& nx) {
    const unsigned G = gridDim.x * gridDim.y * gridDim.z;
    unsigned sum, cnt, mine, sp = 0u;
    for (;;) {
        sum = 0u; cnt = 0u; mine = 0u;
#pragma unroll
        for (unsigned j = 0; j < 16; ++j) { const unsigned c = xb_ld(&bar[XB_XCNT(j)]); sum += c; cnt += (c > 0u) ? 1u : 0u; mine = (j == x) ? c : mine; }
        if (sum == G) break;
        __builtin_amdgcn_s_sleep(1);
        if ((++sp & 255u) == 0u) { if (xb_ld(&bar[XB_TMO])) break; if (sp > XB_SPIN_CAP) { atomicAdd(&bar[XB_TMO], 1u); break; } }
    }
    nloc = mine > 0u ? mine : 1u; nx = cnt > 0u ? cnt : 1u;
}

__device__ __forceinline__ void xcd_barrier(const XcdBarrier& b) {
    asm volatile("s_waitcnt vmcnt(0)" ::: "memory");
    __syncthreads();
    if (threadIdx.x == 0) {
        unsigned* bar = b.bar;
        __builtin_amdgcn_s_waitcnt(0);
        unsigned nloc = b.st[0], nx = b.st[1];
        if (nloc == 0u) { xcd_barrier_complete(bar, b.x, nloc, nx); b.st[0] = nloc; b.st[1] = nx; }
        const unsigned old = xb_add(&bar[XB_XSUB(b.x)], 1u);
        const unsigned gen = old / nloc;
        if (old + 1u == (gen + 1u) * nloc) {
            __builtin_amdgcn_fence(__ATOMIC_RELEASE, "agent");
            asm volatile("s_waitcnt vmcnt(0)" ::: "memory");
            const unsigned og = xb_add(&bar[XB_TOP], 1u);
            const unsigned tg = og / nx;
            if (og + 1u == (tg + 1u) * nx) xb_add(&bar[XB_TOPGEN], 1u);
            else XB_SPIN(xb_ld(&bar[XB_TOPGEN]) == tg, bar);
            __builtin_amdgcn_fence(__ATOMIC_ACQUIRE, "agent");
            xb_add(&bar[XB_XGEN(b.x)], 1u);
            asm volatile("s_waitcnt vmcnt(0)" ::: "memory");
        } else {
            XB_SPIN(xb_ld(&bar[XB_XGEN(b.x)]) == gen, bar);
            __builtin_amdgcn_fence(__ATOMIC_ACQUIRE, "agent");
            asm volatile("s_waitcnt vmcnt(0)" ::: "memory");
        }
    }
    __syncthreads();
}

constexpr int LDS_RSTD = LDS_MISC + 256;
__device__ __forceinline__ void fill_rstd(LAS unsigned char* lds, const pg8::StaticOrder& S, const float* ssq, int tid) {
    LAS float* tbl = (LAS float*)(lds + LDS_RSTD);
    pg8::Unit u;
    if (tid < 256) for (int i = 0; i < 8 && S.next(i, u); ++i) tbl[i * 256 + tid] = 1.0f / sqrtf(ssq[u.pm * 256 + tid] * (1.0f / D) + EPS);
    __syncthreads();
}

constexpr int NPH = 1 + 10 * DEPTH;
#ifndef PH_EN
#define PH_EN 0xffff
#endif
#define EN(b) ((PH_EN >> (b)) & 1)
__global__ void __launch_bounds__(512, 2) mk_fwd(Args A_unused) {
    extern __shared__ __attribute__((aligned(16))) unsigned char lds_raw[];
    LAS unsigned char* lds = (LAS unsigned char*)lds_raw;
    cg::grid_group grid = cg::this_grid();
    const int ph_lo = A_unused.ph_lo, ph_hi = A_unused.ph_hi;
    if (threadIdx.x < 64) ((LAS unsigned*)(lds + LDS_MISC))[threadIdx.x] = 0u;
    __syncthreads();
    XcdBarrier bar = xcd_barrier_post((unsigned*)(A_unused.ws + WS_CTL) + CW_BAR, (volatile LAS unsigned*)(lds + LDS_MISC) + 8);
#define PHASE_ENTER() \
    CArgsP Ap = (CArgsP)__builtin_amdgcn_kernarg_segment_ptr(); asm volatile("" : "+s"(Ap)); \
    int tid = threadIdx.x; asm volatile("" : "+v"(tid)); \
    const int lane = tid & 63, wave = __builtin_amdgcn_readfirstlane(tid >> 6); \
    int bid = blockIdx.x, G = gridDim.x; asm volatile("" : "+s"(bid), "+s"(G)); \
    const int gw = bid * 8 + wave, NGW = G * 8; \
    unsigned char* ws = Ap->ws; asm volatile("" : "+s"(ws)); \
    unsigned char* wl = ws + WS_W; \
    int KD = D, KF = F, KQ = KQKV; asm volatile("" : "+s"(KD), "+s"(KF), "+s"(KQ)); \
    (void)lane; (void)gw; (void)NGW; (void)wl; (void)tid; (void)KD; (void)KF; (void)KQ;
#ifdef PROBE_MASK
    unsigned long long tacc = 0;
#endif
    for (int ph = ph_lo; ph < ph_hi; ++ph) {
#ifdef PROBE_MASK
        const unsigned long long tph0 = __builtin_amdgcn_s_memrealtime();
#endif
        int l = 0, k = -1;
        if (ph == NPH - 1) k = 13; else { l = ph / 10; k = ph % 10; }
        asm volatile("" : "+s"(k), "+s"(l));
        if (k == 0 && l > 0 && gridDim.x == 256) continue;
        if (k == 0) {
            PHASE_ENTER();
            if (EN(12)) prologue(Ap, l, lds, gw, NGW, wave, lane);
        } else if (k == 13) {
            PHASE_ENTER();
            if (EN(0)) norm_phase(Ap->out, Ap->in[I_FINN], nullptr, Ap->out, gw, NGW, lane);
        } else if (EN(1) && (k == 1 || k == 8)) {
            PHASE_ENTER();
            pg8::Gemm g{(const bf16*)(ws + WS_XB), (const bf16*)(wl + (k == 1 ? WL_GU1 : WL_GU2)), M, NGU, KD}; pg8::StaticOrder S; S.init(M, NGU, G, bid);
            const float* ssqp = (const float*)(ws + WS_SSQ) + (size_t)(l * 3 + (k == 1 ? 0 : 2)) * M;
            fill_rstd(lds, S, ssqp, tid);
            EpiSwiglu E{(bf16*)(ws + WS_BIG), ssqp, (const LAS float*)(lds + LDS_RSTD), 0};
            pg8::gemm_phase<EpiSwiglu, pg8::StaticOrder, true, true>(lds, g, S, E);
            if (G == 256 && bid >= 128) convert_items(Ap, l, lds, (k == 1) ? 1 : 3, (bid - 128) * 8 + wave, 1024, wave, lane);
        } else if (EN(2) && (k == 2 || k == 9)) {
            PHASE_ENTER();
            pg8::Gemm g{(const bf16*)(ws + WS_BIG), (const bf16*)(wl + (k == 2 ? WL_DN1 : WL_DN2)), M, D, KF}; pg8::StaticOrder S; S.init(M, D, G, bid);
            EpiResid E{(l == 0 && k == 2) ? Ap->in[I_X] : Ap->out, Ap->out, (bf16*)(ws + WS_XB), (float*)(ws + WS_SSQ) + (size_t)(k == 2 ? l * 3 + 1 : l * 3 + 3) * M, 0.5f};
            pg8::gemm_phase<EpiResid, pg8::StaticOrder, true, true>(lds, g, S, E);
            if (k == 9 && l + 1 < DEPTH && G == 256) convert_items(Ap, l + 1, lds, 0, gw, NGW, wave, lane);
        } else if (EN(4) && k == 3) {
            PHASE_ENTER();
            pg8::Gemm g{(const bf16*)(ws + WS_XB), (const bf16*)(wl + WL_IN), M, NWIN, KD}; pg8::StaticOrder S; S.init(M, NWIN, G, bid);
            fill_rstd(lds, S, (const float*)(ws + WS_SSQ) + (size_t)(l * 3 + 1) * M, tid);
            EpiWin E{(bf16*)(ws + WS_ZS), (bf16*)(ws + WS_U), (bf16*)(ws + WS_QP), (bf16*)(ws + WS_KP), (bf16*)(ws + WS_V), (float*)(ws + WS_FL), (const float*)(ws + WS_SSQ) + (size_t)(l * 3 + 1) * M, (unsigned*)(ws + WS_CTL) + 2048 + l * 96, (const LAS float*)(lds + LDS_RSTD), 0};
            pg8::gemm_phase<EpiWin, pg8::StaticOrder, true, true>(lds, g, S, E);
        } else if (EN(5) && k == 4) {
            PHASE_ENTER();
            prep_phase(Ap, l, lds, tid, wave, lane, bid, G);
        } else if (EN(6) && k == 5) {
            PHASE_ENTER();
            pg8::Gemm g{(const bf16*)(ws + WS_QKN), (const bf16*)(wl + WL_QKV), M, NQKV, KQ}; pg8::StaticOrder S; S.init(M, NQKV, G, bid);
            EpiQKV E{(bf16*)(ws + WS_QP), (bf16*)(ws + WS_KP), (bf16*)(ws + WS_V), (const float*)(ws + WS_ROPE)};
            pg8::gemm_phase<EpiQKV, pg8::StaticOrder, true, true>(lds, g, S, E);
            if (G >= 160) { if (bid >= 128) scan_phase(Ap, l, lds, tid, wave, lane, bid - 128, G - 128); }
            else scan_phase(Ap, l, lds, tid, wave, lane, bid, G);
        } else if (EN(7) && k == 6) {
            PHASE_ENTER();
            LAS unsigned* uw = (LAS unsigned*)(lds + LDS_MISC);
            unsigned* ctl = (unsigned*)(ws + WS_CTL);
            __syncthreads();
            for (int par = 0;; par ^= 1) {
                if (tid == 0) uw[par] = atomicAdd(ctl + 64 * l, 1u);
                asm volatile("s_waitcnt lgkmcnt(0)\n\ts_barrier" ::: "memory");
                const unsigned u = uw[par];
                if (u >= 768u) break;
                const bool fox = (u >= 312u && u < 696u);
                const unsigned v = (u < 312u) ? u : (fox ? u - 312u : u - 696u);
                const int qb = (u < 696u ? 15 : 2) - (int)(v / 24u), bi = (int)(v % 24u), bb = bi / 6, hd = bi % 6 + (fox ? 6 : 0);
                int tbase = 0;
                if (hd >= 6) {
                    const float* C2 = (const float*)(ws + WS_C2) + (size_t)(bb * 6 + hd - 6) * SEQ;
                    const float* nr = (const float*)(ws + WS_CTL) + 2048 + l * 96 + (bb * 6 + hd - 6) * 4;
                    const float B2 = 2.0f * (sqrtf((nr[0] + nr[1]) * (nr[2] + nr[3])) * 1.02f + 1.0f);
                    const float cq = C2[qb * 256];
                    const bool skip = (lane < 4 * (qb + 1) - 4) && (B2 + cq - C2[64 * lane + 63] < -160.0f);
                    const unsigned long long mk = __builtin_amdgcn_ballot_w64(skip);
                    tbase = (~mk == 0ull) ? 0 : __builtin_ctzll(~mk);
                    tbase = __builtin_amdgcn_readfirstlane(tbase);
                }
                att::attn_unit(lds, (const bf16*)(ws + WS_QP), (const bf16*)(ws + WS_KP), (const bf16*)(ws + WS_V), (bf16*)(ws + WS_XN), bb, hd, qb, tbase, tid, wave, lane);
            }
        } else if (EN(8) && k == 7) {
            PHASE_ENTER();
            pg8::Gemm g{(const bf16*)(ws + WS_XN), (const bf16*)(wl + WL_OUT), M, D, KD}; pg8::StaticOrder S; S.init(M, D, G, bid);
            EpiResid E{Ap->out, Ap->out, (bf16*)(ws + WS_XB), (float*)(ws + WS_SSQ) + (size_t)(l * 3 + 2) * M, 1.0f};
            pg8::gemm_phase<EpiResid, pg8::StaticOrder, true, true>(lds, g, S, E);
        }
        if (ph + 1 < ph_hi) { if (ph_hi > 1000) grid.sync(); xcd_barrier(bar); }
#ifdef PROBE_MASK
        if ((PROBE_MASK >> k) & 1) tacc += __builtin_amdgcn_s_memrealtime() - tph0;
#endif
    }
#ifdef PROBE_MASK
    if (blockIdx.x == 0) { const unsigned long long tend = __builtin_amdgcn_s_memrealtime() + 4ull * tacc; while (__builtin_amdgcn_s_memrealtime() < tend) __builtin_amdgcn_s_sleep(32); }
#endif
}

extern "C" void kernel_launch(void* const* d_in, const int* in_sizes, int n_in, void* d_out, int out_size, void* d_ws, size_t ws_size, hipStream_t stream) {
    static int grid = 0;
    if (grid == 0) {
        if (n_in != 18 || out_size != M * D || ws_size < WS_END) { fprintf(stderr, "kernel_launch: unexpected problem (n_in %d out %d ws %zu need %zu)\n", n_in, out_size, ws_size, (size_t)WS_END); grid = -1; return; }
        int dev = 0, cus = 0, per_cu = 0;
        hipGetDevice(&dev); hipDeviceGetAttribute(&cus, hipDeviceAttributeMultiprocessorCount, dev);
        if (hipFuncSetAttribute((const void*)mk_fwd, hipFuncAttributeMaxDynamicSharedMemorySize, LDS_BYTES) != hipSuccess) { fprintf(stderr, "kernel_launch: hipFuncSetAttribute failed\n"); grid = -1; return; }
        if (hipOccupancyMaxActiveBlocksPerMultiprocessor(&per_cu, (const void*)mk_fwd, 512, LDS_BYTES) != hipSuccess || per_cu < 1) { fprintf(stderr, "kernel_launch: occupancy query says %d\n", per_cu); per_cu = 1; }
        (void)hipGetLastError();
        grid = cus * per_cu;
        fprintf(stderr, "kernel_launch: grid %d (cus %d x %d)\n", grid, cus, per_cu);
        if (grid < 192) fprintf(stderr, "kernel_launch: this build keeps per-unit row scales for at most 8 GEMM units per workgroup (needs >= 176 workgroups); grid %d is too small\n", grid);
    }
    if (grid < 0) return;
    (void)hipMemsetAsync((char*)d_ws + WS_CTL, 0, CTL_BYTES, stream);
    Args a{};
    for (int i = 0; i < 18; ++i) a.in[i] = (const float*)d_in[i];
    a.out = (float*)d_out; a.ws = (unsigned char*)d_ws;
#if MK_MULTI
    for (int ph = 0; ph < NPH; ++ph) { a.ph_lo = ph; a.ph_hi = ph + 1; hipLaunchKernelGGL(mk_fwd, dim3(grid), dim3(512), LDS_BYTES, stream, a); }
#else
    a.ph_lo = 0; a.ph_hi = NPH;
    void* args[] = {&a};
    hipError_t e = hipLaunchCooperativeKernel((const void*)mk_fwd, dim3(grid), dim3(512), args, LDS_BYTES, stream);
    if (e != hipSuccess) fprintf(stderr, "kernel_launch: cooperative launch failed: %s (grid %d)\n", hipGetErrorString(e), grid);
#endif
}
```
